# Optimizing an MI355X kernel written in HIP

```python
import math
import jax, jax.numpy as jnp
from jax import lax
import numpy as np

D_MODEL = 1024
BATCH = 16
SEQ = 2048
DEPTH = 1

MEM_LEN = 256
EPS = 1e-6
GMLP_GROUPS = 6
GMLP_GROUP_DIM = 128
GMLP_WIDTH = GMLP_GROUPS * GMLP_GROUP_DIM
CHUNK = 128
MOBA_HEADS = 12
HEAD_DIM = 64
MOBA_WIDTH = MOBA_HEADS * HEAD_DIM
MOBA_BLOCK = 256
MOBA_TOPK = 3
Q_CHUNK = 64
REL_BUCKETS = 32
REL_MAX_DIST = 128
MEM_HEADS = 4
MEM_HEAD_DIM = 128
MEM_WIDTH = MEM_HEADS * MEM_HEAD_DIM
N_BRANCHES = 3
D_FF = -(-8 * D_MODEL // (3 * 256)) * 256
IN_WIDTH = 2 * GMLP_WIDTH + 3 * MOBA_WIDTH + MEM_WIDTH + N_BRANCHES * D_MODEL
NEG = -1e30

kernel_name = "hybrid_gmlp_moba_memxattn_block"


def rms_norm(x, g):
    xf = x.astype(jnp.float32)
    y = xf * lax.rsqrt(jnp.mean(xf * xf, axis=-1, keepdims=True) + EPS)
    return (y * g.astype(jnp.float32)).astype(x.dtype)


def layer_norm(x, g, b):
    xf = x.astype(jnp.float32)
    mu = jnp.mean(xf, axis=-1, keepdims=True)
    xc = xf - mu
    y = xc * lax.rsqrt(jnp.mean(xc * xc, axis=-1, keepdims=True) + EPS)
    return (y * g.astype(jnp.float32) + b.astype(jnp.float32)).astype(x.dtype)


def t5_bucket(dist):
    max_exact = REL_BUCKETS // 2
    n = jnp.maximum(dist, 0)
    nf = jnp.maximum(n, 1).astype(jnp.float32)
    large = max_exact + (jnp.log(nf / max_exact) / math.log(REL_MAX_DIST / max_exact)
                         * (REL_BUCKETS - max_exact)).astype(jnp.int32)
    large = jnp.minimum(large, REL_BUCKETS - 1)
    return jnp.where(n < max_exact, n, large)


def gmlp_branch(u, v, ln_g, ln_b, w_s, b_s):
    B, S, _ = v.shape
    u = jax.nn.gelu(u)
    v = layer_norm(jax.nn.gelu(v), ln_g, ln_b)
    vc = v.reshape(B, S // CHUNK, CHUNK, GMLP_GROUPS, GMLP_GROUP_DIM)
    causal = jnp.tril(jnp.ones((CHUNK, CHUNK), dtype=bool))
    ws = jnp.where(causal[None], w_s, jnp.zeros_like(w_s))
    mixed = jnp.einsum('gts,bcsgd->bctgd', ws, vc) + b_s.T[None, None, :, :, None]
    return u * mixed.reshape(B, S, GMLP_WIDTH)


def moba_attention(q, k, v, rel_bias):
    B, H, S, d = q.shape
    n_blk = -(-S // MOBA_BLOCK)
    pad = n_blk * MOBA_BLOCK - S
    kp = jnp.pad(k, ((0, 0), (0, 0), (0, pad), (0, 0)))
    vp = jnp.pad(v, ((0, 0), (0, 0), (0, pad), (0, 0)))
    kb = kp.reshape(B, H, n_blk, MOBA_BLOCK, d)
    vb = vp.reshape(B, H, n_blk, MOBA_BLOCK, d)
    kmean = jnp.mean(kb.astype(jnp.float32), axis=3)
    gate = jnp.einsum('bhsd,bhnd->bhsn', q.astype(jnp.float32), kmean)
    cur = jnp.arange(S) // MOBA_BLOCK
    past = jnp.arange(n_blk)[None, :] < cur[:, None]
    gate = jnp.where(past[None, None], gate, NEG)
    k_sel = min(MOBA_TOPK, n_blk)
    _, idx = lax.top_k(gate, k_sel)

    n_qc = S // Q_CHUNK
    qs = q.reshape(B, H, n_qc, Q_CHUNK, d).transpose(0, 2, 1, 3, 4).reshape(B * n_qc, H, Q_CHUNK, d)
    ids = idx.reshape(B, H, n_qc, Q_CHUNK, k_sel).transpose(0, 2, 1, 3, 4).reshape(B * n_qc, H, Q_CHUNK, k_sel)
    bids = jnp.repeat(jnp.arange(B), n_qc)
    cids = jnp.tile(jnp.arange(n_qc), B)
    bias_h = rel_bias.T.astype(jnp.float32)
    h_ix = jnp.arange(H)
    blk_ar = jnp.arange(MOBA_BLOCK)

    def one_chunk(args):
        qc, ic, b, c = args
        kb_b = kb[b]
        vb_b = vb[b]
        t = c * Q_CHUNK + jnp.arange(Q_CHUNK)
        own = (c * Q_CHUNK) // MOBA_BLOCK
        k_g = kb_b[h_ix[:, None, None], ic]
        v_g = vb_b[h_ix[:, None, None], ic]
        key_pos = ic[..., None] * MOBA_BLOCK + blk_ar
        s_sel = jnp.einsum('hqd,hqknd->hqkn', qc, k_g).astype(jnp.float32)
        s_sel = s_sel + bias_h[h_ix[:, None, None, None], t5_bucket(t[None, :, None, None] - key_pos)]
        valid = ic < own
        s_sel = jnp.where(valid[..., None], s_sel, NEG)
        k_o = lax.dynamic_index_in_dim(kb_b, own, axis=1, keepdims=False)
        v_o = lax.dynamic_index_in_dim(vb_b, own, axis=1, keepdims=False)
        dist_o = t[:, None] - (own * MOBA_BLOCK + blk_ar)[None, :]
        s_own = jnp.einsum('hqd,hnd->hqn', qc, k_o).astype(jnp.float32) + bias_h[:, t5_bucket(dist_o)]
        s_own = jnp.where((dist_o >= 0)[None], s_own, NEG)
        logits = jnp.concatenate([s_sel.reshape(H, Q_CHUNK, k_sel * MOBA_BLOCK), s_own], axis=-1)
        p = jax.nn.softmax(logits, axis=-1)
        p_sel = p[..., :k_sel * MOBA_BLOCK].reshape(H, Q_CHUNK, k_sel, MOBA_BLOCK).astype(v.dtype)
        p_own = p[..., k_sel * MOBA_BLOCK:].astype(v.dtype)
        return jnp.einsum('hqkn,hqknd->hqd', p_sel, v_g) + jnp.einsum('hqn,hnd->hqd', p_own, v_o)

    out = lax.map(one_chunk, (qs, ids, bids, cids))
    return out.reshape(B, n_qc, H, Q_CHUNK, d).transpose(0, 2, 1, 3, 4).reshape(B, H, S, d)


def mem_attention(q, mem_n, w_kv):
    B, M, _ = mem_n.shape
    kv = mem_n @ w_kv
    k, v = jnp.split(kv, 2, axis=-1)
    k = k.reshape(B, M, MEM_HEADS, MEM_HEAD_DIM)
    v = v.reshape(B, M, MEM_HEADS, MEM_HEAD_DIM)
    s = jnp.einsum('bshd,bmhd->bhsm', q, k).astype(jnp.float32) * (MEM_HEAD_DIM ** -0.5)
    p = jax.nn.softmax(s, axis=-1).astype(v.dtype)
    return jnp.einsum('bhsm,bmhd->bshd', p, v)


def setup_inputs(seed: int = 0) -> dict:
    key = jax.random.key(seed)
    ks = jax.random.split(key, 24)
    f32 = jnp.float32

    def nrm(k, shape, scale):
        return jax.random.normal(k, shape, f32) * scale

    def gain(k, shape):
        return 1.0 + 0.05 * jax.random.normal(k, shape, f32)

    L, D = DEPTH, D_MODEL
    return {
        "x": nrm(ks[0], (BATCH, SEQ, D), 1.0),
        "mem": nrm(ks[1], (BATCH, MEM_LEN, D), 1.0),
        "ln_mix_pre": gain(ks[2], (L, D)),
        "ln_mix_post": gain(ks[3], (L, D)),
        "ln_ffn_pre": gain(ks[4], (L, D)),
        "ln_ffn_post": gain(ks[5], (L, D)),
        "ln_mem": gain(ks[6], (L, D)),
        "w_in": nrm(ks[7], (L, D, IN_WIDTH), D ** -0.5),
        "ln_v_gain": gain(ks[8], (L, GMLP_WIDTH)),
        "ln_v_bias": nrm(ks[9], (L, GMLP_WIDTH), 0.05),
        "w_spatial": nrm(ks[10], (L, GMLP_GROUPS, CHUNK, CHUNK), CHUNK ** -0.5),
        "b_spatial": 1.0 + nrm(ks[11], (L, GMLP_GROUPS, CHUNK), 0.1),
        "rel_bias": nrm(ks[12], (REL_BUCKETS, MOBA_HEADS), 0.5),
        "w_mem_kv": nrm(ks[13], (L, D, 2 * MEM_WIDTH), D ** -0.5),
        "w_branch_a": nrm(ks[14], (L, GMLP_WIDTH, D), GMLP_WIDTH ** -0.5),
        "w_branch_b": nrm(ks[15], (L, MOBA_WIDTH, D), MOBA_WIDTH ** -0.5),
        "w_branch_c": nrm(ks[16], (L, MEM_WIDTH, D), MEM_WIDTH ** -0.5),
        "w_out": nrm(ks[17], (L, D, D), D ** -0.5),
        "w_ffn_gate": nrm(ks[18], (L, D, D_FF), D ** -0.5),
        "w_ffn_up": nrm(ks[19], (L, D, D_FF), D ** -0.5),
        "w_ffn_down": nrm(ks[20], (L, D_FF, D), D_FF ** -0.5),
    }


def reference(x, mem, ln_mix_pre, ln_mix_post, ln_ffn_pre, ln_ffn_post, ln_mem, w_in,
              ln_v_gain, ln_v_bias, w_spatial, b_spatial, rel_bias, w_mem_kv,
              w_branch_a, w_branch_b, w_branch_c, w_out, w_ffn_gate, w_ffn_up, w_ffn_down):
    B, S, D = x.shape
    split_at = np.cumsum([GMLP_WIDTH, GMLP_WIDTH, MOBA_WIDTH, MOBA_WIDTH, MOBA_WIDTH, MEM_WIDTH]).tolist()
    for l in range(DEPTH):
        h = rms_norm(x, ln_mix_pre[l])
        proj = h @ w_in[l]
        a_u, a_v, b_q, b_k, b_v, c_q, g_logit = jnp.split(proj, split_at, axis=-1)
        a_out = gmlp_branch(a_u, a_v, ln_v_gain[l], ln_v_bias[l], w_spatial[l], b_spatial[l])
        to_heads = lambda t: t.reshape(B, S, MOBA_HEADS, HEAD_DIM).transpose(0, 2, 1, 3)
        b_att = moba_attention(to_heads(b_q) * (HEAD_DIM ** -0.5), to_heads(b_k), to_heads(b_v), rel_bias)
        b_out = b_att.transpose(0, 2, 1, 3).reshape(B, S, MOBA_WIDTH)
        mem_n = rms_norm(mem, ln_mem[l])
        c_out = mem_attention(c_q.reshape(B, S, MEM_HEADS, MEM_HEAD_DIM), mem_n, w_mem_kv[l]).reshape(B, S, MEM_WIDTH)
        gates = jax.nn.sigmoid(g_logit).reshape(B, S, N_BRANCHES, D)
        merged = (gates[:, :, 0] * (a_out @ w_branch_a[l])
                  + gates[:, :, 1] * (b_out @ w_branch_b[l])
                  + gates[:, :, 2] * (c_out @ w_branch_c[l]))
        x = x + rms_norm(merged @ w_out[l], ln_mix_post[l])
        h2 = rms_norm(x, ln_ffn_pre[l])
        f = (jax.nn.silu(h2 @ w_ffn_gate[l]) * (h2 @ w_ffn_up[l])) @ w_ffn_down[l]
        x = x + rms_norm(f, ln_ffn_post[l])
    return x
```

```cpp
#include <hip/hip_runtime.h>
#include <cstdio>
#include <cstdint>

typedef unsigned short bf16;
typedef unsigned v4u __attribute__((ext_vector_type(4)));

constexpr int BATCH = 16, SEQ = 2048, DM = 1024, T = BATCH * SEQ;
constexpr int MEMLEN = 256, TM = BATCH * MEMLEN;
constexpr int GW = 768, NGRP = 6, CHUNK = 128;
constexpr int NH = 12, HD = 64, MW = 768, MBLK = 256, NBLK = SEQ / MBLK;
constexpr int MH = 4, MHD = 128, MEMW = 512;
constexpr int DFF = 2816, INW = 7424;
constexpr float EPS = 1e-6f;
constexpr float LOG2E = 1.4426950408889634f;
constexpr float C2Q = 0.125f * LOG2E;
constexpr float C2M = 0.08838834764831845f * LOG2E;

constexpr size_t MiB = 1u << 20;
constexpr size_t DO_H = 0;
constexpr size_t DO_MEMN = 64 * MiB;
constexpr size_t DO_WCAT = 72 * MiB;
constexpr size_t DO_WOUT = 76 * MiB;
constexpr size_t DO_WGU = 78 * MiB;
constexpr size_t DO_WD = 89 * MiB;
constexpr size_t WS_CTL = 0;
constexpr size_t WS_KMEAN = 256 * 1024;
constexpr size_t WS_STATS = 704 * 1024;
constexpr size_t WS_WIN = 1 * MiB;
constexpr size_t WS_WKV = 16 * MiB;
constexpr size_t WS_MEMKV = 18 * MiB;
constexpr size_t WS_MIX = 26 * MiB;
constexpr size_t WS_GV = 154 * MiB;
constexpr size_t WS_KB = 202 * MiB;
constexpr size_t WS_VB = 250 * MiB;
constexpr size_t WS_GATES = 298 * MiB;
constexpr size_t WS_Y = 26 * MiB;
constexpr size_t WS_HID = 26 * MiB;
constexpr size_t WS_F = 202 * MiB;
constexpr size_t WS_H2 = 320 * MiB;
constexpr size_t WS_X1 = 384 * MiB;
constexpr size_t WS_NEED = 512 * MiB;

__device__ __forceinline__ float bf2f(bf16 v) { return __uint_as_float((unsigned)v << 16); }
__device__ __forceinline__ bf16 f2bf(float f) { unsigned u = __float_as_uint(f); return (bf16)((u + 0x7fffu + ((u >> 16) & 1u)) >> 16); }
__device__ __forceinline__ float wave_sum(float v) {
#pragma unroll
    for (int o = 1; o < 64; o <<= 1) v += __shfl_xor(v, o);
    return v;
}
__device__ __forceinline__ float wave_max(float v) {
#pragma unroll
    for (int o = 1; o < 64; o <<= 1) v = fmaxf(v, __shfl_xor(v, o));
    return v;
}
__device__ __forceinline__ float gelu_tanh(float x) {
    const float u = 0.7978845608028654f * (x + 0.044715f * x * x * x);
    return 0.5f * x * (1.0f + tanhf(u));
}
__device__ __forceinline__ float sigmoidf(float x) { return 1.0f / (1.0f + __expf(-x)); }
__device__ __forceinline__ int t5_bucket(int n) {
    if (n < 16) return n;
    int large = 16 + (int)(logf((float)n / 16.0f) / 2.0794415416798357f * 16.0f);
    return large < 31 ? large : 31;
}

__global__ void k_wt(const float* __restrict__ W, int K, int N, bf16* WT, int ldt, int col_off, int mode) {
    const size_t total = (size_t)K * N;
    for (size_t idx = (size_t)blockIdx.x * blockDim.x + threadIdx.x; idx < total; idx += (size_t)gridDim.x * blockDim.x) {
        const int k = (int)(idx / N), n = (int)(idx % N);
        int row = n;
        if (mode) row = (n / 128) * 256 + (n % 128) + (mode == 2 ? 128 : 0);
        WT[(size_t)row * ldt + col_off + k] = f2bf(W[idx]);
    }
}
__global__ void k_rmsnorm_bf16(const float* __restrict__ x, const float* __restrict__ g, bf16* out, int rows) {
    const int lane = threadIdx.x & 63, w = (blockIdx.x * blockDim.x + threadIdx.x) >> 6;
    if (w >= rows) return;
    const float4* xr = (const float4*)(x + (size_t)w * DM);
    float4 v[4]; float s = 0.f;
#pragma unroll
    for (int j = 0; j < 4; ++j) { v[j] = xr[lane + 64 * j]; s += v[j].x * v[j].x + v[j].y * v[j].y + v[j].z * v[j].z + v[j].w * v[j].w; }
    const float r = rsqrtf(wave_sum(s) * (1.f / DM) + EPS);
#pragma unroll
    for (int j = 0; j < 4; ++j) {
        const float4 gg = ((const float4*)g)[lane + 64 * j];
        bf16* o = out + (size_t)w * DM + (lane + 64 * j) * 4;
        o[0] = f2bf(v[j].x * r * gg.x); o[1] = f2bf(v[j].y * r * gg.y); o[2] = f2bf(v[j].z * r * gg.z); o[3] = f2bf(v[j].w * r * gg.w);
    }
}

struct EpiProj {
    bf16 *mix, *gv, *kb, *vb, *gates;
    __device__ __forceinline__ void operator()(int m, int c, float v) const {
        if (c < 768) mix[(size_t)m * 2048 + c] = f2bf(gelu_tanh(v));
        else if (c < 1536) gv[(size_t)m * 768 + (c - 768)] = f2bf(gelu_tanh(v));
        else if (c < 2304) mix[(size_t)m * 2048 + 768 + (c - 1536)] = f2bf(v * C2Q);
        else if (c < 3072) kb[(size_t)m * 768 + (c - 2304)] = f2bf(v);
        else if (c < 3840) vb[(size_t)m * 768 + (c - 3072)] = f2bf(v);
        else if (c < 4352) mix[(size_t)m * 2048 + 1536 + (c - 3840)] = f2bf(v * C2M);
        else gates[(size_t)m * 3072 + (c - 4352)] = f2bf(sigmoidf(v));
    }
};
struct EpiBf16Store { bf16* o; int ld; __device__ __forceinline__ void operator()(int m, int c, float v) const { o[(size_t)m * ld + c] = f2bf(v); } };
struct EpiF32Store { float* o; int ld; __device__ __forceinline__ void operator()(int m, int c, float v) const { o[(size_t)m * ld + c] = v; } };

template <class Epi>
__global__ void __launch_bounds__(256) k_gemm_naive(const bf16* __restrict__ A, const bf16* __restrict__ Bt, int M, int N, int K, Epi epi) {
    __shared__ float As[32][65], Bs[32][65];
    const int tid = threadIdx.x, tx = tid & 15, ty = tid >> 4;
    const int m0 = blockIdx.y * 64, n0 = blockIdx.x * 64;
    float acc[4][4] = {};
    const int lr = tid >> 2, lk = (tid & 3) * 8;
    for (int k0 = 0; k0 < K; k0 += 32) {
        const v4u a = *(const v4u*)(A + (size_t)(m0 + lr) * K + k0 + lk);
        const v4u b = *(const v4u*)(Bt + (size_t)(n0 + lr) * K + k0 + lk);
        __syncthreads();
#pragma unroll
        for (int j = 0; j < 4; ++j) {
            As[lk + 2 * j][lr] = __uint_as_float(a[j] << 16); As[lk + 2 * j + 1][lr] = __uint_as_float(a[j] & 0xffff0000u);
            Bs[lk + 2 * j][lr] = __uint_as_float(b[j] << 16); Bs[lk + 2 * j + 1][lr] = __uint_as_float(b[j] & 0xffff0000u);
        }
        __syncthreads();
#pragma unroll 8
        for (int k = 0; k < 32; ++k) {
            float av[4], bv[4];
#pragma unroll
            for (int i = 0; i < 4; ++i) { av[i] = As[k][ty * 4 + i]; bv[i] = Bs[k][tx * 4 + i]; }
#pragma unroll
            for (int i = 0; i < 4; ++i)
#pragma unroll
                for (int j = 0; j < 4; ++j) acc[i][j] += av[i] * bv[j];
        }
    }
#pragma unroll
    for (int i = 0; i < 4; ++i)
#pragma unroll
        for (int j = 0; j < 4; ++j) epi(m0 + ty * 4 + i, n0 + tx * 4 + j, acc[i][j]);
}

__global__ void __launch_bounds__(256) k_merge_naive(const bf16* __restrict__ A, const bf16* __restrict__ Bt, const bf16* __restrict__ gates, bf16* merged) {
    __shared__ float As[32][65], Bs[32][65];
    const int K = 2048;
    const int tid = threadIdx.x, tx = tid & 15, ty = tid >> 4;
    const int m0 = blockIdx.y * 64, n0 = blockIdx.x * 64;
    float acc[4][4] = {}, tot[4][4] = {};
    const int lr = tid >> 2, lk = (tid & 3) * 8;
    for (int k0 = 0; k0 < K; k0 += 32) {
        const v4u a = *(const v4u*)(A + (size_t)(m0 + lr) * K + k0 + lk);
        const v4u b = *(const v4u*)(Bt + (size_t)(n0 + lr) * K + k0 + lk);
        __syncthreads();
#pragma unroll
        for (int j = 0; j < 4; ++j) {
            As[lk + 2 * j][lr] = __uint_as_float(a[j] << 16); As[lk + 2 * j + 1][lr] = __uint_as_float(a[j] & 0xffff0000u);
            Bs[lk + 2 * j][lr] = __uint_as_float(b[j] << 16); Bs[lk + 2 * j + 1][lr] = __uint_as_float(b[j] & 0xffff0000u);
        }
        __syncthreads();
#pragma unroll 8
        for (int k = 0; k < 32; ++k) {
            float av[4], bv[4];
#pragma unroll
            for (int i = 0; i < 4; ++i) { av[i] = As[k][ty * 4 + i]; bv[i] = Bs[k][tx * 4 + i]; }
#pragma unroll
            for (int i = 0; i < 4; ++i)
#pragma unroll
                for (int j = 0; j < 4; ++j) acc[i][j] += av[i] * bv[j];
        }
        const int kn = k0 + 32;
        if (kn == 768 || kn == 1536 || kn == 2048) {
            const int seg = kn == 768 ? 0 : (kn == 1536 ? 1 : 2);
#pragma unroll
            for (int i = 0; i < 4; ++i)
#pragma unroll
                for (int j = 0; j < 4; ++j) {
                    const float g = bf2f(gates[(size_t)(m0 + ty * 4 + i) * 3072 + seg * 1024 + n0 + tx * 4 + j]);
                    tot[i][j] += g * acc[i][j]; acc[i][j] = 0.f;
                }
        }
    }
#pragma unroll
    for (int i = 0; i < 4; ++i)
#pragma unroll
        for (int j = 0; j < 4; ++j) merged[(size_t)(m0 + ty * 4 + i) * 1024 + n0 + tx * 4 + j] = f2bf(tot[i][j]);
}

__global__ void __launch_bounds__(256) k_ffn_up_naive(const bf16* __restrict__ A, const bf16* __restrict__ Bt, bf16* hid) {
    __shared__ float As[32][65], Bg[32][65], Bu[32][65];
    const int K = 1024;
    const int tid = threadIdx.x, tx = tid & 15, ty = tid >> 4;
    const int m0 = blockIdx.y * 64, j0 = blockIdx.x * 64;
    const int rg = (j0 / 128) * 256 + (j0 % 128), ru = rg + 128;
    float ag[4][4] = {}, au[4][4] = {};
    const int lr = tid >> 2, lk = (tid & 3) * 8;
    for (int k0 = 0; k0 < K; k0 += 32) {
        const v4u a = *(const v4u*)(A + (size_t)(m0 + lr) * K + k0 + lk);
        const v4u b = *(const v4u*)(Bt + (size_t)(rg + lr) * K + k0 + lk);
        const v4u c = *(const v4u*)(Bt + (size_t)(ru + lr) * K + k0 + lk);
        __syncthreads();
#pragma unroll
        for (int j = 0; j < 4; ++j) {
            As[lk + 2 * j][lr] = __uint_as_float(a[j] << 16); As[lk + 2 * j + 1][lr] = __uint_as_float(a[j] & 0xffff0000u);
            Bg[lk + 2 * j][lr] = __uint_as_float(b[j] << 16); Bg[lk + 2 * j + 1][lr] = __uint_as_float(b[j] & 0xffff0000u);
            Bu[lk + 2 * j][lr] = __uint_as_float(c[j] << 16); Bu[lk + 2 * j + 1][lr] = __uint_as_float(c[j] & 0xffff0000u);
        }
        __syncthreads();
#pragma unroll 4
        for (int k = 0; k < 32; ++k) {
            float av[4], bv[4], cv[4];
#pragma unroll
            for (int i = 0; i < 4; ++i) { av[i] = As[k][ty * 4 + i]; bv[i] = Bg[k][tx * 4 + i]; cv[i] = Bu[k][tx * 4 + i]; }
#pragma unroll
            for (int i = 0; i < 4; ++i)
#pragma unroll
                for (int j = 0; j < 4; ++j) { ag[i][j] += av[i] * bv[j]; au[i][j] += av[i] * cv[j]; }
        }
    }
#pragma unroll
    for (int i = 0; i < 4; ++i)
#pragma unroll
        for (int j = 0; j < 4; ++j) { const float g = ag[i][j]; hid[(size_t)(m0 + ty * 4 + i) * DFF + j0 + tx * 4 + j] = f2bf(g * sigmoidf(g) * au[i][j]); }
}

__global__ void k_gv_stats(const bf16* __restrict__ gv, float* stats) {
    const int lane = threadIdx.x & 63, w = (blockIdx.x * blockDim.x + threadIdx.x) >> 6;
    if (w >= T) return;
    float v[12]; float s = 0.f;
#pragma unroll
    for (int j = 0; j < 12; ++j) { v[j] = bf2f(gv[(size_t)w * 768 + lane + 64 * j]); s += v[j]; }
    const float mu = wave_sum(s) * (1.f / 768.f); float q = 0.f;
#pragma unroll
    for (int j = 0; j < 12; ++j) { const float d = v[j] - mu; q += d * d; }
    const float rstd = rsqrtf(wave_sum(q) * (1.f / 768.f) + EPS);
    if (lane == 0) { stats[2 * w] = mu; stats[2 * w + 1] = rstd; }
}
__global__ void k_gmlp_naive(const bf16* __restrict__ gv, const float* __restrict__ stats, const float* __restrict__ gain, const float* __restrict__ bias,
                             const float* __restrict__ wsp, const float* __restrict__ bsp, bf16* mix) {
    const size_t idx = (size_t)blockIdx.x * blockDim.x + threadIdx.x;
    if (idx >= (size_t)T * 768) return;
    const int t = (int)(idx / 768), ch = (int)(idx % 768), g = ch / 128, tl = t % CHUNK, base = t - tl;
    const float ga = gain[ch], be = bias[ch];
    float acc = 0.f;
    for (int s = 0; s <= tl; ++s) {
        const float v = (bf2f(gv[(size_t)(base + s) * 768 + ch]) - stats[2 * (base + s)]) * stats[2 * (base + s) + 1] * ga + be;
        acc += wsp[(size_t)(g * CHUNK + tl) * CHUNK + s] * v;
    }
    acc += bsp[g * CHUNK + tl];
    const float u = bf2f(mix[(size_t)t * 2048 + ch]);
    mix[(size_t)t * 2048 + ch] = f2bf(u * acc);
}

__global__ void k_kmean(const bf16* __restrict__ kb, float* kmean) {
    const int idx = blockIdx.x * blockDim.x + threadIdx.x;
    if (idx >= BATCH * NBLK * 768) return;
    const int c = idx % 768, bn = idx / 768;
    float s = 0.f;
    for (int r = 0; r < MBLK; ++r) s += bf2f(kb[(size_t)(bn * MBLK + r) * 768 + c]);
    kmean[idx] = s * (1.f / MBLK);
}
__global__ void __launch_bounds__(256) k_moba_naive(bf16* mix, const bf16* __restrict__ kb, const bf16* __restrict__ vb, const float* __restrict__ kmean, const float* __restrict__ relb) {
    __shared__ float lg[4][1024];
    const int lane = threadIdx.x & 63, wl = threadIdx.x >> 6;
    const int w = blockIdx.x * 4 + wl;
    const int s = w % SEQ, bh = w / SEQ, h = bh % NH, b = bh / NH;
    const int t = b * SEQ + s, cur = s / MBLK;
    float q[64];
#pragma unroll
    for (int d = 0; d < 64; ++d) q[d] = bf2f(mix[(size_t)t * 2048 + 768 + h * 64 + d]);
    float gt[8];
#pragma unroll
    for (int n = 0; n < 8; ++n) {
        float a = 0.f;
        if (n < cur) { const float* km = kmean + (size_t)(b * NBLK + n) * 768 + h * 64;
#pragma unroll
            for (int d = 0; d < 64; ++d) a += q[d] * km[d]; }
        gt[n] = a;
    }
    unsigned sel = 0;
#pragma unroll
    for (int n = 0; n < 8; ++n) if (n < cur) {
        int rank = 0;
#pragma unroll
        for (int m = 0; m < 8; ++m) if (m < cur && m != n) rank += (gt[m] > gt[n] || (gt[m] == gt[n] && m < n)) ? 1 : 0;
        if (rank < 3) sel |= 1u << n;
    }
    int nslot = 0; float mx = -INFINITY;
    for (int n = 0; n <= cur; ++n) {
        if (n < cur && !((sel >> n) & 1u)) continue;
#pragma unroll
        for (int i = 0; i < 4; ++i) {
            const int j = lane + 64 * i, kp = n * MBLK + j, dist = s - kp;
            float l = -INFINITY;
            if (dist >= 0) {
                const bf16* kr = kb + (size_t)(b * SEQ + kp) * 768 + h * 64; float a = 0.f;
#pragma unroll
                for (int d = 0; d < 64; ++d) a += q[d] * bf2f(kr[d]);
                l = a + relb[t5_bucket(dist) * NH + h] * LOG2E;
            }
            lg[wl][nslot * 256 + j] = l; mx = fmaxf(mx, l);
        }
        ++nslot;
    }
    mx = wave_max(mx);
    float sum = 0.f;
    const int nk = nslot * 256;
    for (int j = lane; j < nk; j += 64) { const float p = exp2f(lg[wl][j] - mx); lg[wl][j] = p; sum += p; }
    sum = wave_sum(sum);
    __syncthreads();
    float o = 0.f; int slot = 0;
    for (int n = 0; n <= cur; ++n) {
        if (n < cur && !((sel >> n) & 1u)) continue;
        const int jmax = (n == cur) ? (s - cur * MBLK + 1) : MBLK;
        for (int j = 0; j < jmax; ++j) o += lg[wl][slot * 256 + j] * bf2f(vb[(size_t)(b * SEQ + n * MBLK + j) * 768 + h * 64 + lane]);
        ++slot;
    }
    mix[(size_t)t * 2048 + 768 + h * 64 + lane] = f2bf(o / sum);
}

__global__ void __launch_bounds__(256) k_memattn_naive(bf16* mix, const bf16* __restrict__ memkv) {
    __shared__ float lg[4][256];
    const int lane = threadIdx.x & 63, wl = threadIdx.x >> 6;
    const int w = blockIdx.x * 4 + wl;
    const int s = w % SEQ, bh = w / SEQ, h = bh % MH, b = bh / MH;
    const int t = b * SEQ + s;
    float mx = -INFINITY;
#pragma unroll
    for (int i = 0; i < 4; ++i) {
        const int m = lane + 64 * i;
        const bf16* kr = memkv + (size_t)(b * MEMLEN + m) * 1024 + h * 128; float a = 0.f;
        for (int d = 0; d < 128; ++d) a += bf2f(mix[(size_t)t * 2048 + 1536 + h * 128 + d]) * bf2f(kr[d]);
        lg[wl][m] = a; mx = fmaxf(mx, a);
    }
    mx = wave_max(mx);
    float sum = 0.f;
#pragma unroll
    for (int i = 0; i < 4; ++i) { const int m = lane + 64 * i; const float p = exp2f(lg[wl][m] - mx); lg[wl][m] = p; sum += p; }
    sum = wave_sum(sum);
    __syncthreads();
    float o0 = 0.f, o1 = 0.f;
    for (int m = 0; m < MEMLEN; ++m) {
        const bf16* vr = memkv + (size_t)(b * MEMLEN + m) * 1024 + 512 + h * 128;
        const float p = lg[wl][m]; o0 += p * bf2f(vr[lane]); o1 += p * bf2f(vr[lane + 64]);
    }
    __syncthreads();
    mix[(size_t)t * 2048 + 1536 + h * 128 + lane] = f2bf(o0 / sum);
    mix[(size_t)t * 2048 + 1536 + h * 128 + lane + 64] = f2bf(o1 / sum);
}

__global__ void k_post_norm(const float* __restrict__ xin, const float* __restrict__ y, const float* __restrict__ g1, float* x1, const float* __restrict__ g2, bf16* h2) {
    const int lane = threadIdx.x & 63, w = (blockIdx.x * blockDim.x + threadIdx.x) >> 6;
    if (w >= T) return;
    const float4* yr = (const float4*)(y + (size_t)w * DM); const float4* xr = (const float4*)(xin + (size_t)w * DM);
    float4 v[4]; float s = 0.f;
#pragma unroll
    for (int j = 0; j < 4; ++j) { v[j] = yr[lane + 64 * j]; s += v[j].x * v[j].x + v[j].y * v[j].y + v[j].z * v[j].z + v[j].w * v[j].w; }
    const float r = rsqrtf(wave_sum(s) * (1.f / DM) + EPS);
    float s2 = 0.f;
#pragma unroll
    for (int j = 0; j < 4; ++j) {
        const float4 gg = ((const float4*)g1)[lane + 64 * j]; const float4 xx = xr[lane + 64 * j];
        v[j].x = xx.x + v[j].x * r * gg.x; v[j].y = xx.y + v[j].y * r * gg.y; v[j].z = xx.z + v[j].z * r * gg.z; v[j].w = xx.w + v[j].w * r * gg.w;
        ((float4*)(x1 + (size_t)w * DM))[lane + 64 * j] = v[j];
        s2 += v[j].x * v[j].x + v[j].y * v[j].y + v[j].z * v[j].z + v[j].w * v[j].w;
    }
    if (h2) {
        const float r2 = rsqrtf(wave_sum(s2) * (1.f / DM) + EPS);
#pragma unroll
        for (int j = 0; j < 4; ++j) {
            const float4 gg = ((const float4*)g2)[lane + 64 * j];
            bf16* o = h2 + (size_t)w * DM + (lane + 64 * j) * 4;
            o[0] = f2bf(v[j].x * r2 * gg.x); o[1] = f2bf(v[j].y * r2 * gg.y); o[2] = f2bf(v[j].z * r2 * gg.z); o[3] = f2bf(v[j].w * r2 * gg.w);
        }
    }
}

extern "C" void kernel_launch(void* const* d_in, const int* in_sizes, int n_in, void* d_out, int out_size, void* d_ws, size_t ws_size, hipStream_t stream) {
    if (n_in != 21 || out_size != T * DM || ws_size < WS_NEED) { fprintf(stderr, "kernel_launch: unexpected shapes (n_in %d out %d ws %zu)\n", n_in, out_size, ws_size); return; }
    const float* x = (const float*)d_in[0]; const float* mem = (const float*)d_in[1];
    const float *ln_mix_pre = (const float*)d_in[2], *ln_mix_post = (const float*)d_in[3], *ln_ffn_pre = (const float*)d_in[4], *ln_ffn_post = (const float*)d_in[5], *ln_mem = (const float*)d_in[6];
    const float* w_in = (const float*)d_in[7]; const float *ln_v_gain = (const float*)d_in[8], *ln_v_bias = (const float*)d_in[9];
    const float *w_spatial = (const float*)d_in[10], *b_spatial = (const float*)d_in[11], *rel_bias = (const float*)d_in[12];
    const float *w_mem_kv = (const float*)d_in[13], *w_ba = (const float*)d_in[14], *w_bb = (const float*)d_in[15], *w_bc = (const float*)d_in[16], *w_out = (const float*)d_in[17];
    const float *w_g = (const float*)d_in[18], *w_u = (const float*)d_in[19], *w_d = (const float*)d_in[20];
    unsigned char* ws = (unsigned char*)d_ws; unsigned char* dob = (unsigned char*)d_out;
    bf16* H = (bf16*)(dob + DO_H); bf16* MERGED = H; bf16* MEMN = (bf16*)(dob + DO_MEMN);
    bf16 *WCAT = (bf16*)(dob + DO_WCAT), *WOUT = (bf16*)(dob + DO_WOUT), *WGU = (bf16*)(dob + DO_WGU), *WD = (bf16*)(dob + DO_WD);
    bf16 *WIN = (bf16*)(ws + WS_WIN), *WKV = (bf16*)(ws + WS_WKV), *MEMKV = (bf16*)(ws + WS_MEMKV), *MIX = (bf16*)(ws + WS_MIX);
    bf16 *GV = (bf16*)(ws + WS_GV), *KB = (bf16*)(ws + WS_KB), *VB = (bf16*)(ws + WS_VB), *GATES = (bf16*)(ws + WS_GATES);
    float *KMEAN = (float*)(ws + WS_KMEAN), *STATS = (float*)(ws + WS_STATS);
    float *Y = (float*)(ws + WS_Y), *F = (float*)(ws + WS_F), *X1 = (float*)(ws + WS_X1); bf16 *HID = (bf16*)(ws + WS_HID), *H2 = (bf16*)(ws + WS_H2);

    k_wt<<<2048, 256, 0, stream>>>(w_in, 1024, INW, WIN, 1024, 0, 0);
    k_wt<<<1024, 256, 0, stream>>>(w_mem_kv, 1024, 1024, WKV, 1024, 0, 0);
    k_wt<<<1024, 256, 0, stream>>>(w_ba, 768, 1024, WCAT, 2048, 0, 0);
    k_wt<<<1024, 256, 0, stream>>>(w_bb, 768, 1024, WCAT, 2048, 768, 0);
    k_wt<<<1024, 256, 0, stream>>>(w_bc, 512, 1024, WCAT, 2048, 1536, 0);
    k_wt<<<1024, 256, 0, stream>>>(w_out, 1024, 1024, WOUT, 1024, 0, 0);
    k_wt<<<2048, 256, 0, stream>>>(w_g, 1024, DFF, WGU, 1024, 0, 1);
    k_wt<<<2048, 256, 0, stream>>>(w_u, 1024, DFF, WGU, 1024, 0, 2);
    k_wt<<<2048, 256, 0, stream>>>(w_d, DFF, 1024, WD, DFF, 0, 0);
    k_rmsnorm_bf16<<<T / 4, 256, 0, stream>>>(x, ln_mix_pre, H, T);
    k_rmsnorm_bf16<<<TM / 4, 256, 0, stream>>>(mem, ln_mem, MEMN, TM);
    k_gemm_naive<EpiProj><<<dim3(INW / 64, T / 64), 256, 0, stream>>>(H, WIN, T, INW, 1024, EpiProj{MIX, GV, KB, VB, GATES});
    k_gemm_naive<EpiBf16Store><<<dim3(1024 / 64, TM / 64), 256, 0, stream>>>(MEMN, WKV, TM, 1024, 1024, EpiBf16Store{MEMKV, 1024});
    k_gv_stats<<<T / 4, 256, 0, stream>>>(GV, STATS);
    k_gmlp_naive<<<(T * 768) / 256, 256, 0, stream>>>(GV, STATS, ln_v_gain, ln_v_bias, w_spatial, b_spatial, MIX);
    k_kmean<<<(BATCH * NBLK * 768) / 256, 256, 0, stream>>>(KB, KMEAN);
    k_moba_naive<<<(BATCH * NH * SEQ) / 4, 256, 0, stream>>>(MIX, KB, VB, KMEAN, rel_bias);
    k_memattn_naive<<<(BATCH * MH * SEQ) / 4, 256, 0, stream>>>(MIX, MEMKV);
    k_merge_naive<<<dim3(1024 / 64, T / 64), 256, 0, stream>>>(MIX, WCAT, GATES, MERGED);
    k_gemm_naive<EpiF32Store><<<dim3(1024 / 64, T / 64), 256, 0, stream>>>(MERGED, WOUT, T, 1024, 1024, EpiF32Store{Y, 1024});
    k_post_norm<<<T / 4, 256, 0, stream>>>(x, Y, ln_mix_post, X1, ln_ffn_pre, H2);
    k_ffn_up_naive<<<dim3(DFF / 64, T / 64), 256, 0, stream>>>(H2, WGU, HID);
    k_gemm_naive<EpiF32Store><<<dim3(1024 / 64, T / 64), 256, 0, stream>>>(HID, WD, T, 1024, DFF, EpiF32Store{F, 1024});
    k_post_norm<<<T / 4, 256, 0, stream>>>(X1, F, ln_ffn_post, (float*)d_out, nullptr, nullptr);
}
```

```cpp
#include <hip/hip_runtime.h>
#include <hip/hip_cooperative_groups.h>
#include <cstdio>
#include <cstdint>
namespace cg = cooperative_groups;

typedef unsigned short bf16;
typedef unsigned v4u __attribute__((ext_vector_type(4)));
typedef float f32x4 __attribute__((ext_vector_type(4)));
#define LAS __attribute__((address_space(3)))
#define GAS __attribute__((address_space(1)))

constexpr int BATCH = 16, SEQ = 2048, DM = 1024, T = BATCH * SEQ;
constexpr int MEMLEN = 256, TM = BATCH * MEMLEN;
constexpr int CHUNK = 128;
constexpr int NH = 12, MBLK = 256, NBLK = SEQ / MBLK;
constexpr int MH = 4;
constexpr int DFF = 2816, INW = 7424;
constexpr float EPS = 1e-6f;
constexpr float LOG2E = 1.4426950408889634f;
constexpr float C2Q = 0.125f * LOG2E;
constexpr float C2M = 0.08838834764831845f * LOG2E;

constexpr size_t MiB = 1u << 20;
constexpr size_t DO_H = 0;
constexpr size_t DO_MEMN = 64 * MiB;
constexpr size_t DO_WCAT = 72 * MiB;
constexpr size_t DO_WOUT = 76 * MiB;
constexpr size_t DO_WGU = 78 * MiB;
constexpr size_t DO_WD = 89 * MiB;
constexpr size_t WS_CTL = 0;
constexpr size_t WS_KMEAN = 256 * 1024;
constexpr size_t WS_WIN = 1 * MiB;
constexpr size_t WS_WKV = 16 * MiB;
constexpr size_t WS_MEMKV = 18 * MiB;
constexpr size_t WS_MIX = 26 * MiB;
constexpr size_t WS_GV = 154 * MiB;
constexpr size_t WS_KB = 202 * MiB;
constexpr size_t WS_VB = 250 * MiB;
constexpr size_t WS_GATES = 298 * MiB;
constexpr size_t WS_Y = 26 * MiB;
constexpr size_t WS_HID = 26 * MiB;
constexpr size_t WS_F = 202 * MiB;
constexpr size_t WS_H2 = 320 * MiB;
constexpr size_t WS_X1 = 384 * MiB;
constexpr size_t WS_NEED = 512 * MiB;

__device__ __forceinline__ float bf2f(bf16 v) { return __uint_as_float((unsigned)v << 16); }
__device__ __forceinline__ unsigned f2bf(float f) { unsigned u = __float_as_uint(f); return (u + 0x7fffu + ((u >> 16) & 1u)) >> 16; }
__device__ __forceinline__ unsigned pk2(float lo, float hi) { return f2bf(lo) | (f2bf(hi) << 16); }
__device__ __forceinline__ float wave_sum(float v) {
#pragma unroll
    for (int o = 1; o < 64; o <<= 1) v += __shfl_xor(v, o);
    return v;
}
__device__ __forceinline__ float wave_max(float v) {
#pragma unroll
    for (int o = 1; o < 64; o <<= 1) v = fmaxf(v, __shfl_xor(v, o));
    return v;
}
__device__ __forceinline__ float fast_sigmoid(float x) { return __builtin_amdgcn_rcpf(1.0f + __builtin_amdgcn_exp2f(-LOG2E * x)); }
__device__ __forceinline__ float gelu_tanh(float x) {
    const float u = 0.7978845608028654f * (x + 0.044715f * x * x * x);
    return x * __builtin_amdgcn_rcpf(1.0f + __builtin_amdgcn_exp2f(-2.0f * LOG2E * u));
}
__device__ __forceinline__ int t5_bucket(int n) {
    if (n < 16) return n;
    int large = 16 + (int)(logf((float)n / 16.0f) / 2.0794415416798357f * 16.0f);
    return large < 31 ? large : 31;
}
namespace pg8 {
#define PG8_LAS __attribute__((address_space(3)))
typedef unsigned short bf16_t;
typedef short bf16x8 __attribute__((ext_vector_type(8)));
typedef float f32x4 __attribute__((ext_vector_type(4)));
typedef unsigned u32x4 __attribute__((ext_vector_type(4)));
constexpr int BM = 256, BK = 64, HALF = 128, HTB = HALF * BK * 2  , STAGE_BYTES = 8 * HTB, NXCD = 8, WGM = 8;

__host__ __device__ __forceinline__ int lds_byte(int r, int c) { const int st = (r >> 4) * 2 + (c >> 5), rr = r & 15, cc = c & 31, ob = rr * 64 + cc * 2; return st * 1024 + (ob ^ (((ob >> 9) & 1) << 5)); }
__host__ __device__ __forceinline__ void stage_rc(int b, int& R, int& C) { const int st = b / 1024, sb = b % 1024, swz = sb ^ (((sb >> 9) & 1) << 5); R = (st >> 1) * 16 + swz / 64; C = (st & 1) * 32 + (swz % 64) / 2; }
__host__ __device__ __forceinline__ int perm32(int rho) { const int n = rho >> 4, i = rho & 15; return 8 * (i >> 2) + 4 * n + (i & 3); }

struct Unit { int pm, pn; };
struct Gemm { const bf16_t* A; const bf16_t* Bt; int M, N, K; };

struct StaticOrder {
    int nM, nN, nwg, G, c;
    __host__ __device__ void init(int M, int N, int G_, int c_) { nM = M / BM; nN = N / BM; nwg = nM * nN; G = G_; c = c_; }
    __host__ __device__ bool next(int i, Unit& u) const {
        const long L = (long)i * G + c; if (L >= nwg) return false;
        int wgid = (int)L; { const int q = nwg / NXCD, r = nwg % NXCD, xcd = wgid % NXCD, off = wgid / NXCD; wgid = (xcd < r ? xcd * (q + 1) : r * (q + 1) + (xcd - r) * q) + off; }
        const int nig = WGM * nN, gid = wgid / nig, fm = gid * WGM, gsz = (nM - fm) < WGM ? (nM - fm) : WGM;
        u.pm = fm + ((wgid % nig) % gsz); u.pn = (wgid % nig) / gsz; return true;
    }
    __device__ __forceinline__ void a_ready(const Unit&) const {}
    __device__ __forceinline__ void done(const Unit&) const {}
};
#ifndef DBG_RAW
#define DBG_RAW 0
#endif
#ifndef DBG_NO_KMEAN
#define DBG_NO_KMEAN 0
#endif
typedef float f32x2_t __attribute__((ext_vector_type(2))); typedef __bf16 bf16x2_t __attribute__((ext_vector_type(2)));
__device__ __forceinline__ unsigned cvt_pk_bf16(float lo, float hi) { f32x2_t v = {lo, hi}; bf16x2_t b = __builtin_convertvector(v, bf16x2_t); return __builtin_bit_cast(unsigned, b); }

template <int ACT> __device__ __forceinline__ f32x4 act4(f32x4 v, float sc) {
    if (ACT == 0) return v * sc;
    f32x4 o;
#pragma unroll
    for (int j = 0; j < 4; ++j) o[j] = (ACT == 1) ? gelu_tanh(v[j]) : fast_sigmoid(v[j]);
    return o;
}
template <int ACT> __device__ __forceinline__ void store_tile_bf16(const f32x4 (&acc)[2][2][4][2], bf16_t* base, int ld, int row0, int col0, float sc) {
#pragma unroll
    for (int ai = 0; ai < 2; ++ai)
#pragma unroll
        for (int m = 0; m < 4; ++m) { bf16_t* rowp = base + (size_t)(row0 + ai * HALF + m * 16) * ld + col0;
#pragma unroll
            for (int bj = 0; bj < 2; ++bj) { const f32x4 v0 = act4<ACT>(acc[ai][bj][m][0], sc), v1 = act4<ACT>(acc[ai][bj][m][1], sc);
                u32x4 w; w.x = cvt_pk_bf16(v0[0], v0[1]); w.y = cvt_pk_bf16(v0[2], v0[3]); w.z = cvt_pk_bf16(v1[0], v1[1]); w.w = cvt_pk_bf16(v1[2], v1[3]);
                *(u32x4*)(rowp + bj * HALF) = w; } }
}
struct EpiProj {
    static constexpr bool PERM = true, AFTER_DRAIN = false;
    bf16_t *mix, *gv, *kb, *vb, *gates; float* kmean;
    __device__ __forceinline__ void operator()(const f32x4 (&acc)[2][2][4][2], const Unit& u, int wr, int wc, int fr, int fq) const {
        const int pn = u.pn, row0 = u.pm * BM + wr * 64 + fr, cw = wc * 32 + 8 * fq;
#if DBG_RAW
        if (pn < 3) store_tile_bf16<0>(acc, mix, 2048, row0, pn * 256 + cw, 1.f);
        else if (pn < 6) store_tile_bf16<0>(acc, gv, 768, row0, (pn - 3) * 256 + cw, 1.f);
        else if (pn < 9) store_tile_bf16<0>(acc, mix, 2048, row0, 768 + (pn - 6) * 256 + cw, 1.f);
#else
        if (pn < 3) store_tile_bf16<1>(acc, mix, 2048, row0, pn * 256 + cw, 1.f);
        else if (pn < 6) store_tile_bf16<1>(acc, gv, 768, row0, (pn - 3) * 256 + cw, 1.f);
        else if (pn < 9) store_tile_bf16<0>(acc, mix, 2048, row0, 768 + (pn - 6) * 256 + cw, C2Q);
#endif
        else if (pn < 12) {
            store_tile_bf16<0>(acc, kb, 768, row0, (pn - 9) * 256 + cw, 1.f);
#pragma unroll
            for (int bj = 0; bj < 2; ++bj)
#pragma unroll
                for (int n = 0; n < 2; ++n) { f32x4 s = (f32x4){0.f, 0.f, 0.f, 0.f};
#pragma unroll
                    for (int ai = 0; ai < 2; ++ai)
#pragma unroll
                        for (int m = 0; m < 4; ++m) s += acc[ai][bj][m][n];
#pragma unroll
                    for (int j = 0; j < 4; ++j) { float v = s[j]; v += __shfl_xor(v, 1); v += __shfl_xor(v, 2); v += __shfl_xor(v, 4); v += __shfl_xor(v, 8);
                        if (fr == 0 && !DBG_NO_KMEAN) atomicAdd(kmean + (size_t)u.pm * 768 + (pn - 9) * 256 + bj * HALF + cw + 4 * n + j, v * (1.0f / 256.0f)); } }
        }
        else if (pn < 15) store_tile_bf16<0>(acc, vb, 768, row0, (pn - 12) * 256 + cw, 1.f);
#if DBG_RAW
        else if (pn < 17) store_tile_bf16<0>(acc, mix, 2048, row0, 1536 + (pn - 15) * 256 + cw, 1.f);
        else store_tile_bf16<0>(acc, gates, 3072, row0, (pn - 17) * 256 + cw, 1.f);
#else
        else if (pn < 17) store_tile_bf16<0>(acc, mix, 2048, row0, 1536 + (pn - 15) * 256 + cw, C2M);
        else store_tile_bf16<2>(acc, gates, 3072, row0, (pn - 17) * 256 + cw, 1.f);
#endif
    }
};
struct EpiBf16Plain {
    static constexpr bool PERM = true, AFTER_DRAIN = false;
    bf16_t* O; int ld;
    __device__ __forceinline__ void operator()(const f32x4 (&acc)[2][2][4][2], const Unit& u, int wr, int wc, int fr, int fq) const {
        store_tile_bf16<0>(acc, O, ld, u.pm * BM + wr * 64 + fr, u.pn * BM + wc * 32 + 8 * fq, 1.f);
    }
};
struct EpiF32 {
    static constexpr bool PERM = false, AFTER_DRAIN = false;
    float* O; int ld;
    __device__ __forceinline__ void operator()(const f32x4 (&acc)[2][2][4][2], const Unit& u, int wr, int wc, int fr, int fq) const {
        const int row0 = u.pm * BM + wr * 64 + fr, col0 = u.pn * BM + wc * 32 + 4 * fq;
#pragma unroll
        for (int ai = 0; ai < 2; ++ai)
#pragma unroll
            for (int m = 0; m < 4; ++m) { float* rowp = O + (size_t)(row0 + ai * HALF + m * 16) * ld + col0;
#pragma unroll
                for (int bj = 0; bj < 2; ++bj)
#pragma unroll
                    for (int n = 0; n < 2; ++n) *(f32x4*)(rowp + bj * HALF + n * 16) = acc[ai][bj][m][n]; }
    }
};
struct EpiSwiGLU {
    static constexpr bool PERM = true, AFTER_DRAIN = false;
    bf16_t* O; int ld;
    __device__ __forceinline__ void operator()(const f32x4 (&acc)[2][2][4][2], const Unit& u, int wr, int wc, int fr, int fq) const {
        const int row0 = u.pm * BM + wr * 64 + fr, col0 = u.pn * HALF + wc * 32 + 8 * fq;
#pragma unroll
        for (int ai = 0; ai < 2; ++ai)
#pragma unroll
            for (int m = 0; m < 4; ++m) { f32x4 h[2];
#pragma unroll
                for (int n = 0; n < 2; ++n)
#pragma unroll
                    for (int j = 0; j < 4; ++j) { const float g = acc[ai][0][m][n][j]; h[n][j] = g * fast_sigmoid(g) * acc[ai][1][m][n][j]; }
                u32x4 w; w.x = cvt_pk_bf16(h[0][0], h[0][1]); w.y = cvt_pk_bf16(h[0][2], h[0][3]); w.z = cvt_pk_bf16(h[1][0], h[1][1]); w.w = cvt_pk_bf16(h[1][2], h[1][3]);
                *(u32x4*)(O + (size_t)(row0 + ai * HALF + m * 16) * ld + col0) = w; }
    }
};
struct EpiMerge {
    static constexpr bool PERM = true, AFTER_DRAIN = false;
    const bf16_t* gates; bf16_t* O;
    __device__ __forceinline__ bool want_mid(int t) const { return t == 12 || t == 24; }
    __device__ __forceinline__ void mid(f32x4 (&acc)[2][2][4][2], const Unit& u, int t, int wr, int wc, int fr, int fq) const {
        const int seg = (t == 12) ? 0 : 1;
        int row0 = u.pm * BM + wr * 64 + fr; asm volatile("" : "+v"(row0));
        const int col0 = u.pn * BM + wc * 32 + 8 * fq;
#pragma unroll
        for (int ai = 0; ai < 2; ++ai)
#pragma unroll
            for (int m = 0; m < 4; ++m) { const bf16_t* gp = gates + (size_t)(row0 + ai * HALF + m * 16) * 3072 + seg * 1024 + col0;
#pragma unroll
                for (int bj = 0; bj < 2; ++bj) { const u32x4 ga = *(const u32x4*)(gp + bj * HALF), gb = *(const u32x4*)(gp + 1024 + bj * HALF);
#pragma unroll
                    for (int e = 0; e < 8; ++e) { const unsigned wa = ga[e >> 1], wb = gb[e >> 1];
                        const float a = __uint_as_float((e & 1) ? (wa & 0xffff0000u) : (wa << 16)), b = __uint_as_float((e & 1) ? (wb & 0xffff0000u) : (wb << 16));
                        acc[ai][bj][m][e >> 2][e & 3] *= a * __builtin_amdgcn_rcpf(b); } } }
    }
    __device__ __forceinline__ void operator()(const f32x4 (&acc)[2][2][4][2], const Unit& u, int wr, int wc, int fr, int fq) const {
        int row0 = u.pm * BM + wr * 64 + fr; asm volatile("" : "+v"(row0));
        const int col0 = u.pn * BM + wc * 32 + 8 * fq;
#pragma unroll
        for (int ai = 0; ai < 2; ++ai)
#pragma unroll
            for (int m = 0; m < 4; ++m) { const size_t r = (size_t)(row0 + ai * HALF + m * 16);
#pragma unroll
                for (int bj = 0; bj < 2; ++bj) { const u32x4 ga = *(const u32x4*)(gates + r * 3072 + 2048 + col0 + bj * HALF); float o[8];
#pragma unroll
                    for (int e = 0; e < 8; ++e) { const unsigned wa = ga[e >> 1]; o[e] = acc[ai][bj][m][e >> 2][e & 3] * __uint_as_float((e & 1) ? (wa & 0xffff0000u) : (wa << 16)); }
                    u32x4 w; w.x = cvt_pk_bf16(o[0], o[1]); w.y = cvt_pk_bf16(o[2], o[3]); w.z = cvt_pk_bf16(o[4], o[5]); w.w = cvt_pk_bf16(o[6], o[7]);
                    *(u32x4*)(O + r * 1024 + col0 + bj * HALF) = w; } }
    }
};
template <class Epi, class Sched, bool ALIGN_EPI = false, bool SP2 = false, bool MID = false>
__device__ __forceinline__ void gemm_phase(PG8_LAS unsigned char* lds, const Gemm g, const Sched& S, const Epi& E, int wave_id) {
    int tid_ = wave_id * 64 + (int)__builtin_amdgcn_mbcnt_hi(~0u, __builtin_amdgcn_mbcnt_lo(~0u, 0u)); asm volatile("" : "+v"(tid_));
    const int tid = tid_, wid = __builtin_amdgcn_readfirstlane(tid >> 6), lane = tid & 63, wr = wid >> 2, wc = wid & 3, fr = lane & 15, fq = lane >> 4;
    const int K = g.K, nt = K / BK;
    unsigned voffA[2], voffB[2];
#pragma unroll
    for (int i = 0; i < 2; ++i) { int R, C; stage_rc(tid * 16 + i * 8192, R, C); const int Rb = Epi::PERM ? ((R & ~31) + perm32(R & 31)) : R;
        voffA[i] = (unsigned)(R * K + C) * 2u; voffB[i] = (unsigned)(Rb * K + C) * 2u; }
    const size_t kstep = (size_t)(BK * 2);
    const size_t hstep = (size_t)HALF * K * 2;
    const size_t tstep = 2 * hstep;
    const unsigned ldsw = (unsigned)wid * 1024u;
    const int aoff = lds_byte(wr * 64 + fr, fq * 8), boff = lds_byte(wc * 32 + fr, fq * 8);
#define PG8_SA(b, h) (((b) * 2 + (h)) * HTB)
#define PG8_SB(b, h) ((4 + (b) * 2 + (h)) * HTB)
#define PG8_STAGE(bufoff, gbase, voff) do { _Pragma("unroll") for (int _i = 0; _i < 2; ++_i) \
        __builtin_amdgcn_global_load_lds((const unsigned*)((const char*)(gbase) + (voff)[_i]), (PG8_LAS unsigned*)(lds + (bufoff) + ldsw + _i * 8192), 16, 0, 0); } while (0)
#define PG8_LDA(dst, b, h) do { _Pragma("unroll") for (int m = 0; m < 4; ++m) _Pragma("unroll") for (int k = 0; k < 2; ++k) dst[m][k] = *(const PG8_LAS bf16x8*)(lds + PG8_SA(b, h) + aoff + m * 2048 + k * 1024); } while (0)
#define PG8_LDB(dst, b, h) do { _Pragma("unroll") for (int n = 0; n < 2; ++n) _Pragma("unroll") for (int k = 0; k < 2; ++k) dst[n][k] = *(const PG8_LAS bf16x8*)(lds + PG8_SB(b, h) + boff + n * 2048 + k * 1024); } while (0)
#define PG8_MMA(ai, bj, At, Bt) do { __builtin_amdgcn_s_setprio(1); _Pragma("unroll") for (int m = 0; m < 4; ++m) _Pragma("unroll") for (int n = 0; n < 2; ++n) _Pragma("unroll") for (int k = 0; k < 2; ++k) \
        acc[ai][bj][m][n] = __builtin_amdgcn_mfma_f32_16x16x32_bf16(Bt[n][k], At[m][k], acc[ai][bj][m][n], 0, 0, 0); __builtin_amdgcn_s_setprio(0); } while (0)
#define PG8_WAIT_V(n) asm volatile("s_waitcnt vmcnt(" #n ")" ::: "memory")
#define PG8_WAIT_L(n) asm volatile("s_waitcnt lgkmcnt(" #n ")" ::: "memory")
#define PG8_BAR __builtin_amdgcn_s_barrier()
#define PG8_SCHED __builtin_amdgcn_sched_barrier(0)
    Unit cur, nxt; int ui = 0;
    if (!S.next(0, cur)) return;
    f32x4 acc[2][2][4][2];
#pragma unroll
    for (int a = 0; a < 2; ++a)
#pragma unroll
        for (int b = 0; b < 2; ++b)
#pragma unroll
            for (int m = 0; m < 4; ++m)
#pragma unroll
                for (int n = 0; n < 2; ++n) acc[a][b][m][n] = (f32x4){0.f, 0.f, 0.f, 0.f};
    bf16x8 At[4][2], B0[2][2], B1[2][2];
    const char* cA = (const char*)g.A + (size_t)cur.pm * tstep; const char* cB = (const char*)g.Bt + (size_t)cur.pn * tstep;
    S.a_ready(cur);
    if constexpr (SP2) {
        PG8_STAGE(PG8_SB(0, 0), cB, voffB); PG8_STAGE(PG8_SB(0, 1), cB + hstep, voffB); PG8_STAGE(PG8_SA(0, 0), cA, voffA); PG8_STAGE(PG8_SA(0, 1), cA + hstep, voffA);
        if (wr == 1) PG8_BAR;
        PG8_WAIT_V(2); PG8_BAR;
        PG8_STAGE(PG8_SB(1, 0), cB + kstep, voffB); PG8_STAGE(PG8_SA(1, 0), cA + kstep, voffA); PG8_STAGE(PG8_SB(1, 1), cB + hstep + kstep, voffB);
        PG8_WAIT_V(6); PG8_BAR;
    } else {
        PG8_STAGE(PG8_SB(0, 0), cB, voffB); PG8_STAGE(PG8_SA(0, 0), cA, voffA); PG8_STAGE(PG8_SB(0, 1), cB + hstep, voffB); PG8_STAGE(PG8_SA(0, 1), cA + hstep, voffA);
        if (wr == 1) PG8_BAR;
        PG8_WAIT_V(4); PG8_BAR;
        PG8_STAGE(PG8_SB(1, 0), cB + kstep, voffB); PG8_STAGE(PG8_SA(1, 0), cA + kstep, voffA); PG8_STAGE(PG8_SB(1, 1), cB + hstep + kstep, voffB);
        PG8_WAIT_V(6); PG8_BAR;
    }
    for (;;) {
        const bool has_next = S.next(ui + 1, nxt);
        const char* nA = has_next ? (const char*)g.A + (size_t)nxt.pm * tstep : cA; const char* nB = has_next ? (const char*)g.Bt + (size_t)nxt.pn * tstep : cB;
        for (int t = 0; t < nt; t += 2) {
            const bool last = (t == nt - 2);
            const char* a1 = cA + (size_t)(t + 1) * kstep;
            const char* a2 = last ? nA : cA + (size_t)(t + 2) * kstep; const char* b2 = last ? nB : cB + (size_t)(t + 2) * kstep;
            const char* a3 = a2 + kstep; const char* b3 = b2 + kstep;
            if (last && has_next) S.a_ready(nxt);
            if constexpr (SP2) {
            PG8_LDB(B0, 0, 0); PG8_LDB(B1, 0, 1); PG8_SCHED; PG8_LDA(At, 0, 0); PG8_STAGE(PG8_SA(1, 1), a1 + hstep, voffA);
            PG8_WAIT_V(8); PG8_WAIT_L(0); PG8_BAR; PG8_MMA(0, 0, At, B0); PG8_MMA(0, 1, At, B1); PG8_BAR; PG8_SCHED;
            PG8_LDA(At, 0, 1); PG8_STAGE(PG8_SB(0, 0), b2, voffB); PG8_STAGE(PG8_SB(0, 1), b2 + hstep, voffB); PG8_STAGE(PG8_SA(0, 0), a2, voffA);
            PG8_WAIT_V(8); PG8_WAIT_L(0); PG8_BAR; PG8_MMA(1, 0, At, B0); PG8_MMA(1, 1, At, B1); PG8_BAR; PG8_SCHED;
            PG8_LDB(B0, 1, 0); PG8_LDB(B1, 1, 1); PG8_SCHED; PG8_LDA(At, 1, 0); PG8_STAGE(PG8_SA(0, 1), a2 + hstep, voffA);
            PG8_WAIT_V(8); PG8_WAIT_L(0); PG8_BAR; PG8_MMA(0, 0, At, B0); PG8_MMA(0, 1, At, B1); PG8_BAR; PG8_SCHED;
            PG8_LDA(At, 1, 1); PG8_STAGE(PG8_SB(1, 0), b3, voffB); PG8_STAGE(PG8_SB(1, 1), b3 + hstep, voffB); PG8_STAGE(PG8_SA(1, 0), a3, voffA);
            PG8_WAIT_V(8); PG8_WAIT_L(0); PG8_BAR; PG8_MMA(1, 0, At, B0); PG8_MMA(1, 1, At, B1); PG8_BAR; PG8_SCHED;
            } else {
            PG8_LDB(B0, 0, 0); PG8_SCHED; PG8_LDA(At, 0, 0); PG8_STAGE(PG8_SA(1, 1), a1 + hstep, voffA);
            PG8_WAIT_L(8); PG8_BAR; PG8_WAIT_L(0); PG8_MMA(0, 0, At, B0); PG8_BAR; PG8_SCHED;
            PG8_LDB(B1, 0, 1); PG8_STAGE(PG8_SB(0, 0), b2, voffB);
            PG8_BAR; PG8_WAIT_L(0); PG8_MMA(0, 1, At, B1); PG8_BAR;
            PG8_LDA(At, 0, 1); PG8_STAGE(PG8_SA(0, 0), a2, voffA);
            PG8_BAR; PG8_WAIT_L(0); PG8_MMA(1, 0, At, B0); PG8_BAR; PG8_SCHED;
            PG8_STAGE(PG8_SB(0, 1), b2 + hstep, voffB);
            PG8_WAIT_V(6); PG8_BAR; PG8_MMA(1, 1, At, B1); PG8_BAR;
            PG8_LDB(B0, 1, 0); PG8_SCHED; PG8_LDA(At, 1, 0); PG8_STAGE(PG8_SA(0, 1), a2 + hstep, voffA);
            PG8_WAIT_L(8); PG8_BAR; PG8_WAIT_L(0); PG8_MMA(0, 0, At, B0); PG8_BAR; PG8_SCHED;
            PG8_LDB(B1, 1, 1); PG8_STAGE(PG8_SB(1, 0), b3, voffB);
            PG8_BAR; PG8_WAIT_L(0); PG8_MMA(0, 1, At, B1); PG8_BAR;
            PG8_LDA(At, 1, 1); PG8_STAGE(PG8_SA(1, 0), a3, voffA);
            PG8_BAR; PG8_WAIT_L(0); PG8_MMA(1, 0, At, B0); PG8_BAR; PG8_SCHED;
            PG8_STAGE(PG8_SB(1, 1), b3 + hstep, voffB);
            PG8_WAIT_V(6); PG8_BAR; PG8_MMA(1, 1, At, B1); PG8_BAR;
            }
            if constexpr (MID) { if (E.want_mid(t + 2)) E.mid(acc, cur, t + 2, wr, wc, fr, fq); }
        }
        if constexpr (ALIGN_EPI) { if (wr == 0) PG8_BAR; }
        if constexpr (!Epi::AFTER_DRAIN) { E(acc, cur, wr, wc, fr, fq); S.done(cur); }
        if (!has_next) break;
#pragma unroll
        for (int a = 0; a < 2; ++a)
#pragma unroll
            for (int b = 0; b < 2; ++b)
#pragma unroll
                for (int m = 0; m < 4; ++m)
#pragma unroll
                    for (int n = 0; n < 2; ++n) acc[a][b][m][n] = (f32x4){0.f, 0.f, 0.f, 0.f};
        cur = nxt; cA = nA; cB = nB; ++ui;
        if constexpr (ALIGN_EPI) { if (wr == 1) PG8_BAR; }
    }
    PG8_WAIT_V(0);
    if constexpr (!ALIGN_EPI) { if (wr == 0) PG8_BAR; }
    PG8_BAR;
    if constexpr (Epi::AFTER_DRAIN) { E.fused(acc, cur, wr, wc, fr, fq, lds, wid, lane); S.done(cur); }
#undef PG8_SA
#undef PG8_SB
#undef PG8_STAGE
#undef PG8_LDA
#undef PG8_LDB
#undef PG8_MMA
#undef PG8_WAIT_V
#undef PG8_WAIT_L
#undef PG8_BAR
#undef PG8_SCHED
}
}
#ifndef DBG_P1
#define DBG_P1 3
#endif
constexpr int NWAVES = 8;
constexpr int RING_BYTES = 131072;
constexpr int LDS_BYTES = 147456;

struct Args { const float* in[21]; float* out; unsigned char* ws; int ph_lo, ph_hi; };

__device__ __forceinline__ int opq(int v) { asm volatile("" : "+v"(v)); return v; }
__device__ __forceinline__ int lane_id() { return (int)__builtin_amdgcn_mbcnt_hi(~0u, __builtin_amdgcn_mbcnt_lo(~0u, 0u)); }
struct Frame {
    LAS unsigned char* lds;
    int wave, vcu, G;
};

__device__ __forceinline__ void p0_transpose_item(const float* W, int K, int N, bf16* WT, int ldt, int col_off, int mode, LAS float* scr, int item, int lane) {
    const int nblk = N / 32, kb = item / nblk, nb = item % nblk, k0 = 64 * kb, n0 = 32 * nb;
#pragma unroll 8
    for (int i = 0; i < 32; ++i) { const int kk = 2 * i + (lane >> 5); scr[kk * 33 + (lane & 31)] = W[(size_t)(k0 + kk) * N + n0 + (lane & 31)]; }
    asm volatile("s_waitcnt lgkmcnt(0)" ::: "memory");
    const int c = lane & 7;
    const int rbase = mode ? ((n0 / 128) * 256 + (n0 % 128) + (mode == 2 ? 128 : 0)) : n0;
#pragma unroll
    for (int j = 0; j < 4; ++j) { const int n = (lane >> 3) + 8 * j; const LAS float* s = scr + (8 * c) * 33 + n;
        v4u o; o.x = pk2(s[0 * 33], s[1 * 33]); o.y = pk2(s[2 * 33], s[3 * 33]); o.z = pk2(s[4 * 33], s[5 * 33]); o.w = pk2(s[6 * 33], s[7 * 33]);
        *(v4u*)(WT + (size_t)(rbase + n) * ldt + col_off + k0 + 8 * c) = o; }
    asm volatile("s_waitcnt lgkmcnt(0)" ::: "memory");
}
__device__ __forceinline__ void rms_row_bf16(const float* xrow, const float* g, bf16* orow, int lane_) {
    const int lane = opq(lane_);
    const f32x4* xr = (const f32x4*)xrow + lane;
    f32x4 v[4]; float s = 0.f;
#pragma unroll
    for (int j = 0; j < 4; ++j) { v[j] = xr[64 * j]; s += (v[j].x * v[j].x + v[j].y * v[j].y) + (v[j].z * v[j].z + v[j].w * v[j].w); }
    const float r = rsqrtf(wave_sum(s) * (1.f / DM) + EPS);
    unsigned long long* o8 = (unsigned long long*)orow + lane;
#pragma unroll
    for (int j = 0; j < 4; ++j) { const f32x4 gg = ((const f32x4*)g)[lane + 64 * j];
        o8[64 * j] = (unsigned long long)pk2(v[j].x * r * gg.x, v[j].y * r * gg.y) | ((unsigned long long)pk2(v[j].z * r * gg.z, v[j].w * r * gg.w) << 32); }
}
__device__ __forceinline__ void post_norm_row(const float* xin, const float* y, const float* g1, float* x1out, const float* g2, bf16* h2, int lane_) {
    const int lane = opq(lane_);
    const f32x4* yr = (const f32x4*)y + lane; const f32x4* xr = (const f32x4*)xin + lane;
    f32x4 v[4]; float s = 0.f;
#pragma unroll
    for (int j = 0; j < 4; ++j) { v[j] = yr[64 * j]; s += (v[j].x * v[j].x + v[j].y * v[j].y) + (v[j].z * v[j].z + v[j].w * v[j].w); }
    const float r = rsqrtf(wave_sum(s) * (1.f / DM) + EPS);
    float s2 = 0.f;
#pragma unroll
    for (int j = 0; j < 4; ++j) { const f32x4 gg = ((const f32x4*)g1)[lane + 64 * j]; const f32x4 xx = xr[64 * j];
        v[j] = xx + v[j] * r * gg; ((f32x4*)x1out)[lane + 64 * j] = v[j];
        s2 += (v[j].x * v[j].x + v[j].y * v[j].y) + (v[j].z * v[j].z + v[j].w * v[j].w); }
    if (h2) {
        const float r2 = rsqrtf(wave_sum(s2) * (1.f / DM) + EPS);
        unsigned long long* o8 = (unsigned long long*)h2 + lane;
#pragma unroll
        for (int j = 0; j < 4; ++j) { const f32x4 gg = ((const f32x4*)g2)[lane + 64 * j];
            o8[64 * j] = (unsigned long long)pk2(v[j].x * r2 * gg.x, v[j].y * r2 * gg.y) | ((unsigned long long)pk2(v[j].z * r2 * gg.z, v[j].w * r2 * gg.w) << 32); }
    }
}

__device__ __forceinline__ void gmlp_body(Frame& F, const bf16* gv, const float* gain, const float* bias, const float* wsp, const float* bsp, bf16* mix) {
    LAS float* stats = (LAS float*)F.lds;
    LAS float* vn = (LAS float*)(F.lds + 1024);
    LAS float* wl = (LAS float*)(F.lds + 1024 + 65536);
    const int lane = opq(lane_id()), tid = F.wave * 64 + lane;
    for (int chunk = F.vcu; chunk < T / CHUNK; chunk += F.G) {
        const int base = chunk * CHUNK;
        for (int r = F.wave; r < CHUNK; r += NWAVES) {
            float v[12]; float s = 0.f;
#pragma unroll
            for (int j = 0; j < 12; ++j) { v[j] = bf2f(gv[(size_t)(base + r) * 768 + lane + 64 * j]); s += v[j]; }
            const float mu = wave_sum(s) * (1.f / 768.f); float q = 0.f;
#pragma unroll
            for (int j = 0; j < 12; ++j) { const float d = v[j] - mu; q += d * d; }
            const float rstd = rsqrtf(wave_sum(q) * (1.f / 768.f) + EPS);
            if (lane == 0) { stats[2 * r] = mu; stats[2 * r + 1] = rstd; }
        }
        __syncthreads();
        for (int g = 0; g < 6; ++g) {
            for (int i = tid; i < CHUNK * 128; i += NWAVES * 64) { const int s = i >> 7, d = i & 127, ch = g * 128 + d;
                vn[i] = (bf2f(gv[(size_t)(base + s) * 768 + ch]) - stats[2 * s]) * stats[2 * s + 1] * gain[ch] + bias[ch];
                wl[i] = wsp[(size_t)g * CHUNK * CHUNK + i]; }
            __syncthreads();
            const int d = tid & 127, tq = tid >> 7;
            for (int i = 0; i < 32; ++i) { const int tl = tq + 4 * i; float a = 0.f;
                for (int s = 0; s <= tl; ++s) a += wl[tl * 128 + s] * vn[s * 128 + d];
                a += bsp[g * CHUNK + tl];
                const size_t o = (size_t)(base + tl) * 2048 + g * 128 + d;
                mix[o] = (bf16)f2bf(bf2f(mix[o]) * a); }
            __syncthreads();
        }
    }
}
__device__ __forceinline__ void moba_body(Frame& F, bf16* mix, const bf16* kb, const bf16* vb, const float* kmean, const float* relb) {
    LAS float* lg = (LAS float*)F.lds + F.wave * 1024;
    const int lane = opq(lane_id());
    for (int w = F.vcu * NWAVES + F.wave; w < BATCH * NH * SEQ; w += F.G * NWAVES) {
        const int s = w % SEQ, bh = w / SEQ, h = bh % NH, b = bh / NH;
        const int t = b * SEQ + s, cur = s / MBLK;
        float q[64];
#pragma unroll
        for (int d = 0; d < 64; ++d) q[d] = bf2f(mix[(size_t)t * 2048 + 768 + h * 64 + d]);
        float gt[8];
#pragma unroll
        for (int n = 0; n < 8; ++n) { float a = 0.f;
            if (n < cur) { const float* km = kmean + (size_t)(b * NBLK + n) * 768 + h * 64;
#pragma unroll
                for (int d = 0; d < 64; ++d) a += q[d] * km[d]; }
            gt[n] = a; }
        unsigned sel = 0;
#pragma unroll
        for (int n = 0; n < 8; ++n) if (n < cur) { int rank = 0;
#pragma unroll
            for (int m = 0; m < 8; ++m) if (m < cur && m != n) rank += (gt[m] > gt[n] || (gt[m] == gt[n] && m < n)) ? 1 : 0;
            if (rank < 3) sel |= 1u << n; }
        int nslot = 0; float mx = -INFINITY;
        for (int n = 0; n <= cur; ++n) {
            if (n < cur && !((sel >> n) & 1u)) continue;
#pragma unroll
            for (int i = 0; i < 4; ++i) { const int j = lane + 64 * i, kp = n * MBLK + j, dist = s - kp; float l = -INFINITY;
                if (dist >= 0) { const bf16* kr = kb + (size_t)(b * SEQ + kp) * 768 + h * 64; float a = 0.f;
#pragma unroll
                    for (int d = 0; d < 64; ++d) a += q[d] * bf2f(kr[d]);
                    l = a + relb[t5_bucket(dist) * NH + h] * LOG2E; }
                lg[nslot * 256 + j] = l; mx = fmaxf(mx, l); }
            ++nslot;
        }
        mx = wave_max(mx);
        float sum = 0.f; const int nk = nslot * 256;
        for (int j = lane; j < nk; j += 64) { const float p = exp2f(lg[j] - mx); lg[j] = p; sum += p; }
        sum = wave_sum(sum);
        asm volatile("s_waitcnt lgkmcnt(0)" ::: "memory");
        float o = 0.f; int slot = 0;
        for (int n = 0; n <= cur; ++n) {
            if (n < cur && !((sel >> n) & 1u)) continue;
            const int jmax = (n == cur) ? (s - cur * MBLK + 1) : MBLK;
            for (int j = 0; j < jmax; ++j) o += lg[slot * 256 + j] * bf2f(vb[(size_t)(b * SEQ + n * MBLK + j) * 768 + h * 64 + lane]);
            ++slot;
        }
        mix[(size_t)t * 2048 + 768 + h * 64 + lane] = (bf16)f2bf(o / sum);
        asm volatile("s_waitcnt lgkmcnt(0)" ::: "memory");
    }
}
__device__ __forceinline__ void memattn_body(Frame& F, bf16* mix, const bf16* memkv) {
    LAS float* lg = (LAS float*)(F.lds + 32768) + F.wave * 256;
    const int lane = opq(lane_id());
    for (int w = F.vcu * NWAVES + F.wave; w < BATCH * MH * SEQ; w += F.G * NWAVES) {
        const int s = w % SEQ, bh = w / SEQ, h = bh % MH, b = bh / MH;
        const int t = b * SEQ + s;
        float mx = -INFINITY;
#pragma unroll
        for (int i = 0; i < 4; ++i) { const int m = lane + 64 * i;
            const bf16* kr = memkv + (size_t)(b * MEMLEN + m) * 1024 + h * 128; float a = 0.f;
            for (int d = 0; d < 128; ++d) a += bf2f(mix[(size_t)t * 2048 + 1536 + h * 128 + d]) * bf2f(kr[d]);
            lg[m] = a; mx = fmaxf(mx, a); }
        mx = wave_max(mx);
        float sum = 0.f;
#pragma unroll
        for (int i = 0; i < 4; ++i) { const int m = lane + 64 * i; const float p = exp2f(lg[m] - mx); lg[m] = p; sum += p; }
        sum = wave_sum(sum);
        asm volatile("s_waitcnt lgkmcnt(0)" ::: "memory");
        float o0 = 0.f, o1 = 0.f;
        for (int m = 0; m < MEMLEN; ++m) { const bf16* vr = memkv + (size_t)(b * MEMLEN + m) * 1024 + 512 + h * 128;
            const float p = lg[m]; o0 += p * bf2f(vr[lane]); o1 += p * bf2f(vr[lane + 64]); }
        mix[(size_t)t * 2048 + 1536 + h * 128 + lane] = (bf16)f2bf(o0 / sum);
        mix[(size_t)t * 2048 + 1536 + h * 128 + lane + 64] = (bf16)f2bf(o1 / sum);
        asm volatile("s_waitcnt lgkmcnt(0)" ::: "memory");
    }
}

__global__ void __launch_bounds__(NWAVES * 64, 2) mega_fwd(Args args) {
    extern __shared__ __attribute__((aligned(16))) unsigned char lds_raw[];
    cg::grid_group grid = cg::this_grid();
    Frame F;
    F.lds = (LAS unsigned char*)lds_raw;
    F.wave = __builtin_amdgcn_readfirstlane((int)threadIdx.x >> 6);
    F.G = gridDim.x; { const int bx = blockIdx.x; F.vcu = (F.G % 8 == 0) ? (bx % 8) * (F.G / 8) + bx / 8 : bx; }
    unsigned char* ws = args.ws; unsigned char* dob = (unsigned char*)args.out;
    const float* x = args.in[0]; const float* mem = args.in[1];
    const float *ln_mix_pre = args.in[2], *ln_mix_post = args.in[3], *ln_ffn_pre = args.in[4], *ln_ffn_post = args.in[5], *ln_mem = args.in[6];
    bf16* H = (bf16*)(dob + DO_H); bf16* MERGED = H; bf16* MEMN = (bf16*)(dob + DO_MEMN);
    bf16 *WCAT = (bf16*)(dob + DO_WCAT), *WOUT = (bf16*)(dob + DO_WOUT), *WGU = (bf16*)(dob + DO_WGU), *WD = (bf16*)(dob + DO_WD);
    bf16 *WIN = (bf16*)(ws + WS_WIN), *WKV = (bf16*)(ws + WS_WKV), *MEMKV = (bf16*)(ws + WS_MEMKV), *MIX = (bf16*)(ws + WS_MIX);
    bf16 *GV = (bf16*)(ws + WS_GV), *KB = (bf16*)(ws + WS_KB), *VB = (bf16*)(ws + WS_VB), *GATES = (bf16*)(ws + WS_GATES);
    float* KMEAN = (float*)(ws + WS_KMEAN);
    float *Y = (float*)(ws + WS_Y), *FF = (float*)(ws + WS_F), *X1 = (float*)(ws + WS_X1); bf16 *HID = (bf16*)(ws + WS_HID), *H2 = (bf16*)(ws + WS_H2);
    const int gw = F.vcu * NWAVES + F.wave, NGW = F.G * NWAVES;

#define IN(k) (args.ph_lo <= (k) && (k) < args.ph_hi)
#define SEAM(k) do { if (IN(k) && IN((k) + 1)) grid.sync(); } while (0)
    if (IN(0)) {
        LAS float* scr = (LAS float*)(F.lds + F.wave * 16384);
        const int lane0 = opq(lane_id());
        constexpr int I_IN = 16 * (INW / 32), I_KV = 16 * 32, I_A = 12 * 32, I_C = 8 * 32, I_O = 16 * 32, I_G = 16 * (DFF / 32), I_D = (DFF / 64) * 32;
        constexpr int NITEMS = I_IN + I_KV + 2 * I_A + I_C + I_O + 2 * I_G + I_D;
        for (int it = gw; it < NITEMS; it += NGW) {
            int r = it;
            if (r < I_IN) { p0_transpose_item(args.in[7], 1024, INW, WIN, 1024, 0, 0, scr, r, lane0); continue; } r -= I_IN;
            if (r < I_KV) { p0_transpose_item(args.in[13], 1024, 1024, WKV, 1024, 0, 0, scr, r, lane0); continue; } r -= I_KV;
            if (r < I_A) { p0_transpose_item(args.in[14], 768, 1024, WCAT, 2048, 0, 0, scr, r, lane0); continue; } r -= I_A;
            if (r < I_A) { p0_transpose_item(args.in[15], 768, 1024, WCAT, 2048, 768, 0, scr, r, lane0); continue; } r -= I_A;
            if (r < I_C) { p0_transpose_item(args.in[16], 512, 1024, WCAT, 2048, 1536, 0, scr, r, lane0); continue; } r -= I_C;
            if (r < I_O) { p0_transpose_item(args.in[17], 1024, 1024, WOUT, 1024, 0, 0, scr, r, lane0); continue; } r -= I_O;
            if (r < I_G) { p0_transpose_item(args.in[18], 1024, DFF, WGU, 1024, 0, 1, scr, r, lane0); continue; } r -= I_G;
            if (r < I_G) { p0_transpose_item(args.in[19], 1024, DFF, WGU, 1024, 0, 2, scr, r, lane0); continue; } r -= I_G;
            p0_transpose_item(args.in[20], DFF, 1024, WD, DFF, 0, 0, scr, r, lane0);
        }
        for (int m = gw; m < T; m += NGW) rms_row_bf16(x + (size_t)m * DM, ln_mix_pre, H + (size_t)m * DM, lane0);
        for (int m = gw; m < TM; m += NGW) rms_row_bf16(mem + (size_t)m * DM, ln_mem, MEMN + (size_t)m * DM, lane0);
        for (int i = blockIdx.x * (NWAVES * 64) + F.wave * 64 + lane0; i < BATCH * NBLK * 768; i += F.G * NWAVES * 64) KMEAN[i] = 0.f;
    }
    SEAM(0);
    if (IN(1)) {
        pg8::Gemm g{H, WIN, T, INW, 1024}; pg8::StaticOrder S; S.init(T, INW, F.G, (int)blockIdx.x);
        pg8::EpiProj E{MIX, GV, KB, VB, GATES, KMEAN};
        if (DBG_P1 & 1) pg8::gemm_phase<pg8::EpiProj, pg8::StaticOrder, true, true>(F.lds, g, S, E, F.wave);
        pg8::Gemm g2{MEMN, WKV, TM, 1024, 1024}; pg8::StaticOrder S2; S2.init(TM, 1024, F.G, (int)blockIdx.x);
        pg8::EpiBf16Plain E2{MEMKV, 1024};
        if (DBG_P1 & 2) pg8::gemm_phase<pg8::EpiBf16Plain, pg8::StaticOrder, true, true>(F.lds, g2, S2, E2, F.wave);
    }
    SEAM(1);
    if (IN(2)) {
    gmlp_body(F, GV, args.in[8], args.in[9], args.in[10], args.in[11], MIX);
    moba_body(F, MIX, KB, VB, KMEAN, args.in[12]);
    memattn_body(F, MIX, MEMKV);
    }
    SEAM(2);
    if (IN(3)) {
        pg8::Gemm g{MIX, WCAT, T, 1024, 2048}; pg8::StaticOrder S; S.init(T, 1024, F.G, (int)blockIdx.x);
        pg8::EpiMerge E{GATES, MERGED};
        pg8::gemm_phase<pg8::EpiMerge, pg8::StaticOrder, true, true, true>(F.lds, g, S, E, F.wave);
    }
    SEAM(3);
    if (IN(4)) {
        pg8::Gemm g{MERGED, WOUT, T, 1024, 1024}; pg8::StaticOrder S; S.init(T, 1024, F.G, (int)blockIdx.x);
        pg8::EpiF32 E{Y, 1024};
        pg8::gemm_phase<pg8::EpiF32, pg8::StaticOrder, true, true>(F.lds, g, S, E, F.wave);
    }
    SEAM(4);
    if (IN(5)) for (int m = gw; m < T; m += NGW) post_norm_row(x + (size_t)m * DM, Y + (size_t)m * DM, ln_mix_post, X1 + (size_t)m * DM, ln_ffn_pre, H2 + (size_t)m * DM, lane_id());
    SEAM(5);
    if (IN(6)) {
        pg8::Gemm g{H2, WGU, T, 2 * DFF, 1024}; pg8::StaticOrder S; S.init(T, 2 * DFF, F.G, (int)blockIdx.x);
        pg8::EpiSwiGLU E{HID, DFF};
        pg8::gemm_phase<pg8::EpiSwiGLU, pg8::StaticOrder, true, true>(F.lds, g, S, E, F.wave);
    }
    SEAM(6);
    if (IN(7)) {
        pg8::Gemm g{HID, WD, T, 1024, DFF}; pg8::StaticOrder S; S.init(T, 1024, F.G, (int)blockIdx.x);
        pg8::EpiF32 E{FF, 1024};
        pg8::gemm_phase<pg8::EpiF32, pg8::StaticOrder, true, true>(F.lds, g, S, E, F.wave);
    }
    SEAM(7);
    if (IN(8)) for (int m = gw; m < T; m += NGW) post_norm_row(X1 + (size_t)m * DM, FF + (size_t)m * DM, ln_ffn_post, args.out + (size_t)m * DM, nullptr, nullptr, lane_id());
}

extern "C" void kernel_launch(void* const* d_in, const int* in_sizes, int n_in, void* d_out, int out_size, void* d_ws, size_t ws_size, hipStream_t stream) {
    static int grid = 0;
    if (grid == 0) {
        if (n_in != 21 || out_size != T * DM || ws_size < WS_NEED) { fprintf(stderr, "kernel_launch: unexpected shapes (n_in %d out %d ws %zu)\n", n_in, out_size, ws_size); grid = -1; return; }
        int dev = 0, cus = 0, per_cu = 0;
        if (hipGetDevice(&dev) != hipSuccess || hipDeviceGetAttribute(&cus, hipDeviceAttributeMultiprocessorCount, dev) != hipSuccess) { grid = -1; return; }
        if (hipFuncSetAttribute((const void*)mega_fwd, hipFuncAttributeMaxDynamicSharedMemorySize, LDS_BYTES) != hipSuccess) { fprintf(stderr, "kernel_launch: hipFuncSetAttribute failed\n"); grid = -1; return; }
        if (hipOccupancyMaxActiveBlocksPerMultiprocessor(&per_cu, (const void*)mega_fwd, NWAVES * 64, LDS_BYTES) != hipSuccess || per_cu < 1) { fprintf(stderr, "kernel_launch: occupancy query says %d\n", per_cu); per_cu = 1; }
        (void)hipGetLastError();
        grid = cus;
    }
    if (grid < 0) return;
    Args a{};
    for (int i = 0; i < 21; ++i) a.in[i] = (const float*)d_in[i];
    a.out = (float*)d_out; a.ws = (unsigned char*)d_ws;
#ifndef MK_PER_PHASE
#define MK_PER_PHASE 0
#endif
    if (MK_PER_PHASE) {
        for (int p = 0; p < 9; ++p) { a.ph_lo = p; a.ph_hi = p + 1; hipLaunchKernelGGL(mega_fwd, dim3(grid), dim3(NWAVES * 64), LDS_BYTES, stream, a); }
    } else {
        a.ph_lo = 0; a.ph_hi = 9;
        void* kargs[] = {&a};
        hipError_t e = hipLaunchCooperativeKernel((const void*)mega_fwd, dim3(grid), dim3(NWAVES * 64), kargs, LDS_BYTES, stream);
        if (e != hipSuccess) fprintf(stderr, "kernel_launch: cooperative launch failed: %s (grid %d)\n", hipGetErrorString(e), grid);
    }
}
```

```cpp
#include <hip/hip_runtime.h>
#include <hip/hip_cooperative_groups.h>
#include <cstdio>
#include <cstdint>
namespace cg = cooperative_groups;

typedef unsigned short bf16;
typedef unsigned v4u __attribute__((ext_vector_type(4)));
typedef float f32x4 __attribute__((ext_vector_type(4)));
#define LAS __attribute__((address_space(3)))
#define GAS __attribute__((address_space(1)))

constexpr int BATCH = 16, SEQ = 2048, DM = 1024, T = BATCH * SEQ;
constexpr int MEMLEN = 256, TM = BATCH * MEMLEN;
constexpr int CHUNK = 128;
constexpr int NH = 12, MBLK = 256, NBLK = SEQ / MBLK;
constexpr int MH = 4;
constexpr int DFF = 2816, INW = 7424;
constexpr float EPS = 1e-6f;
constexpr float LOG2E = 1.4426950408889634f;
constexpr float C2Q = 0.125f * LOG2E;
constexpr float C2M = 0.08838834764831845f * LOG2E;

constexpr size_t MiB = 1u << 20;
constexpr size_t DO_H = 0;
constexpr size_t DO_MEMN = 64 * MiB;
constexpr size_t DO_WCAT = 72 * MiB;
constexpr size_t DO_WOUT = 76 * MiB;
constexpr size_t DO_WGU = 78 * MiB;
constexpr size_t DO_WD = 89 * MiB;
constexpr size_t WS_CTL = 0;
constexpr size_t WS_KMEAN = 256 * 1024;
constexpr size_t WS_WIN = 1 * MiB;
constexpr size_t WS_WKV = 16 * MiB;
constexpr size_t WS_MEMKV = 18 * MiB;
constexpr size_t WS_MIX = 26 * MiB;
constexpr size_t WS_GV = 154 * MiB;
constexpr size_t WS_KB = 202 * MiB;
constexpr size_t WS_VB = 250 * MiB;
constexpr size_t WS_GATES = 298 * MiB;
constexpr size_t WS_Y = 26 * MiB;
constexpr size_t WS_HID = 26 * MiB;
constexpr size_t WS_F = 202 * MiB;
constexpr size_t WS_H2 = 320 * MiB;
constexpr size_t WS_X1 = 384 * MiB;
constexpr size_t WS_NEED = 512 * MiB;

__device__ __forceinline__ float bf2f(bf16 v) { return __uint_as_float((unsigned)v << 16); }
__device__ __forceinline__ unsigned f2bf(float f) { unsigned u = __float_as_uint(f); return (u + 0x7fffu + ((u >> 16) & 1u)) >> 16; }
__device__ __forceinline__ unsigned pk2(float lo, float hi) { return f2bf(lo) | (f2bf(hi) << 16); }
__device__ __forceinline__ float wave_sum(float v) {
#pragma unroll
    for (int o = 1; o < 64; o <<= 1) v += __shfl_xor(v, o);
    return v;
}
__device__ __forceinline__ float wave_max(float v) {
#pragma unroll
    for (int o = 1; o < 64; o <<= 1) v = fmaxf(v, __shfl_xor(v, o));
    return v;
}
__device__ __forceinline__ float fast_sigmoid(float x) { return __builtin_amdgcn_rcpf(1.0f + __builtin_amdgcn_exp2f(-LOG2E * x)); }
__device__ __forceinline__ float gelu_tanh(float x) {
    const float u = 0.7978845608028654f * (x + 0.044715f * x * x * x);
    return x * __builtin_amdgcn_rcpf(1.0f + __builtin_amdgcn_exp2f(-2.0f * LOG2E * u));
}
__device__ __forceinline__ int t5_bucket(int n) {
    if (n < 16) return n;
    int large = 16 + (int)(logf((float)n / 16.0f) / 2.0794415416798357f * 16.0f);
    return large < 31 ? large : 31;
}
namespace pg8 {
#define PG8_LAS __attribute__((address_space(3)))
typedef unsigned short bf16_t;
typedef short bf16x8 __attribute__((ext_vector_type(8)));
typedef float f32x4 __attribute__((ext_vector_type(4)));
typedef unsigned u32x4 __attribute__((ext_vector_type(4)));
constexpr int BM = 256, BK = 64, HALF = 128, HTB = HALF * BK * 2  , STAGE_BYTES = 8 * HTB, NXCD = 8, WGM = 8;

__host__ __device__ __forceinline__ int lds_byte(int r, int c) { const int st = (r >> 4) * 2 + (c >> 5), rr = r & 15, cc = c & 31, ob = rr * 64 + cc * 2; return st * 1024 + (ob ^ (((ob >> 9) & 1) << 5)); }
__host__ __device__ __forceinline__ void stage_rc(int b, int& R, int& C) { const int st = b / 1024, sb = b % 1024, swz = sb ^ (((sb >> 9) & 1) << 5); R = (st >> 1) * 16 + swz / 64; C = (st & 1) * 32 + (swz % 64) / 2; }
__host__ __device__ __forceinline__ int perm32(int rho) { const int n = rho >> 4, i = rho & 15; return 8 * (i >> 2) + 4 * n + (i & 3); }

struct Unit { int pm, pn; };
struct Gemm { const bf16_t* A; const bf16_t* Bt; int M, N, K; };

struct StaticOrder {
    int nM, nN, nwg, G, c;
    __host__ __device__ void init(int M, int N, int G_, int c_) { nM = M / BM; nN = N / BM; nwg = nM * nN; G = G_; c = c_; }
    __host__ __device__ bool next(int i, Unit& u) const {
        const long L = (long)i * G + c; if (L >= nwg) return false;
        int wgid = (int)L; { const int q = nwg / NXCD, r = nwg % NXCD, xcd = wgid % NXCD, off = wgid / NXCD; wgid = (xcd < r ? xcd * (q + 1) : r * (q + 1) + (xcd - r) * q) + off; }
        const int nig = WGM * nN, gid = wgid / nig, fm = gid * WGM, gsz = (nM - fm) < WGM ? (nM - fm) : WGM;
        u.pm = fm + ((wgid % nig) % gsz); u.pn = (wgid % nig) / gsz; return true;
    }
    __device__ __forceinline__ void a_ready(const Unit&) const {}
    __device__ __forceinline__ void done(const Unit&) const {}
};
#ifndef DBG_RAW
#define DBG_RAW 0
#endif
#ifndef DBG_NO_KMEAN
#define DBG_NO_KMEAN 0
#endif
typedef float f32x2_t __attribute__((ext_vector_type(2))); typedef __bf16 bf16x2_t __attribute__((ext_vector_type(2)));
__device__ __forceinline__ unsigned cvt_pk_bf16(float lo, float hi) { f32x2_t v = {lo, hi}; bf16x2_t b = __builtin_convertvector(v, bf16x2_t); return __builtin_bit_cast(unsigned, b); }

template <int ACT> __device__ __forceinline__ f32x4 act4(f32x4 v, float sc) {
    if (ACT == 0) return v * sc;
    f32x4 o;
#pragma unroll
    for (int j = 0; j < 4; ++j) o[j] = (ACT == 1) ? gelu_tanh(v[j]) : fast_sigmoid(v[j]);
    return o;
}
template <int ACT> __device__ __forceinline__ void store_tile_bf16(const f32x4 (&acc)[2][2][4][2], bf16_t* base, int ld, int row0, int col0, float sc) {
#pragma unroll
    for (int ai = 0; ai < 2; ++ai)
#pragma unroll
        for (int m = 0; m < 4; ++m) { bf16_t* rowp = base + (size_t)(row0 + ai * HALF + m * 16) * ld + col0;
#pragma unroll
            for (int bj = 0; bj < 2; ++bj) { const f32x4 v0 = act4<ACT>(acc[ai][bj][m][0], sc), v1 = act4<ACT>(acc[ai][bj][m][1], sc);
                u32x4 w; w.x = cvt_pk_bf16(v0[0], v0[1]); w.y = cvt_pk_bf16(v0[2], v0[3]); w.z = cvt_pk_bf16(v1[0], v1[1]); w.w = cvt_pk_bf16(v1[2], v1[3]);
                *(u32x4*)(rowp + bj * HALF) = w; } }
}
struct EpiProj {
    static constexpr bool PERM = true, AFTER_DRAIN = false;
    bf16_t *mix, *gv, *kb, *vb, *gates; float* kmean;
    __device__ __forceinline__ void operator()(const f32x4 (&acc)[2][2][4][2], const Unit& u, int wr, int wc, int fr, int fq) const {
        const int pn = u.pn, row0 = u.pm * BM + wr * 64 + fr, cw = wc * 32 + 8 * fq;
#if DBG_RAW
        if (pn < 3) store_tile_bf16<0>(acc, mix, 2048, row0, pn * 256 + cw, 1.f);
        else if (pn < 6) store_tile_bf16<0>(acc, gv, 768, row0, (pn - 3) * 256 + cw, 1.f);
        else if (pn < 9) store_tile_bf16<0>(acc, mix, 2048, row0, 768 + (pn - 6) * 256 + cw, 1.f);
#else
        if (pn < 3) store_tile_bf16<1>(acc, mix, 2048, row0, pn * 256 + cw, 1.f);
        else if (pn < 6) store_tile_bf16<1>(acc, gv, 768, row0, (pn - 3) * 256 + cw, 1.f);
        else if (pn < 9) store_tile_bf16<0>(acc, mix, 2048, row0, 768 + (pn - 6) * 256 + cw, C2Q);
#endif
        else if (pn < 12) {
            store_tile_bf16<0>(acc, kb, 768, row0, (pn - 9) * 256 + cw, 1.f);
#pragma unroll
            for (int bj = 0; bj < 2; ++bj)
#pragma unroll
                for (int n = 0; n < 2; ++n) { f32x4 s = (f32x4){0.f, 0.f, 0.f, 0.f};
#pragma unroll
                    for (int ai = 0; ai < 2; ++ai)
#pragma unroll
                        for (int m = 0; m < 4; ++m) s += acc[ai][bj][m][n];
#pragma unroll
                    for (int j = 0; j < 4; ++j) { float v = s[j]; v += __shfl_xor(v, 1); v += __shfl_xor(v, 2); v += __shfl_xor(v, 4); v += __shfl_xor(v, 8);
                        if (fr == 0 && !DBG_NO_KMEAN) atomicAdd(kmean + (size_t)u.pm * 768 + (pn - 9) * 256 + bj * HALF + cw + 4 * n + j, v * (1.0f / 256.0f)); } }
        }
        else if (pn < 15) store_tile_bf16<0>(acc, vb, 768, row0, (pn - 12) * 256 + cw, 1.f);
#if DBG_RAW
        else if (pn < 17) store_tile_bf16<0>(acc, mix, 2048, row0, 1536 + (pn - 15) * 256 + cw, 1.f);
        else store_tile_bf16<0>(acc, gates, 3072, row0, (pn - 17) * 256 + cw, 1.f);
#else
        else if (pn < 17) store_tile_bf16<0>(acc, mix, 2048, row0, 1536 + (pn - 15) * 256 + cw, C2M);
        else store_tile_bf16<2>(acc, gates, 3072, row0, (pn - 17) * 256 + cw, 1.f);
#endif
    }
};
struct EpiBf16Plain {
    static constexpr bool PERM = true, AFTER_DRAIN = false;
    bf16_t* O; int ld;
    __device__ __forceinline__ void operator()(const f32x4 (&acc)[2][2][4][2], const Unit& u, int wr, int wc, int fr, int fq) const {
        store_tile_bf16<0>(acc, O, ld, u.pm * BM + wr * 64 + fr, u.pn * BM + wc * 32 + 8 * fq, 1.f);
    }
};
struct EpiF32 {
    static constexpr bool PERM = false, AFTER_DRAIN = false;
    float* O; int ld;
    __device__ __forceinline__ void operator()(const f32x4 (&acc)[2][2][4][2], const Unit& u, int wr, int wc, int fr, int fq) const {
        const int row0 = u.pm * BM + wr * 64 + fr, col0 = u.pn * BM + wc * 32 + 4 * fq;
#pragma unroll
        for (int ai = 0; ai < 2; ++ai)
#pragma unroll
            for (int m = 0; m < 4; ++m) { float* rowp = O + (size_t)(row0 + ai * HALF + m * 16) * ld + col0;
#pragma unroll
                for (int bj = 0; bj < 2; ++bj)
#pragma unroll
                    for (int n = 0; n < 2; ++n) *(f32x4*)(rowp + bj * HALF + n * 16) = acc[ai][bj][m][n]; }
    }
};
struct EpiSwiGLU {
    static constexpr bool PERM = true, AFTER_DRAIN = false;
    bf16_t* O; int ld;
    __device__ __forceinline__ void operator()(const f32x4 (&acc)[2][2][4][2], const Unit& u, int wr, int wc, int fr, int fq) const {
        const int row0 = u.pm * BM + wr * 64 + fr, col0 = u.pn * HALF + wc * 32 + 8 * fq;
#pragma unroll
        for (int ai = 0; ai < 2; ++ai)
#pragma unroll
            for (int m = 0; m < 4; ++m) { f32x4 h[2];
#pragma unroll
                for (int n = 0; n < 2; ++n)
#pragma unroll
                    for (int j = 0; j < 4; ++j) { const float g = acc[ai][0][m][n][j]; h[n][j] = g * fast_sigmoid(g) * acc[ai][1][m][n][j]; }
                u32x4 w; w.x = cvt_pk_bf16(h[0][0], h[0][1]); w.y = cvt_pk_bf16(h[0][2], h[0][3]); w.z = cvt_pk_bf16(h[1][0], h[1][1]); w.w = cvt_pk_bf16(h[1][2], h[1][3]);
                *(u32x4*)(O + (size_t)(row0 + ai * HALF + m * 16) * ld + col0) = w; }
    }
};
struct EpiMerge {
    static constexpr bool PERM = true, AFTER_DRAIN = false;
    const bf16_t* gates; bf16_t* O;
    __device__ __forceinline__ bool want_mid(int t) const { return t == 12 || t == 24; }
    __device__ __forceinline__ void mid(f32x4 (&acc)[2][2][4][2], const Unit& u, int t, int wr, int wc, int fr, int fq) const {
        const int seg = (t == 12) ? 0 : 1;
        int row0 = u.pm * BM + wr * 64 + fr; asm volatile("" : "+v"(row0));
        const int col0 = u.pn * BM + wc * 32 + 8 * fq;
#pragma unroll
        for (int ai = 0; ai < 2; ++ai)
#pragma unroll
            for (int m = 0; m < 4; ++m) { const bf16_t* gp = gates + (size_t)(row0 + ai * HALF + m * 16) * 3072 + seg * 1024 + col0;
#pragma unroll
                for (int bj = 0; bj < 2; ++bj) { const u32x4 ga = *(const u32x4*)(gp + bj * HALF), gb = *(const u32x4*)(gp + 1024 + bj * HALF);
#pragma unroll
                    for (int e = 0; e < 8; ++e) { const unsigned wa = ga[e >> 1], wb = gb[e >> 1];
                        const float a = __uint_as_float((e & 1) ? (wa & 0xffff0000u) : (wa << 16)), b = __uint_as_float((e & 1) ? (wb & 0xffff0000u) : (wb << 16));
                        acc[ai][bj][m][e >> 2][e & 3] *= a * __builtin_amdgcn_rcpf(b); } } }
    }
    __device__ __forceinline__ void operator()(const f32x4 (&acc)[2][2][4][2], const Unit& u, int wr, int wc, int fr, int fq) const {
        int row0 = u.pm * BM + wr * 64 + fr; asm volatile("" : "+v"(row0));
        const int col0 = u.pn * BM + wc * 32 + 8 * fq;
#pragma unroll
        for (int ai = 0; ai < 2; ++ai)
#pragma unroll
            for (int m = 0; m < 4; ++m) { const size_t r = (size_t)(row0 + ai * HALF + m * 16);
#pragma unroll
                for (int bj = 0; bj < 2; ++bj) { const u32x4 ga = *(const u32x4*)(gates + r * 3072 + 2048 + col0 + bj * HALF); float o[8];
#pragma unroll
                    for (int e = 0; e < 8; ++e) { const unsigned wa = ga[e >> 1]; o[e] = acc[ai][bj][m][e >> 2][e & 3] * __uint_as_float((e & 1) ? (wa & 0xffff0000u) : (wa << 16)); }
                    u32x4 w; w.x = cvt_pk_bf16(o[0], o[1]); w.y = cvt_pk_bf16(o[2], o[3]); w.z = cvt_pk_bf16(o[4], o[5]); w.w = cvt_pk_bf16(o[6], o[7]);
                    *(u32x4*)(O + r * 1024 + col0 + bj * HALF) = w; } }
    }
};
template <class Epi, class Sched, bool ALIGN_EPI = false, bool SP2 = false, bool MID = false>
__device__ __forceinline__ void gemm_phase(PG8_LAS unsigned char* lds, const Gemm g, const Sched& S, const Epi& E, int wave_id) {
    int tid_ = wave_id * 64 + (int)__builtin_amdgcn_mbcnt_hi(~0u, __builtin_amdgcn_mbcnt_lo(~0u, 0u)); asm volatile("" : "+v"(tid_));
    const int tid = tid_, wid = __builtin_amdgcn_readfirstlane(tid >> 6), lane = tid & 63, wr = wid >> 2, wc = wid & 3, fr = lane & 15, fq = lane >> 4;
    const int K = g.K, nt = K / BK;
    unsigned voffA[2], voffB[2];
#pragma unroll
    for (int i = 0; i < 2; ++i) { int R, C; stage_rc(tid * 16 + i * 8192, R, C); const int Rb = Epi::PERM ? ((R & ~31) + perm32(R & 31)) : R;
        voffA[i] = (unsigned)(R * K + C) * 2u; voffB[i] = (unsigned)(Rb * K + C) * 2u; }
    const size_t kstep = (size_t)(BK * 2);
    const size_t hstep = (size_t)HALF * K * 2;
    const size_t tstep = 2 * hstep;
    const unsigned ldsw = (unsigned)wid * 1024u;
    const int aoff = lds_byte(wr * 64 + fr, fq * 8), boff = lds_byte(wc * 32 + fr, fq * 8);
#define PG8_SA(b, h) (((b) * 2 + (h)) * HTB)
#define PG8_SB(b, h) ((4 + (b) * 2 + (h)) * HTB)
#define PG8_STAGE(bufoff, gbase, voff) do { _Pragma("unroll") for (int _i = 0; _i < 2; ++_i) \
        __builtin_amdgcn_global_load_lds((const unsigned*)((const char*)(gbase) + (voff)[_i]), (PG8_LAS unsigned*)(lds + (bufoff) + ldsw + _i * 8192), 16, 0, 0); } while (0)
#define PG8_LDA(dst, b, h) do { _Pragma("unroll") for (int m = 0; m < 4; ++m) _Pragma("unroll") for (int k = 0; k < 2; ++k) dst[m][k] = *(const PG8_LAS bf16x8*)(lds + PG8_SA(b, h) + aoff + m * 2048 + k * 1024); } while (0)
#define PG8_LDB(dst, b, h) do { _Pragma("unroll") for (int n = 0; n < 2; ++n) _Pragma("unroll") for (int k = 0; k < 2; ++k) dst[n][k] = *(const PG8_LAS bf16x8*)(lds + PG8_SB(b, h) + boff + n * 2048 + k * 1024); } while (0)
#define PG8_MMA(ai, bj, At, Bt) do { __builtin_amdgcn_s_setprio(1); _Pragma("unroll") for (int m = 0; m < 4; ++m) _Pragma("unroll") for (int n = 0; n < 2; ++n) _Pragma("unroll") for (int k = 0; k < 2; ++k) \
        acc[ai][bj][m][n] = __builtin_amdgcn_mfma_f32_16x16x32_bf16(Bt[n][k], At[m][k], acc[ai][bj][m][n], 0, 0, 0); __builtin_amdgcn_s_setprio(0); } while (0)
#define PG8_WAIT_V(n) asm volatile("s_waitcnt vmcnt(" #n ")" ::: "memory")
#define PG8_WAIT_L(n) asm volatile("s_waitcnt lgkmcnt(" #n ")" ::: "memory")
#define PG8_BAR __builtin_amdgcn_s_barrier()
#define PG8_SCHED __builtin_amdgcn_sched_barrier(0)
    Unit cur, nxt; int ui = 0;
    if (!S.next(0, cur)) return;
    f32x4 acc[2][2][4][2];
#pragma unroll
    for (int a = 0; a < 2; ++a)
#pragma unroll
        for (int b = 0; b < 2; ++b)
#pragma unroll
            for (int m = 0; m < 4; ++m)
#pragma unroll
                for (int n = 0; n < 2; ++n) acc[a][b][m][n] = (f32x4){0.f, 0.f, 0.f, 0.f};
    bf16x8 At[4][2], B0[2][2], B1[2][2];
    const char* cA = (const char*)g.A + (size_t)cur.pm * tstep; const char* cB = (const char*)g.Bt + (size_t)cur.pn * tstep;
    S.a_ready(cur);
    if constexpr (SP2) {
        PG8_STAGE(PG8_SB(0, 0), cB, voffB); PG8_STAGE(PG8_SB(0, 1), cB + hstep, voffB); PG8_STAGE(PG8_SA(0, 0), cA, voffA); PG8_STAGE(PG8_SA(0, 1), cA + hstep, voffA);
        if (wr == 1) PG8_BAR;
        PG8_WAIT_V(2); PG8_BAR;
        PG8_STAGE(PG8_SB(1, 0), cB + kstep, voffB); PG8_STAGE(PG8_SA(1, 0), cA + kstep, voffA); PG8_STAGE(PG8_SB(1, 1), cB + hstep + kstep, voffB);
        PG8_WAIT_V(6); PG8_BAR;
    } else {
        PG8_STAGE(PG8_SB(0, 0), cB, voffB); PG8_STAGE(PG8_SA(0, 0), cA, voffA); PG8_STAGE(PG8_SB(0, 1), cB + hstep, voffB); PG8_STAGE(PG8_SA(0, 1), cA + hstep, voffA);
        if (wr == 1) PG8_BAR;
        PG8_WAIT_V(4); PG8_BAR;
        PG8_STAGE(PG8_SB(1, 0), cB + kstep, voffB); PG8_STAGE(PG8_SA(1, 0), cA + kstep, voffA); PG8_STAGE(PG8_SB(1, 1), cB + hstep + kstep, voffB);
        PG8_WAIT_V(6); PG8_BAR;
    }
    for (;;) {
        const bool has_next = S.next(ui + 1, nxt);
        const char* nA = has_next ? (const char*)g.A + (size_t)nxt.pm * tstep : cA; const char* nB = has_next ? (const char*)g.Bt + (size_t)nxt.pn * tstep : cB;
        for (int t = 0; t < nt; t += 2) {
            const bool last = (t == nt - 2);
            const char* a1 = cA + (size_t)(t + 1) * kstep;
            const char* a2 = last ? nA : cA + (size_t)(t + 2) * kstep; const char* b2 = last ? nB : cB + (size_t)(t + 2) * kstep;
            const char* a3 = a2 + kstep; const char* b3 = b2 + kstep;
            if (last && has_next) S.a_ready(nxt);
            if constexpr (SP2) {
            PG8_LDB(B0, 0, 0); PG8_LDB(B1, 0, 1); PG8_SCHED; PG8_LDA(At, 0, 0); PG8_STAGE(PG8_SA(1, 1), a1 + hstep, voffA);
            PG8_WAIT_V(8); PG8_WAIT_L(0); PG8_BAR; PG8_MMA(0, 0, At, B0); PG8_MMA(0, 1, At, B1); PG8_BAR; PG8_SCHED;
            PG8_LDA(At, 0, 1); PG8_STAGE(PG8_SB(0, 0), b2, voffB); PG8_STAGE(PG8_SB(0, 1), b2 + hstep, voffB); PG8_STAGE(PG8_SA(0, 0), a2, voffA);
            PG8_WAIT_V(8); PG8_WAIT_L(0); PG8_BAR; PG8_MMA(1, 0, At, B0); PG8_MMA(1, 1, At, B1); PG8_BAR; PG8_SCHED;
            PG8_LDB(B0, 1, 0); PG8_LDB(B1, 1, 1); PG8_SCHED; PG8_LDA(At, 1, 0); PG8_STAGE(PG8_SA(0, 1), a2 + hstep, voffA);
            PG8_WAIT_V(8); PG8_WAIT_L(0); PG8_BAR; PG8_MMA(0, 0, At, B0); PG8_MMA(0, 1, At, B1); PG8_BAR; PG8_SCHED;
            PG8_LDA(At, 1, 1); PG8_STAGE(PG8_SB(1, 0), b3, voffB); PG8_STAGE(PG8_SB(1, 1), b3 + hstep, voffB); PG8_STAGE(PG8_SA(1, 0), a3, voffA);
            PG8_WAIT_V(8); PG8_WAIT_L(0); PG8_BAR; PG8_MMA(1, 0, At, B0); PG8_MMA(1, 1, At, B1); PG8_BAR; PG8_SCHED;
            } else {
            PG8_LDB(B0, 0, 0); PG8_SCHED; PG8_LDA(At, 0, 0); PG8_STAGE(PG8_SA(1, 1), a1 + hstep, voffA);
            PG8_WAIT_L(8); PG8_BAR; PG8_WAIT_L(0); PG8_MMA(0, 0, At, B0); PG8_BAR; PG8_SCHED;
            PG8_LDB(B1, 0, 1); PG8_STAGE(PG8_SB(0, 0), b2, voffB);
            PG8_BAR; PG8_WAIT_L(0); PG8_MMA(0, 1, At, B1); PG8_BAR;
            PG8_LDA(At, 0, 1); PG8_STAGE(PG8_SA(0, 0), a2, voffA);
            PG8_BAR; PG8_WAIT_L(0); PG8_MMA(1, 0, At, B0); PG8_BAR; PG8_SCHED;
            PG8_STAGE(PG8_SB(0, 1), b2 + hstep, voffB);
            PG8_WAIT_V(6); PG8_BAR; PG8_MMA(1, 1, At, B1); PG8_BAR;
            PG8_LDB(B0, 1, 0); PG8_SCHED; PG8_LDA(At, 1, 0); PG8_STAGE(PG8_SA(0, 1), a2 + hstep, voffA);
            PG8_WAIT_L(8); PG8_BAR; PG8_WAIT_L(0); PG8_MMA(0, 0, At, B0); PG8_BAR; PG8_SCHED;
            PG8_LDB(B1, 1, 1); PG8_STAGE(PG8_SB(1, 0), b3, voffB);
            PG8_BAR; PG8_WAIT_L(0); PG8_MMA(0, 1, At, B1); PG8_BAR;
            PG8_LDA(At, 1, 1); PG8_STAGE(PG8_SA(1, 0), a3, voffA);
            PG8_BAR; PG8_WAIT_L(0); PG8_MMA(1, 0, At, B0); PG8_BAR; PG8_SCHED;
            PG8_STAGE(PG8_SB(1, 1), b3 + hstep, voffB);
            PG8_WAIT_V(6); PG8_BAR; PG8_MMA(1, 1, At, B1); PG8_BAR;
            }
            if constexpr (MID) { if (E.want_mid(t + 2)) E.mid(acc, cur, t + 2, wr, wc, fr, fq); }
        }
        if constexpr (ALIGN_EPI) { if (wr == 0) PG8_BAR; }
        if constexpr (!Epi::AFTER_DRAIN) { E(acc, cur, wr, wc, fr, fq); S.done(cur); }
        if (!has_next) break;
#pragma unroll
        for (int a = 0; a < 2; ++a)
#pragma unroll
            for (int b = 0; b < 2; ++b)
#pragma unroll
                for (int m = 0; m < 4; ++m)
#pragma unroll
                    for (int n = 0; n < 2; ++n) acc[a][b][m][n] = (f32x4){0.f, 0.f, 0.f, 0.f};
        cur = nxt; cA = nA; cB = nB; ++ui;
        if constexpr (ALIGN_EPI) { if (wr == 1) PG8_BAR; }
    }
    PG8_WAIT_V(0);
    if constexpr (!ALIGN_EPI) { if (wr == 0) PG8_BAR; }
    PG8_BAR;
    if constexpr (Epi::AFTER_DRAIN) { E.fused(acc, cur, wr, wc, fr, fq, lds, wid, lane); S.done(cur); }
#undef PG8_SA
#undef PG8_SB
#undef PG8_STAGE
#undef PG8_LDA
#undef PG8_LDB
#undef PG8_MMA
#undef PG8_WAIT_V
#undef PG8_WAIT_L
#undef PG8_BAR
#undef PG8_SCHED
}
}
#include <hip/hip_bf16.h>
#include <cmath>
namespace mattn {
using bf16=__hip_bfloat16;
using bf16x8=__attribute__((ext_vector_type(8)))short;
using s16x4=__attribute__((ext_vector_type(4)))short;
using f32x16=__attribute__((ext_vector_type(16)))float;
using u32x4=__attribute__((ext_vector_type(4)))unsigned;
typedef float f32x4_t __attribute__((ext_vector_type(4)));
constexpr int SEQ=2048,D=64,QP=2048,KP=768,QCOL=768,NHEADS=12;
constexpr int NW=8,QBLK=32,QB=QBLK*NW,KVBLK=64,NQB=SEQ/QB;
__device__ __forceinline__ int crow(int r,int hi){return (r&3)+8*(r>>2)+4*hi;}
#define SBAR() __builtin_amdgcn_sched_barrier(0)
constexpr int NSLOT=3, SLOTB=8192;
constexpr int LDS_K=0, LDS_V=NSLOT*SLOTB, LDS_WS=2*NSLOT*SLOTB, LDS_OST=LDS_WS+NW*64*4, LDS_TAB=LDS_OST+NW*4096, LDS_BYTES=LDS_TAB+2048;
constexpr float C2=0.125f*1.4426950408889634f;
__device__ __forceinline__ void glds16(const void*gsrc,unsigned lds_dst){unsigned keep;
  asm volatile("s_mov_b32 %0, m0\n\ts_mov_b32 m0, %2\n\ts_nop 0\n\tglobal_load_lds_dwordx4 %1, off\n\ts_mov_b32 m0, %0":"=&s"(keep):"v"(gsrc),"s"(lds_dst):"memory");}
__device__ __forceinline__ float max3f(float a,float b,float c){float r;asm("v_max3_f32 %0, %1, %2, %3":"=v"(r):"v"(a),"v"(b),"v"(c));return r;}
__device__ __forceinline__ float max2f(float a,float b){float r;asm("v_max_f32_e32 %0, %1, %2":"=v"(r):"v"(a),"v"(b));return r;}
__device__ __forceinline__ float fadd_s(float a,float b){float r;asm("v_add_f32_e32 %0, %1, %2":"=v"(r):"v"(a),"v"(b));return r;}
__device__ __forceinline__ float fsub_s(float a,float b){float r;asm("v_sub_f32_e32 %0, %1, %2":"=v"(r):"v"(a),"v"(b));return r;}
typedef float f32x2_t __attribute__((ext_vector_type(2))); typedef __bf16 bf16x2_t __attribute__((ext_vector_type(2)));
__device__ __forceinline__ unsigned cvtpk_s(float lo,float hi){f32x2_t v={lo,hi};bf16x2_t b=__builtin_convertvector(v,bf16x2_t);return __builtin_bit_cast(unsigned,b);}
#define WAIT_BAR(N) asm volatile("s_waitcnt vmcnt(" #N ") lgkmcnt(0)\n\ts_barrier":::"memory")

__device__ __forceinline__ void qkt(f32x16&p0,f32x16&p1,const char*Kslot,const bf16x8*qr,const f32x16&negm,int r32,int hi){
  const char*kb=Kslot+hi*1024+r32*16;
  #pragma unroll
  for(int d0=0;d0<4;++d0){
    const bf16x8 b0=*reinterpret_cast<const bf16x8*>(kb+d0*2048);
    const bf16x8 b1=*reinterpret_cast<const bf16x8*>(kb+d0*2048+512);
    if(d0==0){p0=__builtin_amdgcn_mfma_f32_32x32x16_bf16(b0,qr[0],negm,0,0,0);p1=__builtin_amdgcn_mfma_f32_32x32x16_bf16(b1,qr[0],negm,0,0,0);}
    else{p0=__builtin_amdgcn_mfma_f32_32x32x16_bf16(b0,qr[d0],p0,0,0,0);p1=__builtin_amdgcn_mfma_f32_32x32x16_bf16(b1,qr[d0],p1,0,0,0);}}
}
typedef __attribute__((address_space(3))) const char* lds_cptr;
typedef short v4i16_t __attribute__((ext_vector_type(4)));
__device__ __forceinline__ void kload8(bf16x8*kf,lds_cptr kp){
  kf[0]=*(const __attribute__((address_space(3))) bf16x8*)(kp);      kf[1]=*(const __attribute__((address_space(3))) bf16x8*)(kp+512);
  kf[2]=*(const __attribute__((address_space(3))) bf16x8*)(kp+2048); kf[3]=*(const __attribute__((address_space(3))) bf16x8*)(kp+2560);
  kf[4]=*(const __attribute__((address_space(3))) bf16x8*)(kp+4096); kf[5]=*(const __attribute__((address_space(3))) bf16x8*)(kp+4608);
  kf[6]=*(const __attribute__((address_space(3))) bf16x8*)(kp+6144); kf[7]=*(const __attribute__((address_space(3))) bf16x8*)(kp+6656);
}
__device__ __forceinline__ void kload2(bf16x8*kf,lds_cptr kp,int j){ kf[2*j]=*(const __attribute__((address_space(3))) bf16x8*)(kp+j*2048); kf[2*j+1]=*(const __attribute__((address_space(3))) bf16x8*)(kp+j*2048+512); }
__device__ __forceinline__ s16x4 vtr(lds_cptr p){ return __builtin_bit_cast(s16x4,__builtin_amdgcn_ds_read_tr16_b64_v4i16((__attribute__((address_space(3))) v4i16_t*)p)); }
__device__ __forceinline__ float rowmax(const f32x16&p0,const f32x16&p1){
  float a=max3f(p0[0],p0[1],p1[0]),b=max3f(p0[2],p0[3],p1[1]);a=max3f(a,p1[2],p1[3]);
  #pragma unroll
  for(int r=4;r<16;r+=4){a=max3f(a,p0[r],p0[r+1]);b=max3f(b,p0[r+2],p0[r+3]);a=max3f(a,p1[r],p1[r+1]);b=max3f(b,p1[r+2],p1[r+3]);}
  const float m=max2f(a,b);
  auto rr=__builtin_amdgcn_permlane32_swap(__float_as_uint(m),__float_as_uint(m),false,false);
  return max2f(__uint_as_float(rr[0]),__uint_as_float(rr[1]));
}
__device__ __forceinline__ void pv(f32x16*o,int vb,bf16x8 pa0,bf16x8 pa1,bf16x8 pa2,bf16x8 pa3){
  #pragma unroll
  for(int d0=0;d0<2;++d0){s16x4 lo[4],hi[4];
    #pragma unroll
    for(int ks=0;ks<4;++ks){
      asm volatile("ds_read_b64_tr_b16 %0,%1 offset:%c2":"=&v"(lo[ks]):"v"(vb),"i"(d0*4096+ks*1024):"memory");
      asm volatile("ds_read_b64_tr_b16 %0,%1 offset:%c2":"=&v"(hi[ks]):"v"(vb),"i"(d0*4096+ks*1024+512):"memory");}
    asm volatile("s_waitcnt lgkmcnt(0)":::"memory");SBAR();
    #define PK(k) (bf16x8){lo[k][0],lo[k][1],lo[k][2],lo[k][3],hi[k][0],hi[k][1],hi[k][2],hi[k][3]}
    o[d0]=__builtin_amdgcn_mfma_f32_32x32x16_bf16(pa0,PK(0),o[d0],0,0,0);
    o[d0]=__builtin_amdgcn_mfma_f32_32x32x16_bf16(pa1,PK(1),o[d0],0,0,0);
    o[d0]=__builtin_amdgcn_mfma_f32_32x32x16_bf16(pa2,PK(2),o[d0],0,0,0);
    o[d0]=__builtin_amdgcn_mfma_f32_32x32x16_bf16(pa3,PK(3),o[d0],0,0,0);
    #undef PK
  }
}

#ifndef ATTN_STORE16
#define ATTN_STORE16(p,v) (*(u32x4*)(p)=(v))
#endif
template<int THRL> __device__ __forceinline__ void attn_unit(int b,int h,int qb,const bf16*Q,const bf16*__restrict__ K,const bf16*__restrict__ V,bf16*O,const float*__restrict__ kmean,const float*__restrict__ relb,char*shm){
  const int tid=threadIdx.x,lane=tid&63,r32=lane&31,hi=lane>>5; const int wid=__builtin_amdgcn_readfirstlane(tid>>6);
  const long rowbase=(long)b*SEQ; const int q0=qb*QB;
  const bf16*Qw=Q+(rowbase+q0+wid*QBLK)*QP+QCOL+h*D;
  const bf16*Kh=K+rowbase*KP+h*D,*Vh=V+rowbase*KP+h*D;
  const unsigned lds0=(unsigned)(uintptr_t)shm;
  float*wsf=(float*)(shm+LDS_WS)+wid*64;
  float*tabR=(float*)(shm+LDS_TAB);
  { const int j_=tid, dist_=383-j_; float v_=-INFINITY; if(dist_>=0){ const int dd_=dist_<128?dist_:128; v_=relb[t5_bucket(dd_)*NHEADS+h]*1.4426950408889634f; } tabR[j_]=v_; }
  const float b31=relb[31*NHEADS+h]*1.4426950408889634f;
  const int qw0=q0+wid*QBLK;
  const bf16*ksrc=Kh+(long)lane*KP+wid*8;
  const bf16*vsrc=Vh+(long)(16*(wid&3)+(lane>>2))*KP+(wid>>2)*32+(lane&3)*8;
  const unsigned kdst=lds0+LDS_K+wid*1024, vdst=lds0+LDS_V+wid*1024;
  #define DMA_K(t,slot) glds16(ksrc+(long)(t)*KVBLK*KP,(unsigned)__builtin_amdgcn_readfirstlane(kdst+(slot)))
  #define DMA_V(t,slot) glds16(vsrc+(long)(t)*KVBLK*KP,(unsigned)__builtin_amdgcn_readfirstlane(vdst+(slot)))
  const int vb0=(int)(lds0+LDS_V)+((lane>>4)&1)*32+(lane&3)*8+(4*hi+((lane&15)>>2))*64;
  const char*Kbase=shm+LDS_K; bf16x8 kf[8];
  const lds_cptr shm3=(lds_cptr)shm; const lds_cptr kp0=shm3+LDS_K+hi*1024+r32*16; const lds_cptr vp0=shm3+LDS_V+((lane>>4)&1)*32+(lane&3)*8+(4*hi+((lane&15)>>2))*64;
  const int NT=(q0+QB)/KVBLK;
  DMA_K(0,0);DMA_V(0,0);DMA_K(1,SLOTB);
  bf16x8 qr[4];
  #pragma unroll
  for(int d0=0;d0<4;++d0)qr[d0]=*reinterpret_cast<const bf16x8*>(&Qw[(long)r32*QP+d0*16+hi*8]);
  unsigned sel=0u;
  if(qb>0){ float gt[7];
    _Pragma("unroll") for(int n=0;n<7;++n){ float a_=0.f; if(n<qb){ const float*km=kmean+n*768+8*hi;
        _Pragma("unroll") for(int d0=0;d0<4;++d0){ const f32x4_t k0=*(const f32x4_t*)(km+16*d0), k1=*(const f32x4_t*)(km+16*d0+4);
          _Pragma("unroll") for(int j=0;j<4;++j){ a_+=__uint_as_float(((unsigned)(unsigned short)qr[d0][j])<<16)*k0[j]; a_+=__uint_as_float(((unsigned)(unsigned short)qr[d0][j+4])<<16)*k1[j]; } }
        a_+=__shfl_xor(a_,32); } gt[n]=a_; }
    _Pragma("unroll") for(int n=0;n<7;++n) if(n<qb){ int rank=0;
      _Pragma("unroll") for(int m=0;m<7;++m) if(m!=n&&m<qb) rank+=(gt[m]>gt[n]||(gt[m]==gt[n]&&m<n))?1:0;
      if(rank<3) sel|=1u<<n; } }
  float mhat=0.f,l_reg=0.f;f32x16 o[2];o[0]=f32x16{};o[1]=f32x16{};f32x16 cin;
  const int qabs=qw0+r32; bool near_=false;
  #define TILE_SETUP(t) do{ const int k0_=64*(t); const bool above_=k0_>qw0+31, far_=(qw0-k0_-63)>=128; \
    const bool lsel_=((t)>=4*qb)||(((sel>>((t)>>2))&1u)!=0u); \
    const float c0_=(above_||!lsel_)?-INFINITY:((far_?b31:0.f)-mhat); \
    _Pragma("unroll") for(int r=0;r<16;++r)cin[r]=c0_; asm volatile("":"+v"(cin)); near_=!above_&&!far_; }while(0)
  #define NEARADD(P0,P1,t) do{ if(near_){ const float*tp_=tabR+(383-(qabs-64*(t)-4*hi)); \
    _Pragma("unroll") for(int r=0;r<16;++r){ P0[r]+=tp_[(r&3)+8*(r>>2)]; P1[r]+=tp_[(r&3)+8*(r>>2)+32]; } } }while(0)
  bool resc=false;
  #define START(P0,P1) do{ const float rm=rowmax(P0,P1); resc=false; \
    { const float dl=(rm==-INFINITY)?0.f:rm; mhat=fadd_s(mhat,dl);     \
      _Pragma("unroll") for(int r=0;r<16;++r){P0[r]=fsub_s(P0[r],dl);P1[r]=fsub_s(P1[r],dl);} } \
    _Pragma("unroll") for(int r=0;r<16;++r)P0[r]=__builtin_amdgcn_exp2f(P0[r]); }while(0)
  #define RESC() do{ if(resc){ asm volatile("s_waitcnt lgkmcnt(0)":::"memory"); \
      _Pragma("unroll") for(int d_=0;d_<2;++d_) _Pragma("unroll") for(int r=0;r<16;++r)o[d_][r]*=wsf[crow(r,hi)]; } }while(0)
  f32x16 pA0,pA1,pB0,pB1;
  int sl_prev=0,sl_cur=0,sl_next=SLOTB;
  #define ROT() do{sl_prev=sl_cur;sl_cur=sl_next;sl_next=(sl_next==(NSLOT-1)*SLOTB)?0:sl_next+SLOTB;}while(0)
  DMA_K(2,2*SLOTB);
  WAIT_BAR(3);
  TILE_SETUP(0); qkt(pA0,pA1,Kbase,qr,cin,r32,hi);asm volatile("s_nop 15\n\ts_nop 7":"+v"(pA0),"+v"(pA1));NEARADD(pA0,pA1,0);asm volatile("s_nop 1":"+v"(pA0),"+v"(pA1));
  START(pA0,pA1);
  _Pragma("unroll") for(int r=0;r<16;++r)pA1[r]=__builtin_amdgcn_exp2f(pA1[r]);
  WAIT_BAR(0);
  DMA_K(3,0);DMA_V(1,SLOTB);
  ROT();
  kload8(kf,kp0+sl_cur);
  WAIT_BAR(2);
  s16x4 vlo[8],vhi[8]; u32x4 pw0,pw1,pw2,pw3;
  #define PKW(P,B) cvtpk_s(P[B],P[B+1])
  #define PAF(k) __builtin_bit_cast(bf16x8,pw##k)
  #define VFR(i) (bf16x8){vlo[i][0],vlo[i][1],vlo[i][2],vlo[i][3],vhi[i][0],vhi[i][1],vhi[i][2],vhi[i][3]}
  #define PIN(x) asm volatile("":"+v"(x))
  #define MX3(a,b,c) __builtin_fmaxf(__builtin_fmaxf((a),(b)),(c))
  #define GAPA(MF,A0,A1,A2,A3,W0,W1,PW) do{ MF; sacc+=A0; sacc+=A1; sacc+=A2; sacc+=A3; PIN(sacc); W0; W1; PIN(PW); SBAR(); }while(0)
  #define EX(v) __builtin_amdgcn_exp2f(v)
  #define GAPB(MF,X,B) do{ MF; X[B]=EX(X[B]); X[B+1]=EX(X[B+1]); X[B+2]=EX(X[B+2]); X[B+3]=EX(X[B+3]); PIN(X); SBAR(); }while(0)
  #define VRD(i) do{ vlo[i]=vtr(vp_+(((i)>>2)*4096+((i)&3)*1024)); vhi[i]=vtr(vp_+(((i)>>2)*4096+((i)&3)*1024+512)); }while(0)
  #define KRD(G,j) do{ if(G){ kload2(kf,kp0+sl_next,j); SBAR(); } }while(0)
  #define STEP(C0,C1,P0,P1,t,GK,GV,GL) do{ TILE_SETUP(t); SBAR(); \
    const lds_cptr vp_=vp0+sl_prev; \
    VRD(0); SBAR(); float sacc=(P0[0]+P0[1]); \
    GAPA(C0=__builtin_amdgcn_mfma_f32_32x32x16_bf16(kf[0],qr[0],cin,0,0,0), P0[2],P0[3],P0[4],P0[5],     pw0[0]=PKW(P0,0), pw0[1]=PKW(P0,2), pw0); \
    VRD(4); SBAR(); GAPA(C1=__builtin_amdgcn_mfma_f32_32x32x16_bf16(kf[1],qr[0],cin,0,0,0), P0[6],P0[7],P0[8],P0[9],     pw0[2]=PKW(P0,4), pw0[3]=PKW(P0,6), pw0); \
    VRD(1); SBAR(); GAPA(C0=__builtin_amdgcn_mfma_f32_32x32x16_bf16(kf[2],qr[1],C0,0,0,0),   P0[10],P0[11],P0[12],P0[13], pw1[0]=PKW(P0,8), pw1[1]=PKW(P0,10), pw1); \
    VRD(5); SBAR(); GAPA(C1=__builtin_amdgcn_mfma_f32_32x32x16_bf16(kf[3],qr[1],C1,0,0,0),   P0[14],P0[15],P1[0],P1[1],   pw1[2]=PKW(P0,12),pw1[3]=PKW(P0,14), pw1); \
    VRD(2); SBAR(); GAPA(C0=__builtin_amdgcn_mfma_f32_32x32x16_bf16(kf[4],qr[2],C0,0,0,0),   P1[2],P1[3],P1[4],P1[5],     pw2[0]=PKW(P1,0), pw2[1]=PKW(P1,2), pw2); \
    VRD(6); SBAR(); GAPA(C1=__builtin_amdgcn_mfma_f32_32x32x16_bf16(kf[5],qr[2],C1,0,0,0),   P1[6],P1[7],P1[8],P1[9],     pw2[2]=PKW(P1,4), pw2[3]=PKW(P1,6), pw2); \
    VRD(3); SBAR(); GAPA(C0=__builtin_amdgcn_mfma_f32_32x32x16_bf16(kf[6],qr[3],C0,0,0,0),   P1[10],P1[11],P1[12],P1[13], pw3[0]=PKW(P1,8), pw3[1]=PKW(P1,10), pw3); \
    VRD(7); SBAR(); GAPA(C1=__builtin_amdgcn_mfma_f32_32x32x16_bf16(kf[7],qr[3],C1,0,0,0),   P1[14],P1[15],0.f,0.f,       pw3[2]=PKW(P1,12),pw3[3]=PKW(P1,14), pw3); \
    l_reg+=sacc; \
    if(GK){DMA_K((t)+3,sl_cur);} if(GV){DMA_V((t)+1,sl_next);} \
    NEARADD(C0,C1,t); \
    { float a=MX3(C0[0],C0[1],C1[0]),b=MX3(C0[2],C0[3],C1[1]); a=MX3(a,C1[2],C1[3]); \
      _Pragma("unroll") for(int r=4;r<16;r+=4){a=MX3(a,C0[r],C0[r+1]);b=MX3(b,C0[r+2],C0[r+3]);a=MX3(a,C1[r],C1[r+1]);b=MX3(b,C1[r+2],C1[r+3]);} \
      float rm=__builtin_fmaxf(a,b); { auto rr=__builtin_amdgcn_permlane32_swap(__float_as_uint(rm),__float_as_uint(rm),false,false); rm=__builtin_fmaxf(__uint_as_float(rr[0]),__uint_as_float(rr[1])); } \
      resc=false; \
      if(__builtin_expect(__any(rm>(float)THRL),0)){ const float dl=__builtin_fmaxf(rm,0.f); mhat+=dl; \
        _Pragma("unroll") for(int r=0;r<16;++r){C0[r]-=dl;C1[r]-=dl;} \
        const float f=__builtin_amdgcn_exp2f(-dl); l_reg*=f; if(hi==0)wsf[r32]=f; resc=true; } } \
    SBAR(); \
    GAPB(o[0]=__builtin_amdgcn_mfma_f32_32x32x16_bf16(PAF(0),VFR(0),o[0],0,0,0), C0,0); \
    GAPB(o[1]=__builtin_amdgcn_mfma_f32_32x32x16_bf16(PAF(0),VFR(4),o[1],0,0,0), C0,4); \
    KRD(GL,0); GAPB(o[0]=__builtin_amdgcn_mfma_f32_32x32x16_bf16(PAF(1),VFR(1),o[0],0,0,0), C0,8); \
    KRD(GL,1); GAPB(o[1]=__builtin_amdgcn_mfma_f32_32x32x16_bf16(PAF(1),VFR(5),o[1],0,0,0), C0,12); \
    KRD(GL,2); GAPB(o[0]=__builtin_amdgcn_mfma_f32_32x32x16_bf16(PAF(2),VFR(2),o[0],0,0,0), C1,0); \
    KRD(GL,3); GAPB(o[1]=__builtin_amdgcn_mfma_f32_32x32x16_bf16(PAF(2),VFR(6),o[1],0,0,0), C1,4); \
    GAPB(o[0]=__builtin_amdgcn_mfma_f32_32x32x16_bf16(PAF(3),VFR(3),o[0],0,0,0), C1,8); \
    GAPB(o[1]=__builtin_amdgcn_mfma_f32_32x32x16_bf16(PAF(3),VFR(7),o[1],0,0,0), C1,12); \
    }while(0)
  int t=1;
  for(;t+7<NT;t+=2){
    STEP(pB0,pB1,pA0,pA1,t,true,true,true);     WAIT_BAR(2); RESC(); ROT();
    STEP(pA0,pA1,pB0,pB1,t+1,true,true,true);   WAIT_BAR(2); RESC(); ROT();
  }
  #define ENDW(tt) do{ if((tt)+3<NT){WAIT_BAR(2);} else if((tt)+2<NT){WAIT_BAR(1);} else {WAIT_BAR(0);} }while(0)
  for(;t+1<NT;t+=2){
    STEP(pB0,pB1,pA0,pA1,t,(t+3<NT),(t+1<NT),(t+1<NT));       ENDW(t);   RESC(); ROT();
    STEP(pA0,pA1,pB0,pB1,t+1,(t+4<NT),(t+2<NT),(t+2<NT));     ENDW(t+1); RESC(); ROT();
  }
  STEP(pB0,pB1,pA0,pA1,NT-1,false,false,false); RESC();
  { float sacc=pB0[0]+pB0[1]; _Pragma("unroll") for(int r=2;r<16;++r)sacc+=pB0[r]; _Pragma("unroll") for(int r=0;r<16;++r)sacc+=pB1[r]; l_reg+=sacc;
    pw0=(u32x4){PKW(pB0,0),PKW(pB0,2),PKW(pB0,4),PKW(pB0,6)};pw1=(u32x4){PKW(pB0,8),PKW(pB0,10),PKW(pB0,12),PKW(pB0,14)};pw2=(u32x4){PKW(pB1,0),PKW(pB1,2),PKW(pB1,4),PKW(pB1,6)};pw3=(u32x4){PKW(pB1,8),PKW(pB1,10),PKW(pB1,12),PKW(pB1,14)};
    SBAR(); pv(o,vb0+sl_cur,PAF(0),PAF(1),PAF(2),PAF(3)); }
  #undef PKW
  #undef PAF
  #undef VFR
  #undef PIN
  #undef MX3
  #undef GAPA
  #undef GAPB
  #undef EX
  #undef VRD
  #undef KRD
  #undef STEP
  #undef ENDW
  {auto rr=__builtin_amdgcn_permlane32_swap(__float_as_uint(l_reg),__float_as_uint(l_reg),false,false);l_reg=__uint_as_float(rr[0])+__uint_as_float(rr[1]);}
  if(hi==0)wsf[32+r32]=l_reg;asm volatile("s_waitcnt lgkmcnt(0)":::"memory");
  float rli[16];
  #pragma unroll
  for(int r=0;r<16;++r)rli[r]=__builtin_amdgcn_rcpf(wsf[32+crow(r,hi)]);
  bf16*Ow=O+(rowbase+q0+wid*QBLK)*QP+QCOL+h*D;
  { bf16*stg=(bf16*)(shm+LDS_OST)+wid*2048;
    #pragma unroll
    for(int r=0;r<16;++r){const int orow=crow(r,hi);
      #pragma unroll
      for(int d0=0;d0<2;++d0)stg[orow*64+d0*32+r32]=__float2bfloat16(o[d0][r]*rli[r]);}
    asm volatile("s_waitcnt lgkmcnt(0)":::"memory");
    #pragma unroll
    for(int i=0;i<4;++i){const int row=i*8+(lane>>3),ch=lane&7; const u32x4 v=*(const u32x4*)(stg+row*64+ch*8); ATTN_STORE16(Ow+(long)row*QP+ch*8,v);} }
  asm volatile("s_waitcnt lgkmcnt(0)\n\ts_barrier":::"memory");
  #undef DMA_K
  #undef DMA_V
  #undef TILE_SETUP
  #undef NEARADD
  #undef START
  #undef RESC
  #undef ROT
}
constexpr int ATTN_LDS_BYTES=LDS_BYTES;
struct AttnTensors { const bf16* Q; const bf16* K; const bf16* V; bf16* O; const float* kmean; const float* relb; };
template<int THRL=8> __device__ __forceinline__ void attn_phase(char*lds,const AttnTensors&T,int vcu,int G){
  for(int p=vcu*3;p<768;p+=G*3){
    for(int i=0;i<3&&p+i<768;++i){ const int pr=p+i, bh=pr>>2, s=pr&3, b=bh/NHEADS, h=bh-b*NHEADS; const float*km=T.kmean+(long)b*8*768+h*64;
      attn_unit<THRL>(b,h,s,T.Q,T.K,T.V,T.O,km,T.relb,lds);
      attn_unit<THRL>(b,h,7-s,T.Q,T.K,T.V,T.O,km,T.relb,lds); } }
}
#undef SBAR
#undef WAIT_BAR
}
#ifndef DBG_NAIVE_MOBA
#define DBG_NAIVE_MOBA 0
#endif
#ifndef DBG_P1
#define DBG_P1 3
#endif
constexpr int NWAVES = 8;
constexpr int RING_BYTES = 131072;
constexpr int LDS_BYTES = 147456;

struct Args { const float* in[21]; float* out; unsigned char* ws; int ph_lo, ph_hi; };

__device__ __forceinline__ int opq(int v) { asm volatile("" : "+v"(v)); return v; }
__device__ __forceinline__ int lane_id() { return (int)__builtin_amdgcn_mbcnt_hi(~0u, __builtin_amdgcn_mbcnt_lo(~0u, 0u)); }
struct Frame {
    LAS unsigned char* lds;
    int wave, vcu, G;
};

__device__ __forceinline__ void p0_transpose_item(const float* W, int K, int N, bf16* WT, int ldt, int col_off, int mode, LAS float* scr, int item, int lane) {
    const int nblk = N / 32, kb = item / nblk, nb = item % nblk, k0 = 64 * kb, n0 = 32 * nb;
#pragma unroll 8
    for (int i = 0; i < 32; ++i) { const int kk = 2 * i + (lane >> 5); scr[kk * 33 + (lane & 31)] = W[(size_t)(k0 + kk) * N + n0 + (lane & 31)]; }
    asm volatile("s_waitcnt lgkmcnt(0)" ::: "memory");
    const int c = lane & 7;
    const int rbase = mode ? ((n0 / 128) * 256 + (n0 % 128) + (mode == 2 ? 128 : 0)) : n0;
#pragma unroll
    for (int j = 0; j < 4; ++j) { const int n = (lane >> 3) + 8 * j; const LAS float* s = scr + (8 * c) * 33 + n;
        v4u o; o.x = pk2(s[0 * 33], s[1 * 33]); o.y = pk2(s[2 * 33], s[3 * 33]); o.z = pk2(s[4 * 33], s[5 * 33]); o.w = pk2(s[6 * 33], s[7 * 33]);
        *(v4u*)(WT + (size_t)(rbase + n) * ldt + col_off + k0 + 8 * c) = o; }
    asm volatile("s_waitcnt lgkmcnt(0)" ::: "memory");
}
__device__ __forceinline__ void rms_row_bf16(const float* xrow, const float* g, bf16* orow, int lane_) {
    const int lane = opq(lane_);
    const f32x4* xr = (const f32x4*)xrow + lane;
    f32x4 v[4]; float s = 0.f;
#pragma unroll
    for (int j = 0; j < 4; ++j) { v[j] = xr[64 * j]; s += (v[j].x * v[j].x + v[j].y * v[j].y) + (v[j].z * v[j].z + v[j].w * v[j].w); }
    const float r = rsqrtf(wave_sum(s) * (1.f / DM) + EPS);
    unsigned long long* o8 = (unsigned long long*)orow + lane;
#pragma unroll
    for (int j = 0; j < 4; ++j) { const f32x4 gg = ((const f32x4*)g)[lane + 64 * j];
        o8[64 * j] = (unsigned long long)pk2(v[j].x * r * gg.x, v[j].y * r * gg.y) | ((unsigned long long)pk2(v[j].z * r * gg.z, v[j].w * r * gg.w) << 32); }
}
__device__ __forceinline__ void post_norm_row(const float* xin, const float* y, const float* g1, float* x1out, const float* g2, bf16* h2, int lane_) {
    const int lane = opq(lane_);
    const f32x4* yr = (const f32x4*)y + lane; const f32x4* xr = (const f32x4*)xin + lane;
    f32x4 v[4]; float s = 0.f;
#pragma unroll
    for (int j = 0; j < 4; ++j) { v[j] = yr[64 * j]; s += (v[j].x * v[j].x + v[j].y * v[j].y) + (v[j].z * v[j].z + v[j].w * v[j].w); }
    const float r = rsqrtf(wave_sum(s) * (1.f / DM) + EPS);
    float s2 = 0.f;
#pragma unroll
    for (int j = 0; j < 4; ++j) { const f32x4 gg = ((const f32x4*)g1)[lane + 64 * j]; const f32x4 xx = xr[64 * j];
        v[j] = xx + v[j] * r * gg; ((f32x4*)x1out)[lane + 64 * j] = v[j];
        s2 += (v[j].x * v[j].x + v[j].y * v[j].y) + (v[j].z * v[j].z + v[j].w * v[j].w); }
    if (h2) {
        const float r2 = rsqrtf(wave_sum(s2) * (1.f / DM) + EPS);
        unsigned long long* o8 = (unsigned long long*)h2 + lane;
#pragma unroll
        for (int j = 0; j < 4; ++j) { const f32x4 gg = ((const f32x4*)g2)[lane + 64 * j];
            o8[64 * j] = (unsigned long long)pk2(v[j].x * r2 * gg.x, v[j].y * r2 * gg.y) | ((unsigned long long)pk2(v[j].z * r2 * gg.z, v[j].w * r2 * gg.w) << 32); }
    }
}

__device__ __forceinline__ void gmlp_body(Frame& F, const bf16* gv, const float* gain, const float* bias, const float* wsp, const float* bsp, bf16* mix) {
    LAS float* stats = (LAS float*)F.lds;
    LAS float* vn = (LAS float*)(F.lds + 1024);
    LAS float* wl = (LAS float*)(F.lds + 1024 + 65536);
    const int lane = opq(lane_id()), tid = F.wave * 64 + lane;
    for (int chunk = F.vcu; chunk < T / CHUNK; chunk += F.G) {
        const int base = chunk * CHUNK;
        for (int r = F.wave; r < CHUNK; r += NWAVES) {
            float v[12]; float s = 0.f;
#pragma unroll
            for (int j = 0; j < 12; ++j) { v[j] = bf2f(gv[(size_t)(base + r) * 768 + lane + 64 * j]); s += v[j]; }
            const float mu = wave_sum(s) * (1.f / 768.f); float q = 0.f;
#pragma unroll
            for (int j = 0; j < 12; ++j) { const float d = v[j] - mu; q += d * d; }
            const float rstd = rsqrtf(wave_sum(q) * (1.f / 768.f) + EPS);
            if (lane == 0) { stats[2 * r] = mu; stats[2 * r + 1] = rstd; }
        }
        __syncthreads();
        for (int g = 0; g < 6; ++g) {
            for (int i = tid; i < CHUNK * 128; i += NWAVES * 64) { const int s = i >> 7, d = i & 127, ch = g * 128 + d;
                vn[i] = (bf2f(gv[(size_t)(base + s) * 768 + ch]) - stats[2 * s]) * stats[2 * s + 1] * gain[ch] + bias[ch];
                wl[i] = wsp[(size_t)g * CHUNK * CHUNK + i]; }
            __syncthreads();
            const int d = tid & 127, tq = tid >> 7;
            for (int i = 0; i < 32; ++i) { const int tl = tq + 4 * i; float a = 0.f;
                for (int s = 0; s <= tl; ++s) a += wl[tl * 128 + s] * vn[s * 128 + d];
                a += bsp[g * CHUNK + tl];
                const size_t o = (size_t)(base + tl) * 2048 + g * 128 + d;
                mix[o] = (bf16)f2bf(bf2f(mix[o]) * a); }
            __syncthreads();
        }
    }
}
__device__ __forceinline__ void moba_body(Frame& F, bf16* mix, const bf16* kb, const bf16* vb, const float* kmean, const float* relb) {
    LAS float* lg = (LAS float*)F.lds + F.wave * 1024;
    const int lane = opq(lane_id());
    for (int w = F.vcu * NWAVES + F.wave; w < BATCH * NH * SEQ; w += F.G * NWAVES) {
        const int s = w % SEQ, bh = w / SEQ, h = bh % NH, b = bh / NH;
        const int t = b * SEQ + s, cur = s / MBLK;
        float q[64];
#pragma unroll
        for (int d = 0; d < 64; ++d) q[d] = bf2f(mix[(size_t)t * 2048 + 768 + h * 64 + d]);
        float gt[8];
#pragma unroll
        for (int n = 0; n < 8; ++n) { float a = 0.f;
            if (n < cur) { const float* km = kmean + (size_t)(b * NBLK + n) * 768 + h * 64;
#pragma unroll
                for (int d = 0; d < 64; ++d) a += q[d] * km[d]; }
            gt[n] = a; }
        unsigned sel = 0;
#pragma unroll
        for (int n = 0; n < 8; ++n) if (n < cur) { int rank = 0;
#pragma unroll
            for (int m = 0; m < 8; ++m) if (m < cur && m != n) rank += (gt[m] > gt[n] || (gt[m] == gt[n] && m < n)) ? 1 : 0;
            if (rank < 3) sel |= 1u << n; }
        int nslot = 0; float mx = -INFINITY;
        for (int n = 0; n <= cur; ++n) {
            if (n < cur && !((sel >> n) & 1u)) continue;
#pragma unroll
            for (int i = 0; i < 4; ++i) { const int j = lane + 64 * i, kp = n * MBLK + j, dist = s - kp; float l = -INFINITY;
                if (dist >= 0) { const bf16* kr = kb + (size_t)(b * SEQ + kp) * 768 + h * 64; float a = 0.f;
#pragma unroll
                    for (int d = 0; d < 64; ++d) a += q[d] * bf2f(kr[d]);
                    l = a + relb[t5_bucket(dist) * NH + h] * LOG2E; }
                lg[nslot * 256 + j] = l; mx = fmaxf(mx, l); }
            ++nslot;
        }
        mx = wave_max(mx);
        float sum = 0.f; const int nk = nslot * 256;
        for (int j = lane; j < nk; j += 64) { const float p = exp2f(lg[j] - mx); lg[j] = p; sum += p; }
        sum = wave_sum(sum);
        asm volatile("s_waitcnt lgkmcnt(0)" ::: "memory");
        float o = 0.f; int slot = 0;
        for (int n = 0; n <= cur; ++n) {
            if (n < cur && !((sel >> n) & 1u)) continue;
            const int jmax = (n == cur) ? (s - cur * MBLK + 1) : MBLK;
            for (int j = 0; j < jmax; ++j) o += lg[slot * 256 + j] * bf2f(vb[(size_t)(b * SEQ + n * MBLK + j) * 768 + h * 64 + lane]);
            ++slot;
        }
        mix[(size_t)t * 2048 + 768 + h * 64 + lane] = (bf16)f2bf(o / sum);
        asm volatile("s_waitcnt lgkmcnt(0)" ::: "memory");
    }
}
__device__ __forceinline__ void memattn_body(Frame& F, bf16* mix, const bf16* memkv) {
    LAS float* lg = (LAS float*)(F.lds + 32768) + F.wave * 256;
    const int lane = opq(lane_id());
    for (int w = F.vcu * NWAVES + F.wave; w < BATCH * MH * SEQ; w += F.G * NWAVES) {
        const int s = w % SEQ, bh = w / SEQ, h = bh % MH, b = bh / MH;
        const int t = b * SEQ + s;
        float mx = -INFINITY;
#pragma unroll
        for (int i = 0; i < 4; ++i) { const int m = lane + 64 * i;
            const bf16* kr = memkv + (size_t)(b * MEMLEN + m) * 1024 + h * 128; float a = 0.f;
            for (int d = 0; d < 128; ++d) a += bf2f(mix[(size_t)t * 2048 + 1536 + h * 128 + d]) * bf2f(kr[d]);
            lg[m] = a; mx = fmaxf(mx, a); }
        mx = wave_max(mx);
        float sum = 0.f;
#pragma unroll
        for (int i = 0; i < 4; ++i) { const int m = lane + 64 * i; const float p = exp2f(lg[m] - mx); lg[m] = p; sum += p; }
        sum = wave_sum(sum);
        asm volatile("s_waitcnt lgkmcnt(0)" ::: "memory");
        float o0 = 0.f, o1 = 0.f;
        for (int m = 0; m < MEMLEN; ++m) { const bf16* vr = memkv + (size_t)(b * MEMLEN + m) * 1024 + 512 + h * 128;
            const float p = lg[m]; o0 += p * bf2f(vr[lane]); o1 += p * bf2f(vr[lane + 64]); }
        mix[(size_t)t * 2048 + 1536 + h * 128 + lane] = (bf16)f2bf(o0 / sum);
        mix[(size_t)t * 2048 + 1536 + h * 128 + lane + 64] = (bf16)f2bf(o1 / sum);
        asm volatile("s_waitcnt lgkmcnt(0)" ::: "memory");
    }
}

__global__ void __launch_bounds__(NWAVES * 64, 2) mega_fwd(Args args) {
    extern __shared__ __attribute__((aligned(16))) unsigned char lds_raw[];
    cg::grid_group grid = cg::this_grid();
    Frame F;
    F.lds = (LAS unsigned char*)lds_raw;
    F.wave = __builtin_amdgcn_readfirstlane((int)threadIdx.x >> 6);
    F.G = gridDim.x; { const int bx = blockIdx.x; F.vcu = (F.G % 8 == 0) ? (bx % 8) * (F.G / 8) + bx / 8 : bx; }
    unsigned char* ws = args.ws; unsigned char* dob = (unsigned char*)args.out;
    const float* x = args.in[0]; const float* mem = args.in[1];
    const float *ln_mix_pre = args.in[2], *ln_mix_post = args.in[3], *ln_ffn_pre = args.in[4], *ln_ffn_post = args.in[5], *ln_mem = args.in[6];
    bf16* H = (bf16*)(dob + DO_H); bf16* MERGED = H; bf16* MEMN = (bf16*)(dob + DO_MEMN);
    bf16 *WCAT = (bf16*)(dob + DO_WCAT), *WOUT = (bf16*)(dob + DO_WOUT), *WGU = (bf16*)(dob + DO_WGU), *WD = (bf16*)(dob + DO_WD);
    bf16 *WIN = (bf16*)(ws + WS_WIN), *WKV = (bf16*)(ws + WS_WKV), *MEMKV = (bf16*)(ws + WS_MEMKV), *MIX = (bf16*)(ws + WS_MIX);
    bf16 *GV = (bf16*)(ws + WS_GV), *KB = (bf16*)(ws + WS_KB), *VB = (bf16*)(ws + WS_VB), *GATES = (bf16*)(ws + WS_GATES);
    float* KMEAN = (float*)(ws + WS_KMEAN);
    float *Y = (float*)(ws + WS_Y), *FF = (float*)(ws + WS_F), *X1 = (float*)(ws + WS_X1); bf16 *HID = (bf16*)(ws + WS_HID), *H2 = (bf16*)(ws + WS_H2);
    const int gw = F.vcu * NWAVES + F.wave, NGW = F.G * NWAVES;

#define IN(k) (args.ph_lo <= (k) && (k) < args.ph_hi)
#define SEAM(k) do { if (IN(k) && IN((k) + 1)) grid.sync(); } while (0)
    if (IN(0)) {
        LAS float* scr = (LAS float*)(F.lds + F.wave * 16384);
        const int lane0 = opq(lane_id());
        constexpr int I_IN = 16 * (INW / 32), I_KV = 16 * 32, I_A = 12 * 32, I_C = 8 * 32, I_O = 16 * 32, I_G = 16 * (DFF / 32), I_D = (DFF / 64) * 32;
        constexpr int NITEMS = I_IN + I_KV + 2 * I_A + I_C + I_O + 2 * I_G + I_D;
        for (int it = gw; it < NITEMS; it += NGW) {
            int r = it;
            if (r < I_IN) { p0_transpose_item(args.in[7], 1024, INW, WIN, 1024, 0, 0, scr, r, lane0); continue; } r -= I_IN;
            if (r < I_KV) { p0_transpose_item(args.in[13], 1024, 1024, WKV, 1024, 0, 0, scr, r, lane0); continue; } r -= I_KV;
            if (r < I_A) { p0_transpose_item(args.in[14], 768, 1024, WCAT, 2048, 0, 0, scr, r, lane0); continue; } r -= I_A;
            if (r < I_A) { p0_transpose_item(args.in[15], 768, 1024, WCAT, 2048, 768, 0, scr, r, lane0); continue; } r -= I_A;
            if (r < I_C) { p0_transpose_item(args.in[16], 512, 1024, WCAT, 2048, 1536, 0, scr, r, lane0); continue; } r -= I_C;
            if (r < I_O) { p0_transpose_item(args.in[17], 1024, 1024, WOUT, 1024, 0, 0, scr, r, lane0); continue; } r -= I_O;
            if (r < I_G) { p0_transpose_item(args.in[18], 1024, DFF, WGU, 1024, 0, 1, scr, r, lane0); continue; } r -= I_G;
            if (r < I_G) { p0_transpose_item(args.in[19], 1024, DFF, WGU, 1024, 0, 2, scr, r, lane0); continue; } r -= I_G;
            p0_transpose_item(args.in[20], DFF, 1024, WD, DFF, 0, 0, scr, r, lane0);
        }
        for (int m = gw; m < T; m += NGW) rms_row_bf16(x + (size_t)m * DM, ln_mix_pre, H + (size_t)m * DM, lane0);
        for (int m = gw; m < TM; m += NGW) rms_row_bf16(mem + (size_t)m * DM, ln_mem, MEMN + (size_t)m * DM, lane0);
        for (int i = blockIdx.x * (NWAVES * 64) + F.wave * 64 + lane0; i < BATCH * NBLK * 768; i += F.G * NWAVES * 64) KMEAN[i] = 0.f;
    }
    SEAM(0);
    if (IN(1)) {
        pg8::Gemm g{H, WIN, T, INW, 1024}; pg8::StaticOrder S; S.init(T, INW, F.G, (int)blockIdx.x);
        pg8::EpiProj E{MIX, GV, KB, VB, GATES, KMEAN};
        if (DBG_P1 & 1) pg8::gemm_phase<pg8::EpiProj, pg8::StaticOrder, true, true>(F.lds, g, S, E, F.wave);
        pg8::Gemm g2{MEMN, WKV, TM, 1024, 1024}; pg8::StaticOrder S2; S2.init(TM, 1024, F.G, (int)blockIdx.x);
        pg8::EpiBf16Plain E2{MEMKV, 1024};
        if (DBG_P1 & 2) pg8::gemm_phase<pg8::EpiBf16Plain, pg8::StaticOrder, true, true>(F.lds, g2, S2, E2, F.wave);
    }
    SEAM(1);
    if (IN(2)) {
    gmlp_body(F, GV, args.in[8], args.in[9], args.in[10], args.in[11], MIX);
#if DBG_NAIVE_MOBA
    moba_body(F, MIX, KB, VB, KMEAN, args.in[12]);
#else
    { __syncthreads();
      const mattn::AttnTensors AT{(const mattn::bf16*)MIX, (const mattn::bf16*)KB, (const mattn::bf16*)VB, (mattn::bf16*)MIX, KMEAN, args.in[12]};
      mattn::attn_phase<8>((char*)lds_raw, AT, F.vcu, F.G);
      __syncthreads(); }
#endif
    memattn_body(F, MIX, MEMKV);
    }
    SEAM(2);
    if (IN(3)) {
        pg8::Gemm g{MIX, WCAT, T, 1024, 2048}; pg8::StaticOrder S; S.init(T, 1024, F.G, (int)blockIdx.x);
        pg8::EpiMerge E{GATES, MERGED};
        pg8::gemm_phase<pg8::EpiMerge, pg8::StaticOrder, true, true, true>(F.lds, g, S, E, F.wave);
    }
    SEAM(3);
    if (IN(4)) {
        pg8::Gemm g{MERGED, WOUT, T, 1024, 1024}; pg8::StaticOrder S; S.init(T, 1024, F.G, (int)blockIdx.x);
        pg8::EpiF32 E{Y, 1024};
        pg8::gemm_phase<pg8::EpiF32, pg8::StaticOrder, true, true>(F.lds, g, S, E, F.wave);
    }
    SEAM(4);
    if (IN(5)) for (int m = gw; m < T; m += NGW) post_norm_row(x + (size_t)m * DM, Y + (size_t)m * DM, ln_mix_post, X1 + (size_t)m * DM, ln_ffn_pre, H2 + (size_t)m * DM, lane_id());
    SEAM(5);
    if (IN(6)) {
        pg8::Gemm g{H2, WGU, T, 2 * DFF, 1024}; pg8::StaticOrder S; S.init(T, 2 * DFF, F.G, (int)blockIdx.x);
        pg8::EpiSwiGLU E{HID, DFF};
        pg8::gemm_phase<pg8::EpiSwiGLU, pg8::StaticOrder, true, true>(F.lds, g, S, E, F.wave);
    }
    SEAM(6);
    if (IN(7)) {
        pg8::Gemm g{HID, WD, T, 1024, DFF}; pg8::StaticOrder S; S.init(T, 1024, F.G, (int)blockIdx.x);
        pg8::EpiF32 E{FF, 1024};
        pg8::gemm_phase<pg8::EpiF32, pg8::StaticOrder, true, true>(F.lds, g, S, E, F.wave);
    }
    SEAM(7);
    if (IN(8)) for (int m = gw; m < T; m += NGW) post_norm_row(X1 + (size_t)m * DM, FF + (size_t)m * DM, ln_ffn_post, args.out + (size_t)m * DM, nullptr, nullptr, lane_id());
}

extern "C" void kernel_launch(void* const* d_in, const int* in_sizes, int n_in, void* d_out, int out_size, void* d_ws, size_t ws_size, hipStream_t stream) {
    static int grid = 0;
    if (grid == 0) {
        if (n_in != 21 || out_size != T * DM || ws_size < WS_NEED) { fprintf(stderr, "kernel_launch: unexpected shapes (n_in %d out %d ws %zu)\n", n_in, out_size, ws_size); grid = -1; return; }
        int dev = 0, cus = 0, per_cu = 0;
        if (hipGetDevice(&dev) != hipSuccess || hipDeviceGetAttribute(&cus, hipDeviceAttributeMultiprocessorCount, dev) != hipSuccess) { grid = -1; return; }
        if (hipFuncSetAttribute((const void*)mega_fwd, hipFuncAttributeMaxDynamicSharedMemorySize, LDS_BYTES) != hipSuccess) { fprintf(stderr, "kernel_launch: hipFuncSetAttribute failed\n"); grid = -1; return; }
        if (hipOccupancyMaxActiveBlocksPerMultiprocessor(&per_cu, (const void*)mega_fwd, NWAVES * 64, LDS_BYTES) != hipSuccess || per_cu < 1) { fprintf(stderr, "kernel_launch: occupancy query says %d\n", per_cu); per_cu = 1; }
        (void)hipGetLastError();
        grid = cus;
    }
    if (grid < 0) return;
    Args a{};
    for (int i = 0; i < 21; ++i) a.in[i] = (const float*)d_in[i];
    a.out = (float*)d_out; a.ws = (unsigned char*)d_ws;
#ifndef MK_PER_PHASE
#define MK_PER_PHASE 0
#endif
    if (MK_PER_PHASE) {
        for (int p = 0; p < 9; ++p) { a.ph_lo = p; a.ph_hi = p + 1; hipLaunchKernelGGL(mega_fwd, dim3(grid), dim3(NWAVES * 64), LDS_BYTES, stream, a); }
    } else {
        a.ph_lo = 0; a.ph_hi = 9;
        void* kargs[] = {&a};
        hipError_t e = hipLaunchCooperativeKernel((const void*)mega_fwd, dim3(grid), dim3(NWAVES * 64), kargs, LDS_BYTES, stream);
        if (e != hipSuccess) fprintf(stderr, "kernel_launch: cooperative launch failed: %s (grid %d)\n", hipGetErrorString(e), grid);
    }
}
```

```cpp
#include <hip/hip_runtime.h>
#include <hip/hip_cooperative_groups.h>
#include <cstdio>
#include <cstdint>
namespace cg = cooperative_groups;

typedef unsigned short bf16;
typedef unsigned v4u __attribute__((ext_vector_type(4)));
typedef float f32x4 __attribute__((ext_vector_type(4)));
#define LAS __attribute__((address_space(3)))
#define GAS __attribute__((address_space(1)))

constexpr int BATCH = 16, SEQ = 2048, DM = 1024, T = BATCH * SEQ;
constexpr int MEMLEN = 256, TM = BATCH * MEMLEN;
constexpr int CHUNK = 128;
constexpr int NH = 12, MBLK = 256, NBLK = SEQ / MBLK;
constexpr int MH = 4;
constexpr int DFF = 2816, INW = 7424;
constexpr float EPS = 1e-6f;
constexpr float LOG2E = 1.4426950408889634f;
constexpr float C2Q = 0.125f * LOG2E;
constexpr float C2M = 0.08838834764831845f * LOG2E;

constexpr size_t MiB = 1u << 20;
constexpr size_t DO_H = 0;
constexpr size_t DO_MEMN = 64 * MiB;
constexpr size_t DO_WCAT = 72 * MiB;
constexpr size_t DO_WOUT = 76 * MiB;
constexpr size_t DO_WGU = 78 * MiB;
constexpr size_t DO_WD = 89 * MiB;
constexpr size_t WS_CTL = 0;
constexpr size_t WS_KMEAN = 256 * 1024;
constexpr size_t WS_WIN = 1 * MiB;
constexpr size_t WS_WKV = 16 * MiB;
constexpr size_t WS_MEMKV = 18 * MiB;
constexpr size_t WS_MIX = 26 * MiB;
constexpr size_t WS_GV = 154 * MiB;
constexpr size_t WS_KB = 202 * MiB;
constexpr size_t WS_VB = 250 * MiB;
constexpr size_t WS_GATES = 298 * MiB;
constexpr size_t WS_Y = 26 * MiB;
constexpr size_t WS_HID = 26 * MiB;
constexpr size_t WS_F = 202 * MiB;
constexpr size_t WS_H2 = 320 * MiB;
constexpr size_t WS_X1 = 384 * MiB;
constexpr size_t WS_NEED = 512 * MiB;

__device__ __forceinline__ float bf2f(bf16 v) { return __uint_as_float((unsigned)v << 16); }
__device__ __forceinline__ unsigned f2bf(float f) { unsigned u = __float_as_uint(f); return (u + 0x7fffu + ((u >> 16) & 1u)) >> 16; }
__device__ __forceinline__ unsigned pk2(float lo, float hi) { return f2bf(lo) | (f2bf(hi) << 16); }
__device__ __forceinline__ float wave_sum(float v) {
#pragma unroll
    for (int o = 1; o < 64; o <<= 1) v += __shfl_xor(v, o);
    return v;
}
__device__ __forceinline__ float wave_max(float v) {
#pragma unroll
    for (int o = 1; o < 64; o <<= 1) v = fmaxf(v, __shfl_xor(v, o));
    return v;
}
__device__ __forceinline__ float fast_sigmoid(float x) { return __builtin_amdgcn_rcpf(1.0f + __builtin_amdgcn_exp2f(-LOG2E * x)); }
__device__ __forceinline__ float gelu_tanh(float x) {
    const float u = 0.7978845608028654f * (x + 0.044715f * x * x * x);
    return x * __builtin_amdgcn_rcpf(1.0f + __builtin_amdgcn_exp2f(-2.0f * LOG2E * u));
}
__device__ __forceinline__ int t5_bucket(int n) {
    if (n < 16) return n;
    int large = 16 + (int)(logf((float)n / 16.0f) / 2.0794415416798357f * 16.0f);
    return large < 31 ? large : 31;
}
namespace pg8 {
#define PG8_LAS __attribute__((address_space(3)))
typedef unsigned short bf16_t;
typedef short bf16x8 __attribute__((ext_vector_type(8)));
typedef float f32x4 __attribute__((ext_vector_type(4)));
typedef unsigned u32x4 __attribute__((ext_vector_type(4)));
constexpr int BM = 256, BK = 64, HALF = 128, HTB = HALF * BK * 2  , STAGE_BYTES = 8 * HTB, NXCD = 8, WGM = 8;

__host__ __device__ __forceinline__ int lds_byte(int r, int c) { const int st = (r >> 4) * 2 + (c >> 5), rr = r & 15, cc = c & 31, ob = rr * 64 + cc * 2; return st * 1024 + (ob ^ (((ob >> 9) & 1) << 5)); }
__host__ __device__ __forceinline__ void stage_rc(int b, int& R, int& C) { const int st = b / 1024, sb = b % 1024, swz = sb ^ (((sb >> 9) & 1) << 5); R = (st >> 1) * 16 + swz / 64; C = (st & 1) * 32 + (swz % 64) / 2; }
__host__ __device__ __forceinline__ int perm32(int rho) { const int n = rho >> 4, i = rho & 15; return 8 * (i >> 2) + 4 * n + (i & 3); }

struct Unit { int pm, pn; };
struct Gemm { const bf16_t* A; const bf16_t* Bt; int M, N, K; };

struct StaticOrder {
    int nM, nN, nwg, G, c;
    __host__ __device__ void init(int M, int N, int G_, int c_) { nM = M / BM; nN = N / BM; nwg = nM * nN; G = G_; c = c_; }
    __host__ __device__ bool next(int i, Unit& u) const {
        const long L = (long)i * G + c; if (L >= nwg) return false;
        int wgid = (int)L; { const int q = nwg / NXCD, r = nwg % NXCD, xcd = wgid % NXCD, off = wgid / NXCD; wgid = (xcd < r ? xcd * (q + 1) : r * (q + 1) + (xcd - r) * q) + off; }
        const int nig = WGM * nN, gid = wgid / nig, fm = gid * WGM, gsz = (nM - fm) < WGM ? (nM - fm) : WGM;
        u.pm = fm + ((wgid % nig) % gsz); u.pn = (wgid % nig) / gsz; return true;
    }
    __device__ __forceinline__ void a_ready(const Unit&) const {}
    __device__ __forceinline__ void done(const Unit&) const {}
};
#ifndef DBG_RAW
#define DBG_RAW 0
#endif
#ifndef DBG_NO_KMEAN
#define DBG_NO_KMEAN 0
#endif
typedef float f32x2_t __attribute__((ext_vector_type(2))); typedef __bf16 bf16x2_t __attribute__((ext_vector_type(2)));
__device__ __forceinline__ unsigned cvt_pk_bf16(float lo, float hi) { f32x2_t v = {lo, hi}; bf16x2_t b = __builtin_convertvector(v, bf16x2_t); return __builtin_bit_cast(unsigned, b); }

template <int ACT> __device__ __forceinline__ f32x4 act4(f32x4 v, float sc) {
    if (ACT == 0) return v * sc;
    f32x4 o;
#pragma unroll
    for (int j = 0; j < 4; ++j) o[j] = (ACT == 1) ? gelu_tanh(v[j]) : fast_sigmoid(v[j]);
    return o;
}
template <int ACT> __device__ __forceinline__ void store_tile_bf16(const f32x4 (&acc)[2][2][4][2], bf16_t* base, int ld, int row0, int col0, float sc) {
#pragma unroll
    for (int ai = 0; ai < 2; ++ai)
#pragma unroll
        for (int m = 0; m < 4; ++m) { bf16_t* rowp = base + (size_t)(row0 + ai * HALF + m * 16) * ld + col0;
#pragma unroll
            for (int bj = 0; bj < 2; ++bj) { const f32x4 v0 = act4<ACT>(acc[ai][bj][m][0], sc), v1 = act4<ACT>(acc[ai][bj][m][1], sc);
                u32x4 w; w.x = cvt_pk_bf16(v0[0], v0[1]); w.y = cvt_pk_bf16(v0[2], v0[3]); w.z = cvt_pk_bf16(v1[0], v1[1]); w.w = cvt_pk_bf16(v1[2], v1[3]);
                *(u32x4*)(rowp + bj * HALF) = w; } }
}
struct EpiProj {
    static constexpr bool PERM = true, AFTER_DRAIN = false;
    bf16_t *mix, *gv, *kb, *vb, *gates; float* kmean;
    __device__ __forceinline__ void operator()(const f32x4 (&acc)[2][2][4][2], const Unit& u, int wr, int wc, int fr, int fq) const {
        const int pn = u.pn, row0 = u.pm * BM + wr * 64 + fr, cw = wc * 32 + 8 * fq;
#if DBG_RAW
        if (pn < 3) store_tile_bf16<0>(acc, mix, 2048, row0, pn * 256 + cw, 1.f);
        else if (pn < 6) store_tile_bf16<0>(acc, gv, 768, row0, (pn - 3) * 256 + cw, 1.f);
        else if (pn < 9) store_tile_bf16<0>(acc, mix, 2048, row0, 768 + (pn - 6) * 256 + cw, 1.f);
#else
        if (pn < 3) store_tile_bf16<1>(acc, mix, 2048, row0, pn * 256 + cw, 1.f);
        else if (pn < 6) store_tile_bf16<1>(acc, gv, 768, row0, (pn - 3) * 256 + cw, 1.f);
        else if (pn < 9) store_tile_bf16<0>(acc, mix, 2048, row0, 768 + (pn - 6) * 256 + cw, C2Q);
#endif
        else if (pn < 12) {
            store_tile_bf16<0>(acc, kb, 768, row0, (pn - 9) * 256 + cw, 1.f);
#pragma unroll
            for (int bj = 0; bj < 2; ++bj)
#pragma unroll
                for (int n = 0; n < 2; ++n) { f32x4 s = (f32x4){0.f, 0.f, 0.f, 0.f};
#pragma unroll
                    for (int ai = 0; ai < 2; ++ai)
#pragma unroll
                        for (int m = 0; m < 4; ++m) s += acc[ai][bj][m][n];
#pragma unroll
                    for (int j = 0; j < 4; ++j) { float v = s[j]; v += __shfl_xor(v, 1); v += __shfl_xor(v, 2); v += __shfl_xor(v, 4); v += __shfl_xor(v, 8);
                        if (fr == 0 && !DBG_NO_KMEAN) atomicAdd(kmean + (size_t)u.pm * 768 + (pn - 9) * 256 + bj * HALF + cw + 4 * n + j, v * (1.0f / 256.0f)); } }
        }
        else if (pn < 15) store_tile_bf16<0>(acc, vb, 768, row0, (pn - 12) * 256 + cw, 1.f);
#if DBG_RAW
        else if (pn < 17) store_tile_bf16<0>(acc, mix, 2048, row0, 1536 + (pn - 15) * 256 + cw, 1.f);
        else store_tile_bf16<0>(acc, gates, 3072, row0, (pn - 17) * 256 + cw, 1.f);
#else
        else if (pn < 17) store_tile_bf16<0>(acc, mix, 2048, row0, 1536 + (pn - 15) * 256 + cw, C2M);
        else store_tile_bf16<2>(acc, gates, 3072, row0, (pn - 17) * 256 + cw, 1.f);
#endif
    }
};
struct EpiBf16Plain {
    static constexpr bool PERM = true, AFTER_DRAIN = false;
    bf16_t* O; int ld;
    __device__ __forceinline__ void operator()(const f32x4 (&acc)[2][2][4][2], const Unit& u, int wr, int wc, int fr, int fq) const {
        store_tile_bf16<0>(acc, O, ld, u.pm * BM + wr * 64 + fr, u.pn * BM + wc * 32 + 8 * fq, 1.f);
    }
};
struct EpiF32 {
    static constexpr bool PERM = false, AFTER_DRAIN = false;
    float* O; int ld;
    __device__ __forceinline__ void operator()(const f32x4 (&acc)[2][2][4][2], const Unit& u, int wr, int wc, int fr, int fq) const {
        const int row0 = u.pm * BM + wr * 64 + fr, col0 = u.pn * BM + wc * 32 + 4 * fq;
#pragma unroll
        for (int ai = 0; ai < 2; ++ai)
#pragma unroll
            for (int m = 0; m < 4; ++m) { float* rowp = O + (size_t)(row0 + ai * HALF + m * 16) * ld + col0;
#pragma unroll
                for (int bj = 0; bj < 2; ++bj)
#pragma unroll
                    for (int n = 0; n < 2; ++n) *(f32x4*)(rowp + bj * HALF + n * 16) = acc[ai][bj][m][n]; }
    }
};
struct EpiSwiGLU {
    static constexpr bool PERM = true, AFTER_DRAIN = false;
    bf16_t* O; int ld;
    __device__ __forceinline__ void operator()(const f32x4 (&acc)[2][2][4][2], const Unit& u, int wr, int wc, int fr, int fq) const {
        const int row0 = u.pm * BM + wr * 64 + fr, col0 = u.pn * HALF + wc * 32 + 8 * fq;
#pragma unroll
        for (int ai = 0; ai < 2; ++ai)
#pragma unroll
            for (int m = 0; m < 4; ++m) { f32x4 h[2];
#pragma unroll
                for (int n = 0; n < 2; ++n)
#pragma unroll
                    for (int j = 0; j < 4; ++j) { const float g = acc[ai][0][m][n][j]; h[n][j] = g * fast_sigmoid(g) * acc[ai][1][m][n][j]; }
                u32x4 w; w.x = cvt_pk_bf16(h[0][0], h[0][1]); w.y = cvt_pk_bf16(h[0][2], h[0][3]); w.z = cvt_pk_bf16(h[1][0], h[1][1]); w.w = cvt_pk_bf16(h[1][2], h[1][3]);
                *(u32x4*)(O + (size_t)(row0 + ai * HALF + m * 16) * ld + col0) = w; }
    }
};
struct EpiMerge {
    static constexpr bool PERM = true, AFTER_DRAIN = false;
    const bf16_t* gates; bf16_t* O;
    __device__ __forceinline__ bool want_mid(int t) const { return t == 12 || t == 24; }
    __device__ __forceinline__ void mid(f32x4 (&acc)[2][2][4][2], const Unit& u, int t, int wr, int wc, int fr, int fq) const {
        const int seg = (t == 12) ? 0 : 1;
        int row0 = u.pm * BM + wr * 64 + fr; asm volatile("" : "+v"(row0));
        const int col0 = u.pn * BM + wc * 32 + 8 * fq;
#pragma unroll
        for (int ai = 0; ai < 2; ++ai)
#pragma unroll
            for (int m = 0; m < 4; ++m) { const bf16_t* gp = gates + (size_t)(row0 + ai * HALF + m * 16) * 3072 + seg * 1024 + col0;
#pragma unroll
                for (int bj = 0; bj < 2; ++bj) { const u32x4 ga = *(const u32x4*)(gp + bj * HALF), gb = *(const u32x4*)(gp + 1024 + bj * HALF);
#pragma unroll
                    for (int e = 0; e < 8; ++e) { const unsigned wa = ga[e >> 1], wb = gb[e >> 1];
                        const float a = __uint_as_float((e & 1) ? (wa & 0xffff0000u) : (wa << 16)), b = __uint_as_float((e & 1) ? (wb & 0xffff0000u) : (wb << 16));
                        acc[ai][bj][m][e >> 2][e & 3] *= a * __builtin_amdgcn_rcpf(b); } } }
    }
    __device__ __forceinline__ void operator()(const f32x4 (&acc)[2][2][4][2], const Unit& u, int wr, int wc, int fr, int fq) const {
        int row0 = u.pm * BM + wr * 64 + fr; asm volatile("" : "+v"(row0));
        const int col0 = u.pn * BM + wc * 32 + 8 * fq;
#pragma unroll
        for (int ai = 0; ai < 2; ++ai)
#pragma unroll
            for (int m = 0; m < 4; ++m) { const size_t r = (size_t)(row0 + ai * HALF + m * 16);
#pragma unroll
                for (int bj = 0; bj < 2; ++bj) { const u32x4 ga = *(const u32x4*)(gates + r * 3072 + 2048 + col0 + bj * HALF); float o[8];
#pragma unroll
                    for (int e = 0; e < 8; ++e) { const unsigned wa = ga[e >> 1]; o[e] = acc[ai][bj][m][e >> 2][e & 3] * __uint_as_float((e & 1) ? (wa & 0xffff0000u) : (wa << 16)); }
                    u32x4 w; w.x = cvt_pk_bf16(o[0], o[1]); w.y = cvt_pk_bf16(o[2], o[3]); w.z = cvt_pk_bf16(o[4], o[5]); w.w = cvt_pk_bf16(o[6], o[7]);
                    *(u32x4*)(O + r * 1024 + col0 + bj * HALF) = w; } }
    }
};
template <class Epi, class Sched, bool ALIGN_EPI = false, bool SP2 = false, bool MID = false>
__device__ __forceinline__ void gemm_phase(PG8_LAS unsigned char* lds, const Gemm g, const Sched& S, const Epi& E, int wave_id) {
    int tid_ = wave_id * 64 + (int)__builtin_amdgcn_mbcnt_hi(~0u, __builtin_amdgcn_mbcnt_lo(~0u, 0u)); asm volatile("" : "+v"(tid_));
    const int tid = tid_, wid = __builtin_amdgcn_readfirstlane(tid >> 6), lane = tid & 63, wr = wid >> 2, wc = wid & 3, fr = lane & 15, fq = lane >> 4;
    const int K = g.K, nt = K / BK;
    unsigned voffA[2], voffB[2];
#pragma unroll
    for (int i = 0; i < 2; ++i) { int R, C; stage_rc(tid * 16 + i * 8192, R, C); const int Rb = Epi::PERM ? ((R & ~31) + perm32(R & 31)) : R;
        voffA[i] = (unsigned)(R * K + C) * 2u; voffB[i] = (unsigned)(Rb * K + C) * 2u; }
    const size_t kstep = (size_t)(BK * 2);
    const size_t hstep = (size_t)HALF * K * 2;
    const size_t tstep = 2 * hstep;
    const unsigned ldsw = (unsigned)wid * 1024u;
    const int aoff = lds_byte(wr * 64 + fr, fq * 8), boff = lds_byte(wc * 32 + fr, fq * 8);
#define PG8_SA(b, h) (((b) * 2 + (h)) * HTB)
#define PG8_SB(b, h) ((4 + (b) * 2 + (h)) * HTB)
#define PG8_STAGE(bufoff, gbase, voff) do { _Pragma("unroll") for (int _i = 0; _i < 2; ++_i) \
        __builtin_amdgcn_global_load_lds((const unsigned*)((const char*)(gbase) + (voff)[_i]), (PG8_LAS unsigned*)(lds + (bufoff) + ldsw + _i * 8192), 16, 0, 0); } while (0)
#define PG8_LDA(dst, b, h) do { _Pragma("unroll") for (int m = 0; m < 4; ++m) _Pragma("unroll") for (int k = 0; k < 2; ++k) dst[m][k] = *(const PG8_LAS bf16x8*)(lds + PG8_SA(b, h) + aoff + m * 2048 + k * 1024); } while (0)
#define PG8_LDB(dst, b, h) do { _Pragma("unroll") for (int n = 0; n < 2; ++n) _Pragma("unroll") for (int k = 0; k < 2; ++k) dst[n][k] = *(const PG8_LAS bf16x8*)(lds + PG8_SB(b, h) + boff + n * 2048 + k * 1024); } while (0)
#define PG8_MMA(ai, bj, At, Bt) do { __builtin_amdgcn_s_setprio(1); _Pragma("unroll") for (int m = 0; m < 4; ++m) _Pragma("unroll") for (int n = 0; n < 2; ++n) _Pragma("unroll") for (int k = 0; k < 2; ++k) \
        acc[ai][bj][m][n] = __builtin_amdgcn_mfma_f32_16x16x32_bf16(Bt[n][k], At[m][k], acc[ai][bj][m][n], 0, 0, 0); __builtin_amdgcn_s_setprio(0); } while (0)
#define PG8_WAIT_V(n) asm volatile("s_waitcnt vmcnt(" #n ")" ::: "memory")
#define PG8_WAIT_L(n) asm volatile("s_waitcnt lgkmcnt(" #n ")" ::: "memory")
#define PG8_BAR __builtin_amdgcn_s_barrier()
#define PG8_SCHED __builtin_amdgcn_sched_barrier(0)
    Unit cur, nxt; int ui = 0;
    if (!S.next(0, cur)) return;
    f32x4 acc[2][2][4][2];
#pragma unroll
    for (int a = 0; a < 2; ++a)
#pragma unroll
        for (int b = 0; b < 2; ++b)
#pragma unroll
            for (int m = 0; m < 4; ++m)
#pragma unroll
                for (int n = 0; n < 2; ++n) acc[a][b][m][n] = (f32x4){0.f, 0.f, 0.f, 0.f};
    bf16x8 At[4][2], B0[2][2], B1[2][2];
    const char* cA = (const char*)g.A + (size_t)cur.pm * tstep; const char* cB = (const char*)g.Bt + (size_t)cur.pn * tstep;
    S.a_ready(cur);
    if constexpr (SP2) {
        PG8_STAGE(PG8_SB(0, 0), cB, voffB); PG8_STAGE(PG8_SB(0, 1), cB + hstep, voffB); PG8_STAGE(PG8_SA(0, 0), cA, voffA); PG8_STAGE(PG8_SA(0, 1), cA + hstep, voffA);
        if (wr == 1) PG8_BAR;
        PG8_WAIT_V(2); PG8_BAR;
        PG8_STAGE(PG8_SB(1, 0), cB + kstep, voffB); PG8_STAGE(PG8_SA(1, 0), cA + kstep, voffA); PG8_STAGE(PG8_SB(1, 1), cB + hstep + kstep, voffB);
        PG8_WAIT_V(6); PG8_BAR;
    } else {
        PG8_STAGE(PG8_SB(0, 0), cB, voffB); PG8_STAGE(PG8_SA(0, 0), cA, voffA); PG8_STAGE(PG8_SB(0, 1), cB + hstep, voffB); PG8_STAGE(PG8_SA(0, 1), cA + hstep, voffA);
        if (wr == 1) PG8_BAR;
        PG8_WAIT_V(4); PG8_BAR;
        PG8_STAGE(PG8_SB(1, 0), cB + kstep, voffB); PG8_STAGE(PG8_SA(1, 0), cA + kstep, voffA); PG8_STAGE(PG8_SB(1, 1), cB + hstep + kstep, voffB);
        PG8_WAIT_V(6); PG8_BAR;
    }
    for (;;) {
        const bool has_next = S.next(ui + 1, nxt);
        const char* nA = has_next ? (const char*)g.A + (size_t)nxt.pm * tstep : cA; const char* nB = has_next ? (const char*)g.Bt + (size_t)nxt.pn * tstep : cB;
        for (int t = 0; t < nt; t += 2) {
            const bool last = (t == nt - 2);
            const char* a1 = cA + (size_t)(t + 1) * kstep;
            const char* a2 = last ? nA : cA + (size_t)(t + 2) * kstep; const char* b2 = last ? nB : cB + (size_t)(t + 2) * kstep;
            const char* a3 = a2 + kstep; const char* b3 = b2 + kstep;
            if (last && has_next) S.a_ready(nxt);
            if constexpr (SP2) {
            PG8_LDB(B0, 0, 0); PG8_LDB(B1, 0, 1); PG8_SCHED; PG8_LDA(At, 0, 0); PG8_STAGE(PG8_SA(1, 1), a1 + hstep, voffA);
            PG8_WAIT_V(8); PG8_WAIT_L(0); PG8_BAR; PG8_MMA(0, 0, At, B0); PG8_MMA(0, 1, At, B1); PG8_BAR; PG8_SCHED;
            PG8_LDA(At, 0, 1); PG8_STAGE(PG8_SB(0, 0), b2, voffB); PG8_STAGE(PG8_SB(0, 1), b2 + hstep, voffB); PG8_STAGE(PG8_SA(0, 0), a2, voffA);
            PG8_WAIT_V(8); PG8_WAIT_L(0); PG8_BAR; PG8_MMA(1, 0, At, B0); PG8_MMA(1, 1, At, B1); PG8_BAR; PG8_SCHED;
            PG8_LDB(B0, 1, 0); PG8_LDB(B1, 1, 1); PG8_SCHED; PG8_LDA(At, 1, 0); PG8_STAGE(PG8_SA(0, 1), a2 + hstep, voffA);
            PG8_WAIT_V(8); PG8_WAIT_L(0); PG8_BAR; PG8_MMA(0, 0, At, B0); PG8_MMA(0, 1, At, B1); PG8_BAR; PG8_SCHED;
            PG8_LDA(At, 1, 1); PG8_STAGE(PG8_SB(1, 0), b3, voffB); PG8_STAGE(PG8_SB(1, 1), b3 + hstep, voffB); PG8_STAGE(PG8_SA(1, 0), a3, voffA);
            PG8_WAIT_V(8); PG8_WAIT_L(0); PG8_BAR; PG8_MMA(1, 0, At, B0); PG8_MMA(1, 1, At, B1); PG8_BAR; PG8_SCHED;
            } else {
            PG8_LDB(B0, 0, 0); PG8_SCHED; PG8_LDA(At, 0, 0); PG8_STAGE(PG8_SA(1, 1), a1 + hstep, voffA);
            PG8_WAIT_L(8); PG8_BAR; PG8_WAIT_L(0); PG8_MMA(0, 0, At, B0); PG8_BAR; PG8_SCHED;
            PG8_LDB(B1, 0, 1); PG8_STAGE(PG8_SB(0, 0), b2, voffB);
            PG8_BAR; PG8_WAIT_L(0); PG8_MMA(0, 1, At, B1); PG8_BAR;
            PG8_LDA(At, 0, 1); PG8_STAGE(PG8_SA(0, 0), a2, voffA);
            PG8_BAR; PG8_WAIT_L(0); PG8_MMA(1, 0, At, B0); PG8_BAR; PG8_SCHED;
            PG8_STAGE(PG8_SB(0, 1), b2 + hstep, voffB);
            PG8_WAIT_V(6); PG8_BAR; PG8_MMA(1, 1, At, B1); PG8_BAR;
            PG8_LDB(B0, 1, 0); PG8_SCHED; PG8_LDA(At, 1, 0); PG8_STAGE(PG8_SA(0, 1), a2 + hstep, voffA);
            PG8_WAIT_L(8); PG8_BAR; PG8_WAIT_L(0); PG8_MMA(0, 0, At, B0); PG8_BAR; PG8_SCHED;
            PG8_LDB(B1, 1, 1); PG8_STAGE(PG8_SB(1, 0), b3, voffB);
            PG8_BAR; PG8_WAIT_L(0); PG8_MMA(0, 1, At, B1); PG8_BAR;
            PG8_LDA(At, 1, 1); PG8_STAGE(PG8_SA(1, 0), a3, voffA);
            PG8_BAR; PG8_WAIT_L(0); PG8_MMA(1, 0, At, B0); PG8_BAR; PG8_SCHED;
            PG8_STAGE(PG8_SB(1, 1), b3 + hstep, voffB);
            PG8_WAIT_V(6); PG8_BAR; PG8_MMA(1, 1, At, B1); PG8_BAR;
            }
            if constexpr (MID) { if (E.want_mid(t + 2)) E.mid(acc, cur, t + 2, wr, wc, fr, fq); }
        }
        if constexpr (ALIGN_EPI) { if (wr == 0) PG8_BAR; }
        if constexpr (!Epi::AFTER_DRAIN) { E(acc, cur, wr, wc, fr, fq); S.done(cur); }
        if (!has_next) break;
#pragma unroll
        for (int a = 0; a < 2; ++a)
#pragma unroll
            for (int b = 0; b < 2; ++b)
#pragma unroll
                for (int m = 0; m < 4; ++m)
#pragma unroll
                    for (int n = 0; n < 2; ++n) acc[a][b][m][n] = (f32x4){0.f, 0.f, 0.f, 0.f};
        cur = nxt; cA = nA; cB = nB; ++ui;
        if constexpr (ALIGN_EPI) { if (wr == 1) PG8_BAR; }
    }
    PG8_WAIT_V(0);
    if constexpr (!ALIGN_EPI) { if (wr == 0) PG8_BAR; }
    PG8_BAR;
    if constexpr (Epi::AFTER_DRAIN) { E.fused(acc, cur, wr, wc, fr, fq, lds, wid, lane); S.done(cur); }
#undef PG8_SA
#undef PG8_SB
#undef PG8_STAGE
#undef PG8_LDA
#undef PG8_LDB
#undef PG8_MMA
#undef PG8_WAIT_V
#undef PG8_WAIT_L
#undef PG8_BAR
#undef PG8_SCHED
}
}
#include <hip/hip_bf16.h>
#include <cmath>
namespace mattn {
using bf16=__hip_bfloat16;
using bf16x8=__attribute__((ext_vector_type(8)))short;
using s16x4=__attribute__((ext_vector_type(4)))short;
using f32x16=__attribute__((ext_vector_type(16)))float;
using u32x4=__attribute__((ext_vector_type(4)))unsigned;
typedef float f32x4_t __attribute__((ext_vector_type(4)));
constexpr int SEQ=2048,D=64,QP=2048,KP=768,QCOL=768,NHEADS=12;
constexpr int NW=8,QBLK=32,QB=QBLK*NW,KVBLK=64,NQB=SEQ/QB;
__device__ __forceinline__ int crow(int r,int hi){return (r&3)+8*(r>>2)+4*hi;}
#define SBAR() __builtin_amdgcn_sched_barrier(0)
constexpr int NSLOT=3, SLOTB=8192;
constexpr int LDS_K=0, LDS_V=NSLOT*SLOTB, LDS_WS=2*NSLOT*SLOTB, LDS_OST=LDS_WS+NW*64*4, LDS_TAB=LDS_OST+NW*4096, LDS_BYTES=LDS_TAB+2048;
constexpr float C2=0.125f*1.4426950408889634f;
__device__ __forceinline__ void glds16(const void*gsrc,unsigned lds_dst){unsigned keep;
  asm volatile("s_mov_b32 %0, m0\n\ts_mov_b32 m0, %2\n\ts_nop 0\n\tglobal_load_lds_dwordx4 %1, off\n\ts_mov_b32 m0, %0":"=&s"(keep):"v"(gsrc),"s"(lds_dst):"memory");}
__device__ __forceinline__ float max3f(float a,float b,float c){float r;asm("v_max3_f32 %0, %1, %2, %3":"=v"(r):"v"(a),"v"(b),"v"(c));return r;}
__device__ __forceinline__ float max2f(float a,float b){float r;asm("v_max_f32_e32 %0, %1, %2":"=v"(r):"v"(a),"v"(b));return r;}
__device__ __forceinline__ float fadd_s(float a,float b){float r;asm("v_add_f32_e32 %0, %1, %2":"=v"(r):"v"(a),"v"(b));return r;}
__device__ __forceinline__ float fsub_s(float a,float b){float r;asm("v_sub_f32_e32 %0, %1, %2":"=v"(r):"v"(a),"v"(b));return r;}
typedef float f32x2_t __attribute__((ext_vector_type(2))); typedef __bf16 bf16x2_t __attribute__((ext_vector_type(2)));
__device__ __forceinline__ unsigned cvtpk_s(float lo,float hi){f32x2_t v={lo,hi};bf16x2_t b=__builtin_convertvector(v,bf16x2_t);return __builtin_bit_cast(unsigned,b);}
#define WAIT_BAR(N) asm volatile("s_waitcnt vmcnt(" #N ") lgkmcnt(0)\n\ts_barrier":::"memory")

__device__ __forceinline__ void qkt(f32x16&p0,f32x16&p1,const char*Kslot,const bf16x8*qr,const f32x16&negm,int r32,int hi){
  const char*kb=Kslot+hi*1024+r32*16;
  #pragma unroll
  for(int d0=0;d0<4;++d0){
    const bf16x8 b0=*reinterpret_cast<const bf16x8*>(kb+d0*2048);
    const bf16x8 b1=*reinterpret_cast<const bf16x8*>(kb+d0*2048+512);
    if(d0==0){p0=__builtin_amdgcn_mfma_f32_32x32x16_bf16(b0,qr[0],negm,0,0,0);p1=__builtin_amdgcn_mfma_f32_32x32x16_bf16(b1,qr[0],negm,0,0,0);}
    else{p0=__builtin_amdgcn_mfma_f32_32x32x16_bf16(b0,qr[d0],p0,0,0,0);p1=__builtin_amdgcn_mfma_f32_32x32x16_bf16(b1,qr[d0],p1,0,0,0);}}
}
typedef __attribute__((address_space(3))) const char* lds_cptr;
typedef short v4i16_t __attribute__((ext_vector_type(4)));
__device__ __forceinline__ void kload8(bf16x8*kf,lds_cptr kp){
  kf[0]=*(const __attribute__((address_space(3))) bf16x8*)(kp);      kf[1]=*(const __attribute__((address_space(3))) bf16x8*)(kp+512);
  kf[2]=*(const __attribute__((address_space(3))) bf16x8*)(kp+2048); kf[3]=*(const __attribute__((address_space(3))) bf16x8*)(kp+2560);
  kf[4]=*(const __attribute__((address_space(3))) bf16x8*)(kp+4096); kf[5]=*(const __attribute__((address_space(3))) bf16x8*)(kp+4608);
  kf[6]=*(const __attribute__((address_space(3))) bf16x8*)(kp+6144); kf[7]=*(const __attribute__((address_space(3))) bf16x8*)(kp+6656);
}
__device__ __forceinline__ void kload2(bf16x8*kf,lds_cptr kp,int j){ kf[2*j]=*(const __attribute__((address_space(3))) bf16x8*)(kp+j*2048); kf[2*j+1]=*(const __attribute__((address_space(3))) bf16x8*)(kp+j*2048+512); }
__device__ __forceinline__ s16x4 vtr(lds_cptr p){ return __builtin_bit_cast(s16x4,__builtin_amdgcn_ds_read_tr16_b64_v4i16((__attribute__((address_space(3))) v4i16_t*)p)); }
__device__ __forceinline__ float rowmax(const f32x16&p0,const f32x16&p1){
  float a=max3f(p0[0],p0[1],p1[0]),b=max3f(p0[2],p0[3],p1[1]);a=max3f(a,p1[2],p1[3]);
  #pragma unroll
  for(int r=4;r<16;r+=4){a=max3f(a,p0[r],p0[r+1]);b=max3f(b,p0[r+2],p0[r+3]);a=max3f(a,p1[r],p1[r+1]);b=max3f(b,p1[r+2],p1[r+3]);}
  const float m=max2f(a,b);
  auto rr=__builtin_amdgcn_permlane32_swap(__float_as_uint(m),__float_as_uint(m),false,false);
  return max2f(__uint_as_float(rr[0]),__uint_as_float(rr[1]));
}
__device__ __forceinline__ void pv(f32x16*o,int vb,bf16x8 pa0,bf16x8 pa1,bf16x8 pa2,bf16x8 pa3){
  #pragma unroll
  for(int d0=0;d0<2;++d0){s16x4 lo[4],hi[4];
    #pragma unroll
    for(int ks=0;ks<4;++ks){
      asm volatile("ds_read_b64_tr_b16 %0,%1 offset:%c2":"=&v"(lo[ks]):"v"(vb),"i"(d0*4096+ks*1024):"memory");
      asm volatile("ds_read_b64_tr_b16 %0,%1 offset:%c2":"=&v"(hi[ks]):"v"(vb),"i"(d0*4096+ks*1024+512):"memory");}
    asm volatile("s_waitcnt lgkmcnt(0)":::"memory");SBAR();
    #define PK(k) (bf16x8){lo[k][0],lo[k][1],lo[k][2],lo[k][3],hi[k][0],hi[k][1],hi[k][2],hi[k][3]}
    o[d0]=__builtin_amdgcn_mfma_f32_32x32x16_bf16(pa0,PK(0),o[d0],0,0,0);
    o[d0]=__builtin_amdgcn_mfma_f32_32x32x16_bf16(pa1,PK(1),o[d0],0,0,0);
    o[d0]=__builtin_amdgcn_mfma_f32_32x32x16_bf16(pa2,PK(2),o[d0],0,0,0);
    o[d0]=__builtin_amdgcn_mfma_f32_32x32x16_bf16(pa3,PK(3),o[d0],0,0,0);
    #undef PK
  }
}

#ifndef ATTN_STORE16
#define ATTN_STORE16(p,v) (*(u32x4*)(p)=(v))
#endif
template<int THRL> __device__ __forceinline__ void attn_unit(int b,int h,int qb,const bf16*Q,const bf16*__restrict__ K,const bf16*__restrict__ V,bf16*O,const float*__restrict__ kmean,const float*__restrict__ relb,char*shm){
  const int tid=threadIdx.x,lane=tid&63,r32=lane&31,hi=lane>>5; const int wid=__builtin_amdgcn_readfirstlane(tid>>6);
  const long rowbase=(long)b*SEQ; const int q0=qb*QB;
  const bf16*Qw=Q+(rowbase+q0+wid*QBLK)*QP+QCOL+h*D;
  const bf16*Kh=K+rowbase*KP+h*D,*Vh=V+rowbase*KP+h*D;
  const unsigned lds0=(unsigned)(uintptr_t)shm;
  float*wsf=(float*)(shm+LDS_WS)+wid*64;
  float*tabR=(float*)(shm+LDS_TAB);
  { const int j_=tid, dist_=383-j_; float v_=-INFINITY; if(dist_>=0){ const int dd_=dist_<128?dist_:128; v_=relb[t5_bucket(dd_)*NHEADS+h]*1.4426950408889634f; } tabR[j_]=v_; }
  const float b31=relb[31*NHEADS+h]*1.4426950408889634f;
  const int qw0=q0+wid*QBLK;
  const bf16*ksrc=Kh+(long)lane*KP+wid*8;
  const bf16*vsrc=Vh+(long)(16*(wid&3)+(lane>>2))*KP+(wid>>2)*32+(lane&3)*8;
  const unsigned kdst=lds0+LDS_K+wid*1024, vdst=lds0+LDS_V+wid*1024;
  #define DMA_K(t,slot) glds16(ksrc+(long)(t)*KVBLK*KP,(unsigned)__builtin_amdgcn_readfirstlane(kdst+(slot)))
  #define DMA_V(t,slot) glds16(vsrc+(long)(t)*KVBLK*KP,(unsigned)__builtin_amdgcn_readfirstlane(vdst+(slot)))
  const int vb0=(int)(lds0+LDS_V)+((lane>>4)&1)*32+(lane&3)*8+(4*hi+((lane&15)>>2))*64;
  const char*Kbase=shm+LDS_K; bf16x8 kf[8];
  const lds_cptr shm3=(lds_cptr)shm; const lds_cptr kp0=shm3+LDS_K+hi*1024+r32*16; const lds_cptr vp0=shm3+LDS_V+((lane>>4)&1)*32+(lane&3)*8+(4*hi+((lane&15)>>2))*64;
  const int NT=(q0+QB)/KVBLK;
  DMA_K(0,0);DMA_V(0,0);DMA_K(1,SLOTB);
  bf16x8 qr[4];
  #pragma unroll
  for(int d0=0;d0<4;++d0)qr[d0]=*reinterpret_cast<const bf16x8*>(&Qw[(long)r32*QP+d0*16+hi*8]);
  unsigned sel=0u;
  if(qb>0){ float gt[7];
    _Pragma("unroll") for(int n=0;n<7;++n){ float a_=0.f; if(n<qb){ const float*km=kmean+n*768+8*hi;
        _Pragma("unroll") for(int d0=0;d0<4;++d0){ const f32x4_t k0=*(const f32x4_t*)(km+16*d0), k1=*(const f32x4_t*)(km+16*d0+4);
          _Pragma("unroll") for(int j=0;j<4;++j){ a_+=__uint_as_float(((unsigned)(unsigned short)qr[d0][j])<<16)*k0[j]; a_+=__uint_as_float(((unsigned)(unsigned short)qr[d0][j+4])<<16)*k1[j]; } }
        a_+=__shfl_xor(a_,32); } gt[n]=a_; }
    _Pragma("unroll") for(int n=0;n<7;++n) if(n<qb){ int rank=0;
      _Pragma("unroll") for(int m=0;m<7;++m) if(m!=n&&m<qb) rank+=(gt[m]>gt[n]||(gt[m]==gt[n]&&m<n))?1:0;
      if(rank<3) sel|=1u<<n; } }
  float mhat=0.f,l_reg=0.f;f32x16 o[2];o[0]=f32x16{};o[1]=f32x16{};f32x16 cin;
  const int qabs=qw0+r32; bool near_=false;
  #define TILE_SETUP(t) do{ const int k0_=64*(t); const bool above_=k0_>qw0+31, far_=(qw0-k0_-63)>=128; \
    const bool lsel_=((t)>=4*qb)||(((sel>>((t)>>2))&1u)!=0u); \
    const float c0_=(above_||!lsel_)?-INFINITY:((far_?b31:0.f)-mhat); \
    _Pragma("unroll") for(int r=0;r<16;++r)cin[r]=c0_; asm volatile("":"+v"(cin)); near_=!above_&&!far_; }while(0)
  #define NEARADD(P0,P1,t) do{ if(near_){ const float*tp_=tabR+(383-(qabs-64*(t)-4*hi)); \
    _Pragma("unroll") for(int r=0;r<16;++r){ P0[r]+=tp_[(r&3)+8*(r>>2)]; P1[r]+=tp_[(r&3)+8*(r>>2)+32]; } } }while(0)
  bool resc=false;
  #define START(P0,P1) do{ const float rm=rowmax(P0,P1); resc=false; \
    { const float dl=(rm==-INFINITY)?0.f:rm; mhat=fadd_s(mhat,dl);     \
      _Pragma("unroll") for(int r=0;r<16;++r){P0[r]=fsub_s(P0[r],dl);P1[r]=fsub_s(P1[r],dl);} } \
    _Pragma("unroll") for(int r=0;r<16;++r)P0[r]=__builtin_amdgcn_exp2f(P0[r]); }while(0)
  #define RESC() do{ if(resc){ asm volatile("s_waitcnt lgkmcnt(0)":::"memory"); \
      _Pragma("unroll") for(int d_=0;d_<2;++d_) _Pragma("unroll") for(int r=0;r<16;++r)o[d_][r]*=wsf[crow(r,hi)]; } }while(0)
  f32x16 pA0,pA1,pB0,pB1;
  int sl_prev=0,sl_cur=0,sl_next=SLOTB;
  #define ROT() do{sl_prev=sl_cur;sl_cur=sl_next;sl_next=(sl_next==(NSLOT-1)*SLOTB)?0:sl_next+SLOTB;}while(0)
  DMA_K(2,2*SLOTB);
  WAIT_BAR(3);
  TILE_SETUP(0); qkt(pA0,pA1,Kbase,qr,cin,r32,hi);asm volatile("s_nop 15\n\ts_nop 7":"+v"(pA0),"+v"(pA1));NEARADD(pA0,pA1,0);asm volatile("s_nop 1":"+v"(pA0),"+v"(pA1));
  START(pA0,pA1);
  _Pragma("unroll") for(int r=0;r<16;++r)pA1[r]=__builtin_amdgcn_exp2f(pA1[r]);
  WAIT_BAR(0);
  DMA_K(3,0);DMA_V(1,SLOTB);
  ROT();
  kload8(kf,kp0+sl_cur);
  WAIT_BAR(2);
  s16x4 vlo[8],vhi[8]; u32x4 pw0,pw1,pw2,pw3;
  #define PKW(P,B) cvtpk_s(P[B],P[B+1])
  #define PAF(k) __builtin_bit_cast(bf16x8,pw##k)
  #define VFR(i) (bf16x8){vlo[i][0],vlo[i][1],vlo[i][2],vlo[i][3],vhi[i][0],vhi[i][1],vhi[i][2],vhi[i][3]}
  #define PIN(x) asm volatile("":"+v"(x))
  #define MX3(a,b,c) __builtin_fmaxf(__builtin_fmaxf((a),(b)),(c))
  #define GAPA(MF,A0,A1,A2,A3,W0,W1,PW) do{ MF; sacc+=A0; sacc+=A1; sacc+=A2; sacc+=A3; PIN(sacc); W0; W1; PIN(PW); SBAR(); }while(0)
  #define EX(v) __builtin_amdgcn_exp2f(v)
  #define GAPB(MF,X,B) do{ MF; X[B]=EX(X[B]); X[B+1]=EX(X[B+1]); X[B+2]=EX(X[B+2]); X[B+3]=EX(X[B+3]); PIN(X); SBAR(); }while(0)
  #define VRD(i) do{ vlo[i]=vtr(vp_+(((i)>>2)*4096+((i)&3)*1024)); vhi[i]=vtr(vp_+(((i)>>2)*4096+((i)&3)*1024+512)); }while(0)
  #define KRD(G,j) do{ if(G){ kload2(kf,kp0+sl_next,j); SBAR(); } }while(0)
  #define STEP(C0,C1,P0,P1,t,GK,GV,GL) do{ TILE_SETUP(t); SBAR(); \
    const lds_cptr vp_=vp0+sl_prev; \
    VRD(0); SBAR(); float sacc=(P0[0]+P0[1]); \
    GAPA(C0=__builtin_amdgcn_mfma_f32_32x32x16_bf16(kf[0],qr[0],cin,0,0,0), P0[2],P0[3],P0[4],P0[5],     pw0[0]=PKW(P0,0), pw0[1]=PKW(P0,2), pw0); \
    VRD(4); SBAR(); GAPA(C1=__builtin_amdgcn_mfma_f32_32x32x16_bf16(kf[1],qr[0],cin,0,0,0), P0[6],P0[7],P0[8],P0[9],     pw0[2]=PKW(P0,4), pw0[3]=PKW(P0,6), pw0); \
    VRD(1); SBAR(); GAPA(C0=__builtin_amdgcn_mfma_f32_32x32x16_bf16(kf[2],qr[1],C0,0,0,0),   P0[10],P0[11],P0[12],P0[13], pw1[0]=PKW(P0,8), pw1[1]=PKW(P0,10), pw1); \
    VRD(5); SBAR(); GAPA(C1=__builtin_amdgcn_mfma_f32_32x32x16_bf16(kf[3],qr[1],C1,0,0,0),   P0[14],P0[15],P1[0],P1[1],   pw1[2]=PKW(P0,12),pw1[3]=PKW(P0,14), pw1); \
    VRD(2); SBAR(); GAPA(C0=__builtin_amdgcn_mfma_f32_32x32x16_bf16(kf[4],qr[2],C0,0,0,0),   P1[2],P1[3],P1[4],P1[5],     pw2[0]=PKW(P1,0), pw2[1]=PKW(P1,2), pw2); \
    VRD(6); SBAR(); GAPA(C1=__builtin_amdgcn_mfma_f32_32x32x16_bf16(kf[5],qr[2],C1,0,0,0),   P1[6],P1[7],P1[8],P1[9],     pw2[2]=PKW(P1,4), pw2[3]=PKW(P1,6), pw2); \
    VRD(3); SBAR(); GAPA(C0=__builtin_amdgcn_mfma_f32_32x32x16_bf16(kf[6],qr[3],C0,0,0,0),   P1[10],P1[11],P1[12],P1[13], pw3[0]=PKW(P1,8), pw3[1]=PKW(P1,10), pw3); \
    VRD(7); SBAR(); GAPA(C1=__builtin_amdgcn_mfma_f32_32x32x16_bf16(kf[7],qr[3],C1,0,0,0),   P1[14],P1[15],0.f,0.f,       pw3[2]=PKW(P1,12),pw3[3]=PKW(P1,14), pw3); \
    l_reg+=sacc; \
    if(GK){DMA_K((t)+3,sl_cur);} if(GV){DMA_V((t)+1,sl_next);} \
    NEARADD(C0,C1,t); \
    { float a=MX3(C0[0],C0[1],C1[0]),b=MX3(C0[2],C0[3],C1[1]); a=MX3(a,C1[2],C1[3]); \
      _Pragma("unroll") for(int r=4;r<16;r+=4){a=MX3(a,C0[r],C0[r+1]);b=MX3(b,C0[r+2],C0[r+3]);a=MX3(a,C1[r],C1[r+1]);b=MX3(b,C1[r+2],C1[r+3]);} \
      float rm=__builtin_fmaxf(a,b); { auto rr=__builtin_amdgcn_permlane32_swap(__float_as_uint(rm),__float_as_uint(rm),false,false); rm=__builtin_fmaxf(__uint_as_float(rr[0]),__uint_as_float(rr[1])); } \
      resc=false; \
      if(__builtin_expect(__any(rm>(float)THRL),0)){ const float dl=__builtin_fmaxf(rm,0.f); mhat+=dl; \
        _Pragma("unroll") for(int r=0;r<16;++r){C0[r]-=dl;C1[r]-=dl;} \
        const float f=__builtin_amdgcn_exp2f(-dl); l_reg*=f; if(hi==0)wsf[r32]=f; resc=true; } } \
    SBAR(); \
    GAPB(o[0]=__builtin_amdgcn_mfma_f32_32x32x16_bf16(PAF(0),VFR(0),o[0],0,0,0), C0,0); \
    GAPB(o[1]=__builtin_amdgcn_mfma_f32_32x32x16_bf16(PAF(0),VFR(4),o[1],0,0,0), C0,4); \
    KRD(GL,0); GAPB(o[0]=__builtin_amdgcn_mfma_f32_32x32x16_bf16(PAF(1),VFR(1),o[0],0,0,0), C0,8); \
    KRD(GL,1); GAPB(o[1]=__builtin_amdgcn_mfma_f32_32x32x16_bf16(PAF(1),VFR(5),o[1],0,0,0), C0,12); \
    KRD(GL,2); GAPB(o[0]=__builtin_amdgcn_mfma_f32_32x32x16_bf16(PAF(2),VFR(2),o[0],0,0,0), C1,0); \
    KRD(GL,3); GAPB(o[1]=__builtin_amdgcn_mfma_f32_32x32x16_bf16(PAF(2),VFR(6),o[1],0,0,0), C1,4); \
    GAPB(o[0]=__builtin_amdgcn_mfma_f32_32x32x16_bf16(PAF(3),VFR(3),o[0],0,0,0), C1,8); \
    GAPB(o[1]=__builtin_amdgcn_mfma_f32_32x32x16_bf16(PAF(3),VFR(7),o[1],0,0,0), C1,12); \
    }while(0)
  int t=1;
  for(;t+7<NT;t+=2){
    STEP(pB0,pB1,pA0,pA1,t,true,true,true);     WAIT_BAR(2); RESC(); ROT();
    STEP(pA0,pA1,pB0,pB1,t+1,true,true,true);   WAIT_BAR(2); RESC(); ROT();
  }
  #define ENDW(tt) do{ if((tt)+3<NT){WAIT_BAR(2);} else if((tt)+2<NT){WAIT_BAR(1);} else {WAIT_BAR(0);} }while(0)
  for(;t+1<NT;t+=2){
    STEP(pB0,pB1,pA0,pA1,t,(t+3<NT),(t+1<NT),(t+1<NT));       ENDW(t);   RESC(); ROT();
    STEP(pA0,pA1,pB0,pB1,t+1,(t+4<NT),(t+2<NT),(t+2<NT));     ENDW(t+1); RESC(); ROT();
  }
  STEP(pB0,pB1,pA0,pA1,NT-1,false,false,false); RESC();
  { float sacc=pB0[0]+pB0[1]; _Pragma("unroll") for(int r=2;r<16;++r)sacc+=pB0[r]; _Pragma("unroll") for(int r=0;r<16;++r)sacc+=pB1[r]; l_reg+=sacc;
    pw0=(u32x4){PKW(pB0,0),PKW(pB0,2),PKW(pB0,4),PKW(pB0,6)};pw1=(u32x4){PKW(pB0,8),PKW(pB0,10),PKW(pB0,12),PKW(pB0,14)};pw2=(u32x4){PKW(pB1,0),PKW(pB1,2),PKW(pB1,4),PKW(pB1,6)};pw3=(u32x4){PKW(pB1,8),PKW(pB1,10),PKW(pB1,12),PKW(pB1,14)};
    SBAR(); pv(o,vb0+sl_cur,PAF(0),PAF(1),PAF(2),PAF(3)); }
  #undef PKW
  #undef PAF
  #undef VFR
  #undef PIN
  #undef MX3
  #undef GAPA
  #undef GAPB
  #undef EX
  #undef VRD
  #undef KRD
  #undef STEP
  #undef ENDW
  {auto rr=__builtin_amdgcn_permlane32_swap(__float_as_uint(l_reg),__float_as_uint(l_reg),false,false);l_reg=__uint_as_float(rr[0])+__uint_as_float(rr[1]);}
  if(hi==0)wsf[32+r32]=l_reg;asm volatile("s_waitcnt lgkmcnt(0)":::"memory");
  float rli[16];
  #pragma unroll
  for(int r=0;r<16;++r)rli[r]=__builtin_amdgcn_rcpf(wsf[32+crow(r,hi)]);
  bf16*Ow=O+(rowbase+q0+wid*QBLK)*QP+QCOL+h*D;
  { bf16*stg=(bf16*)(shm+LDS_OST)+wid*2048;
    #pragma unroll
    for(int r=0;r<16;++r){const int orow=crow(r,hi);
      #pragma unroll
      for(int d0=0;d0<2;++d0)stg[orow*64+d0*32+r32]=__float2bfloat16(o[d0][r]*rli[r]);}
    asm volatile("s_waitcnt lgkmcnt(0)":::"memory");
    #pragma unroll
    for(int i=0;i<4;++i){const int row=i*8+(lane>>3),ch=lane&7; const u32x4 v=*(const u32x4*)(stg+row*64+ch*8); ATTN_STORE16(Ow+(long)row*QP+ch*8,v);} }
  asm volatile("s_waitcnt lgkmcnt(0)\n\ts_barrier":::"memory");
  #undef DMA_K
  #undef DMA_V
  #undef TILE_SETUP
  #undef NEARADD
  #undef START
  #undef RESC
  #undef ROT
}
constexpr int ATTN_LDS_BYTES=LDS_BYTES;
struct AttnTensors { const bf16* Q; const bf16* K; const bf16* V; bf16* O; const float* kmean; const float* relb; };
template<int THRL=8> __device__ __forceinline__ void attn_phase(char*lds,const AttnTensors&T,int vcu,int G){
  for(int p=vcu*3;p<768;p+=G*3){
    for(int i=0;i<3&&p+i<768;++i){ const int pr=p+i, bh=pr>>2, s=pr&3, b=bh/NHEADS, h=bh-b*NHEADS; const float*km=T.kmean+(long)b*8*768+h*64;
      attn_unit<THRL>(b,h,s,T.Q,T.K,T.V,T.O,km,T.relb,lds);
      attn_unit<THRL>(b,h,7-s,T.Q,T.K,T.V,T.O,km,T.relb,lds); } }
}
#undef SBAR
#undef WAIT_BAR
}
namespace mix2 {
typedef short bf16x8 __attribute__((ext_vector_type(8)));
typedef short s16x4 __attribute__((ext_vector_type(4)));
typedef float f32x16 __attribute__((ext_vector_type(16)));
typedef float f32x4v __attribute__((ext_vector_type(4)));
typedef unsigned u32x4 __attribute__((ext_vector_type(4)));
typedef unsigned u32x2 __attribute__((ext_vector_type(2)));
typedef __attribute__((address_space(3))) unsigned char* ldsp;
typedef __attribute__((address_space(3))) const unsigned char* ldscp;
__device__ __forceinline__ int crow(int r, int hi) { return (r & 3) + 8 * (r >> 2) + 4 * hi; }
__device__ __forceinline__ s16x4 vtr(ldscp p) { return __builtin_bit_cast(s16x4, __builtin_amdgcn_ds_read_tr16_b64_v4i16((__attribute__((address_space(3))) s16x4*)p)); }
__device__ __forceinline__ unsigned cvt2(float lo, float hi) { typedef float f2 __attribute__((ext_vector_type(2))); typedef __bf16 b2 __attribute__((ext_vector_type(2))); f2 v = {lo, hi}; b2 b = __builtin_convertvector(v, b2); return __builtin_bit_cast(unsigned, b); }
__device__ __forceinline__ float bflo(unsigned w) { return __uint_as_float(w << 16); }
__device__ __forceinline__ float bfhi(unsigned w) { return __uint_as_float(w & 0xffff0000u); }
#define MFMA32(a, b, c) __builtin_amdgcn_mfma_f32_32x32x16_bf16(a, b, c, 0, 0, 0)

constexpr int G_VN = 1024, G_W = 1024 + 32768;
__device__ __forceinline__ void gmlp_phase(ldsp lds, int wave, int vcu, int G, const bf16* gv, const float* gain, const float* bias, const float* wsp, const float* bsp, bf16* mix) {
    const int lane = (int)__builtin_amdgcn_mbcnt_hi(~0u, __builtin_amdgcn_mbcnt_lo(~0u, 0u)), tid = wave * 64 + lane, r32 = lane & 31, hi = lane >> 5;
    __attribute__((address_space(3))) float* stats = (__attribute__((address_space(3))) float*)lds;
    for (int chunk = vcu; chunk < T / CHUNK; chunk += G) {
        const int base = chunk * CHUNK;
        for (int rr = 0; rr < 16; ++rr) { const int row = wave * 16 + rr;
            const unsigned long long* gp = (const unsigned long long*)(gv + (size_t)(base + row) * 768) + lane;
            float v[12]; float s = 0.f;
#pragma unroll
            for (int j = 0; j < 3; ++j) { const unsigned long long w = gp[64 * j]; const unsigned lo = (unsigned)w, hw = (unsigned)(w >> 32);
                v[4 * j] = bflo(lo); v[4 * j + 1] = bfhi(lo); v[4 * j + 2] = bflo(hw); v[4 * j + 3] = bfhi(hw); s += (v[4 * j] + v[4 * j + 1]) + (v[4 * j + 2] + v[4 * j + 3]); }
            const float mu = wave_sum(s) * (1.f / 768.f); float q = 0.f;
#pragma unroll
            for (int j = 0; j < 12; ++j) { const float d = v[j] - mu; q += d * d; }
            const float rstd = rsqrtf(wave_sum(q) * (1.f / 768.f) + EPS);
            if (lane == 0) { stats[2 * row] = mu; stats[2 * row + 1] = rstd; } }
        __syncthreads();
        for (int g = 0; g < 6; ++g) {
#pragma unroll
            for (int k = 0; k < 4; ++k) { const int id = tid + 512 * k, s = id >> 4, c = id & 15, ch = g * 128 + c * 8;
                const u32x4 w = *(const u32x4*)(gv + (size_t)(base + s) * 768 + ch);
                const f32x4v g0 = *(const f32x4v*)(gain + ch), g1 = *(const f32x4v*)(gain + ch + 4), b0 = *(const f32x4v*)(bias + ch), b1 = *(const f32x4v*)(bias + ch + 4);
                const float mu = stats[2 * s], rs = stats[2 * s + 1];
                u32x4 o;
                o.x = cvt2((bflo(w.x) - mu) * rs * g0[0] + b0[0], (bfhi(w.x) - mu) * rs * g0[1] + b0[1]);
                o.y = cvt2((bflo(w.y) - mu) * rs * g0[2] + b0[2], (bfhi(w.y) - mu) * rs * g0[3] + b0[3]);
                o.z = cvt2((bflo(w.z) - mu) * rs * g1[0] + b1[0], (bfhi(w.z) - mu) * rs * g1[1] + b1[1]);
                o.w = cvt2((bflo(w.w) - mu) * rs * g1[2] + b1[2], (bfhi(w.w) - mu) * rs * g1[3] + b1[3]);
                *(__attribute__((address_space(3))) u32x4*)(lds + G_VN + (c >> 2) * 8192 + s * 64 + (c & 3) * 16) = o;
                const int t = s;
                const f32x4v w0 = *(const f32x4v*)(wsp + (size_t)g * 16384 + t * 128 + c * 8), w1 = *(const f32x4v*)(wsp + (size_t)g * 16384 + t * 128 + c * 8 + 4);
                float wv[8] = {w0[0], w0[1], w0[2], w0[3], w1[0], w1[1], w1[2], w1[3]};
#pragma unroll
                for (int j = 0; j < 8; ++j) if (c * 8 + j > t) wv[j] = 0.f;
                u32x4 ow; ow.x = cvt2(wv[0], wv[1]); ow.y = cvt2(wv[2], wv[3]); ow.z = cvt2(wv[4], wv[5]); ow.w = cvt2(wv[6], wv[7]);
                *(__attribute__((address_space(3))) u32x4*)(lds + G_W + t * 256 + ((c ^ (t & 15)) << 4)) = ow; }
            __syncthreads();
            const int tb = wave & 3, dh = wave >> 2;
            f32x16 acc0 = {}, acc1 = {};
            const int trow = 32 * tb + r32;
            ldscp vb = (ldscp)(lds + G_VN + (2 * dh) * 8192 + (8 * hi + ((lane & 15) >> 2)) * 64 + ((lane >> 4) & 1) * 32 + (lane & 3) * 8);
            for (int ks = 0; ks <= 2 * tb + 1; ++ks) {
                const bf16x8 a = *(__attribute__((address_space(3))) const bf16x8*)(lds + G_W + trow * 256 + (((2 * ks + hi) ^ (trow & 15)) << 4));
                const s16x4 l0 = vtr(vb + ks * 1024), h0 = vtr(vb + ks * 1024 + 256), l1 = vtr(vb + 8192 + ks * 1024), h1 = vtr(vb + 8192 + ks * 1024 + 256);
                const bf16x8 v0 = {l0[0], l0[1], l0[2], l0[3], h0[0], h0[1], h0[2], h0[3]}, v1 = {l1[0], l1[1], l1[2], l1[3], h1[0], h1[1], h1[2], h1[3]};
                acc0 = MFMA32(a, v0, acc0); acc1 = MFMA32(a, v1, acc1);
            }
#pragma unroll
            for (int r = 0; r < 16; ++r) { const int tl = 32 * tb + crow(r, hi); const float bs = bsp[g * CHUNK + tl];
                bf16* mp = mix + (size_t)(base + tl) * 2048 + g * 128 + dh * 64 + r32;
                mp[0] = (bf16)f2bf(bf2f(mp[0]) * (acc0[r] + bs)); mp[32] = (bf16)f2bf(bf2f(mp[32]) * (acc1[r] + bs)); }
            __syncthreads();
        }
    }
}

constexpr int M_V = 65536, M_WS = 131072, M_LDS = 131072 + 2048;
__device__ __forceinline__ void memattn_phase(ldsp lds, int wave, int vcu, int G, bf16* mix, const bf16* memkv) {
    const int lane = (int)__builtin_amdgcn_mbcnt_hi(~0u, __builtin_amdgcn_mbcnt_lo(~0u, 0u)), tid = wave * 64 + lane, r32 = lane & 31, hi = lane >> 5;
    __attribute__((address_space(3))) float* wsf = (__attribute__((address_space(3))) float*)(lds + M_WS) + wave * 64;
    for (int task = vcu; task < BATCH * MH * 4; task += G) {
        const int bh = task >> 2, jq = task & 3, b = bh >> 2, h = bh & 3;
#pragma unroll
        for (int k = 0; k < 8; ++k) { const int id = tid + 512 * k, row = id >> 4, c = id & 15;
            const bf16* src = memkv + (size_t)(b * MEMLEN + row) * 1024 + h * 128 + c * 8;
            const u32x4 kk = *(const u32x4*)src, vv = *(const u32x4*)(src + 512);
            *(__attribute__((address_space(3))) u32x4*)(lds + row * 256 + ((c ^ (row & 15)) << 4)) = kk;
            *(__attribute__((address_space(3))) u32x4*)(lds + M_V + (c >> 2) * 16384 + row * 64 + (c & 3) * 16) = vv; }
        __syncthreads();
        for (int qi = 0; qi < 2; ++qi) {
            const int t0 = b * SEQ + (2 * jq + qi) * 256 + wave * 32;
            bf16x8 qr[8];
#pragma unroll
            for (int d0 = 0; d0 < 8; ++d0) qr[d0] = *(const bf16x8*)(mix + (size_t)(t0 + r32) * 2048 + 1536 + h * 128 + d0 * 16 + hi * 8);
            f32x16 o[4]; o[0] = f32x16{}; o[1] = f32x16{}; o[2] = f32x16{}; o[3] = f32x16{};
            float mrow = -INFINITY, lsum = 0.f;
            ldscp vb = (ldscp)(lds + M_V + (4 * hi + ((lane & 15) >> 2)) * 64 + ((lane >> 4) & 1) * 32 + (lane & 3) * 8);
            for (int kc = 0; kc < 4; ++kc) {
                f32x16 p0 = {}, p1 = {};
                const int krow = kc * 64 + r32;
#pragma unroll
                for (int d0 = 0; d0 < 8; ++d0) { const int sw = ((2 * d0 + hi) ^ (r32 & 15)) << 4;
                    const bf16x8 k0 = *(__attribute__((address_space(3))) const bf16x8*)(lds + krow * 256 + sw), k1 = *(__attribute__((address_space(3))) const bf16x8*)(lds + (krow + 32) * 256 + sw);
                    p0 = MFMA32(k0, qr[d0], p0); p1 = MFMA32(k1, qr[d0], p1); }
                float mx = fmaxf(p0[0], p1[0]);
#pragma unroll
                for (int r = 1; r < 16; ++r) mx = fmaxf(mx, fmaxf(p0[r], p1[r]));
                mx = fmaxf(mx, __shfl_xor(mx, 32));
                const float mn = fmaxf(mrow, mx), alpha = __builtin_amdgcn_exp2f(mrow - mn); mrow = mn;
                float ps = 0.f;
#pragma unroll
                for (int r = 0; r < 16; ++r) { p0[r] = __builtin_amdgcn_exp2f(p0[r] - mn); p1[r] = __builtin_amdgcn_exp2f(p1[r] - mn); ps += p0[r] + p1[r]; }
                lsum = lsum * alpha + ps;
                if (hi == 0) wsf[r32] = alpha;
                u32x4 pw0, pw1, pw2, pw3;
                pw0 = (u32x4){cvt2(p0[0], p0[1]), cvt2(p0[2], p0[3]), cvt2(p0[4], p0[5]), cvt2(p0[6], p0[7])};
                pw1 = (u32x4){cvt2(p0[8], p0[9]), cvt2(p0[10], p0[11]), cvt2(p0[12], p0[13]), cvt2(p0[14], p0[15])};
                pw2 = (u32x4){cvt2(p1[0], p1[1]), cvt2(p1[2], p1[3]), cvt2(p1[4], p1[5]), cvt2(p1[6], p1[7])};
                pw3 = (u32x4){cvt2(p1[8], p1[9]), cvt2(p1[10], p1[11]), cvt2(p1[12], p1[13]), cvt2(p1[14], p1[15])};
                if (kc > 0) {
#pragma unroll
                    for (int r = 0; r < 16; ++r) { const float f = wsf[crow(r, hi)];
#pragma unroll
                        for (int dq = 0; dq < 4; ++dq) o[dq][r] *= f; } }
#pragma unroll
                for (int dq = 0; dq < 4; ++dq) {
#pragma unroll
                    for (int ks = 0; ks < 4; ++ks) { ldscp vp = vb + dq * 16384 + (kc * 64 + ks * 16) * 64;
                        const s16x4 l = vtr(vp), hh = vtr(vp + 512);
                        const bf16x8 vf = {l[0], l[1], l[2], l[3], hh[0], hh[1], hh[2], hh[3]};
                        const u32x4 pa = ks == 0 ? pw0 : (ks == 1 ? pw1 : (ks == 2 ? pw2 : pw3));
                        o[dq] = MFMA32(__builtin_bit_cast(bf16x8, pa), vf, o[dq]); } }
            }
            lsum += __shfl_xor(lsum, 32);
            if (hi == 0) wsf[32 + r32] = 1.0f / lsum;
#pragma unroll
            for (int r = 0; r < 16; ++r) { const float f = wsf[32 + crow(r, hi)];
                bf16* op = mix + (size_t)(t0 + crow(r, hi)) * 2048 + 1536 + h * 128 + r32;
#pragma unroll
                for (int dq = 0; dq < 4; ++dq) op[dq * 32] = (bf16)f2bf(o[dq][r] * f); }
        }
        __syncthreads();
    }
}
#undef MFMA32
}
#ifndef DBG_NAIVE_GMLP
#define DBG_NAIVE_GMLP 0
#endif
#ifndef DBG_NAIVE_MEMATTN
#define DBG_NAIVE_MEMATTN 0
#endif
#ifndef DBG_NAIVE_MOBA
#define DBG_NAIVE_MOBA 0
#endif
#ifndef DBG_P1
#define DBG_P1 3
#endif
constexpr int NWAVES = 8;
constexpr int RING_BYTES = 131072;
constexpr int LDS_BYTES = 147456;

struct Args { const float* in[21]; float* out; unsigned char* ws; int ph_lo, ph_hi; };

__device__ __forceinline__ int opq(int v) { asm volatile("" : "+v"(v)); return v; }
__device__ __forceinline__ int lane_id() { return (int)__builtin_amdgcn_mbcnt_hi(~0u, __builtin_amdgcn_mbcnt_lo(~0u, 0u)); }
struct Frame {
    LAS unsigned char* lds;
    int wave, vcu, G;
};

__device__ __forceinline__ void p0_transpose_item(const float* W, int K, int N, bf16* WT, int ldt, int col_off, int mode, LAS float* scr, int item, int lane) {
    const int nblk = N / 32, kb = item / nblk, nb = item % nblk, k0 = 64 * kb, n0 = 32 * nb;
#pragma unroll 8
    for (int i = 0; i < 32; ++i) { const int kk = 2 * i + (lane >> 5); scr[kk * 33 + (lane & 31)] = W[(size_t)(k0 + kk) * N + n0 + (lane & 31)]; }
    asm volatile("s_waitcnt lgkmcnt(0)" ::: "memory");
    const int c = lane & 7;
    const int rbase = mode ? ((n0 / 128) * 256 + (n0 % 128) + (mode == 2 ? 128 : 0)) : n0;
#pragma unroll
    for (int j = 0; j < 4; ++j) { const int n = (lane >> 3) + 8 * j; const LAS float* s = scr + (8 * c) * 33 + n;
        v4u o; o.x = pk2(s[0 * 33], s[1 * 33]); o.y = pk2(s[2 * 33], s[3 * 33]); o.z = pk2(s[4 * 33], s[5 * 33]); o.w = pk2(s[6 * 33], s[7 * 33]);
        *(v4u*)(WT + (size_t)(rbase + n) * ldt + col_off + k0 + 8 * c) = o; }
    asm volatile("s_waitcnt lgkmcnt(0)" ::: "memory");
}
__device__ __forceinline__ void rms_row_bf16(const float* xrow, const float* g, bf16* orow, int lane_) {
    const int lane = opq(lane_);
    const f32x4* xr = (const f32x4*)xrow + lane;
    f32x4 v[4]; float s = 0.f;
#pragma unroll
    for (int j = 0; j < 4; ++j) { v[j] = xr[64 * j]; s += (v[j].x * v[j].x + v[j].y * v[j].y) + (v[j].z * v[j].z + v[j].w * v[j].w); }
    const float r = rsqrtf(wave_sum(s) * (1.f / DM) + EPS);
    unsigned long long* o8 = (unsigned long long*)orow + lane;
#pragma unroll
    for (int j = 0; j < 4; ++j) { const f32x4 gg = ((const f32x4*)g)[lane + 64 * j];
        o8[64 * j] = (unsigned long long)pk2(v[j].x * r * gg.x, v[j].y * r * gg.y) | ((unsigned long long)pk2(v[j].z * r * gg.z, v[j].w * r * gg.w) << 32); }
}
__device__ __forceinline__ void post_norm_row(const float* xin, const float* y, const float* g1, float* x1out, const float* g2, bf16* h2, int lane_) {
    const int lane = opq(lane_);
    const f32x4* yr = (const f32x4*)y + lane; const f32x4* xr = (const f32x4*)xin + lane;
    f32x4 v[4]; float s = 0.f;
#pragma unroll
    for (int j = 0; j < 4; ++j) { v[j] = yr[64 * j]; s += (v[j].x * v[j].x + v[j].y * v[j].y) + (v[j].z * v[j].z + v[j].w * v[j].w); }
    const float r = rsqrtf(wave_sum(s) * (1.f / DM) + EPS);
    float s2 = 0.f;
#pragma unroll
    for (int j = 0; j < 4; ++j) { const f32x4 gg = ((const f32x4*)g1)[lane + 64 * j]; const f32x4 xx = xr[64 * j];
        v[j] = xx + v[j] * r * gg; ((f32x4*)x1out)[lane + 64 * j] = v[j];
        s2 += (v[j].x * v[j].x + v[j].y * v[j].y) + (v[j].z * v[j].z + v[j].w * v[j].w); }
    if (h2) {
        const float r2 = rsqrtf(wave_sum(s2) * (1.f / DM) + EPS);
        unsigned long long* o8 = (unsigned long long*)h2 + lane;
#pragma unroll
        for (int j = 0; j < 4; ++j) { const f32x4 gg = ((const f32x4*)g2)[lane + 64 * j];
            o8[64 * j] = (unsigned long long)pk2(v[j].x * r2 * gg.x, v[j].y * r2 * gg.y) | ((unsigned long long)pk2(v[j].z * r2 * gg.z, v[j].w * r2 * gg.w) << 32); }
    }
}

__device__ __forceinline__ void gmlp_body(Frame& F, const bf16* gv, const float* gain, const float* bias, const float* wsp, const float* bsp, bf16* mix) {
    LAS float* stats = (LAS float*)F.lds;
    LAS float* vn = (LAS float*)(F.lds + 1024);
    LAS float* wl = (LAS float*)(F.lds + 1024 + 65536);
    const int lane = opq(lane_id()), tid = F.wave * 64 + lane;
    for (int chunk = F.vcu; chunk < T / CHUNK; chunk += F.G) {
        const int base = chunk * CHUNK;
        for (int r = F.wave; r < CHUNK; r += NWAVES) {
            float v[12]; float s = 0.f;
#pragma unroll
            for (int j = 0; j < 12; ++j) { v[j] = bf2f(gv[(size_t)(base + r) * 768 + lane + 64 * j]); s += v[j]; }
            const float mu = wave_sum(s) * (1.f / 768.f); float q = 0.f;
#pragma unroll
            for (int j = 0; j < 12; ++j) { const float d = v[j] - mu; q += d * d; }
            const float rstd = rsqrtf(wave_sum(q) * (1.f / 768.f) + EPS);
            if (lane == 0) { stats[2 * r] = mu; stats[2 * r + 1] = rstd; }
        }
        __syncthreads();
        for (int g = 0; g < 6; ++g) {
            for (int i = tid; i < CHUNK * 128; i += NWAVES * 64) { const int s = i >> 7, d = i & 127, ch = g * 128 + d;
                vn[i] = (bf2f(gv[(size_t)(base + s) * 768 + ch]) - stats[2 * s]) * stats[2 * s + 1] * gain[ch] + bias[ch];
                wl[i] = wsp[(size_t)g * CHUNK * CHUNK + i]; }
            __syncthreads();
            const int d = tid & 127, tq = tid >> 7;
            for (int i = 0; i < 32; ++i) { const int tl = tq + 4 * i; float a = 0.f;
                for (int s = 0; s <= tl; ++s) a += wl[tl * 128 + s] * vn[s * 128 + d];
                a += bsp[g * CHUNK + tl];
                const size_t o = (size_t)(base + tl) * 2048 + g * 128 + d;
                mix[o] = (bf16)f2bf(bf2f(mix[o]) * a); }
            __syncthreads();
        }
    }
}
__device__ __forceinline__ void moba_body(Frame& F, bf16* mix, const bf16* kb, const bf16* vb, const float* kmean, const float* relb) {
    LAS float* lg = (LAS float*)F.lds + F.wave * 1024;
    const int lane = opq(lane_id());
    for (int w = F.vcu * NWAVES + F.wave; w < BATCH * NH * SEQ; w += F.G * NWAVES) {
        const int s = w % SEQ, bh = w / SEQ, h = bh % NH, b = bh / NH;
        const int t = b * SEQ + s, cur = s / MBLK;
        float q[64];
#pragma unroll
        for (int d = 0; d < 64; ++d) q[d] = bf2f(mix[(size_t)t * 2048 + 768 + h * 64 + d]);
        float gt[8];
#pragma unroll
        for (int n = 0; n < 8; ++n) { float a = 0.f;
            if (n < cur) { const float* km = kmean + (size_t)(b * NBLK + n) * 768 + h * 64;
#pragma unroll
                for (int d = 0; d < 64; ++d) a += q[d] * km[d]; }
            gt[n] = a; }
        unsigned sel = 0;
#pragma unroll
        for (int n = 0; n < 8; ++n) if (n < cur) { int rank = 0;
#pragma unroll
            for (int m = 0; m < 8; ++m) if (m < cur && m != n) rank += (gt[m] > gt[n] || (gt[m] == gt[n] && m < n)) ? 1 : 0;
            if (rank < 3) sel |= 1u << n; }
        int nslot = 0; float mx = -INFINITY;
        for (int n = 0; n <= cur; ++n) {
            if (n < cur && !((sel >> n) & 1u)) continue;
#pragma unroll
            for (int i = 0; i < 4; ++i) { const int j = lane + 64 * i, kp = n * MBLK + j, dist = s - kp; float l = -INFINITY;
                if (dist >= 0) { const bf16* kr = kb + (size_t)(b * SEQ + kp) * 768 + h * 64; float a = 0.f;
#pragma unroll
                    for (int d = 0; d < 64; ++d) a += q[d] * bf2f(kr[d]);
                    l = a + relb[t5_bucket(dist) * NH + h] * LOG2E; }
                lg[nslot * 256 + j] = l; mx = fmaxf(mx, l); }
            ++nslot;
        }
        mx = wave_max(mx);
        float sum = 0.f; const int nk = nslot * 256;
        for (int j = lane; j < nk; j += 64) { const float p = exp2f(lg[j] - mx); lg[j] = p; sum += p; }
        sum = wave_sum(sum);
        asm volatile("s_waitcnt lgkmcnt(0)" ::: "memory");
        float o = 0.f; int slot = 0;
        for (int n = 0; n <= cur; ++n) {
            if (n < cur && !((sel >> n) & 1u)) continue;
            const int jmax = (n == cur) ? (s - cur * MBLK + 1) : MBLK;
            for (int j = 0; j < jmax; ++j) o += lg[slot * 256 + j] * bf2f(vb[(size_t)(b * SEQ + n * MBLK + j) * 768 + h * 64 + lane]);
            ++slot;
        }
        mix[(size_t)t * 2048 + 768 + h * 64 + lane] = (bf16)f2bf(o / sum);
        asm volatile("s_waitcnt lgkmcnt(0)" ::: "memory");
    }
}
__device__ __forceinline__ void memattn_body(Frame& F, bf16* mix, const bf16* memkv) {
    LAS float* lg = (LAS float*)(F.lds + 32768) + F.wave * 256;
    const int lane = opq(lane_id());
    for (int w = F.vcu * NWAVES + F.wave; w < BATCH * MH * SEQ; w += F.G * NWAVES) {
        const int s = w % SEQ, bh = w / SEQ, h = bh % MH, b = bh / MH;
        const int t = b * SEQ + s;
        float mx = -INFINITY;
#pragma unroll
        for (int i = 0; i < 4; ++i) { const int m = lane + 64 * i;
            const bf16* kr = memkv + (size_t)(b * MEMLEN + m) * 1024 + h * 128; float a = 0.f;
            for (int d = 0; d < 128; ++d) a += bf2f(mix[(size_t)t * 2048 + 1536 + h * 128 + d]) * bf2f(kr[d]);
            lg[m] = a; mx = fmaxf(mx, a); }
        mx = wave_max(mx);
        float sum = 0.f;
#pragma unroll
        for (int i = 0; i < 4; ++i) { const int m = lane + 64 * i; const float p = exp2f(lg[m] - mx); lg[m] = p; sum += p; }
        sum = wave_sum(sum);
        asm volatile("s_waitcnt lgkmcnt(0)" ::: "memory");
        float o0 = 0.f, o1 = 0.f;
        for (int m = 0; m < MEMLEN; ++m) { const bf16* vr = memkv + (size_t)(b * MEMLEN + m) * 1024 + 512 + h * 128;
            const float p = lg[m]; o0 += p * bf2f(vr[lane]); o1 += p * bf2f(vr[lane + 64]); }
        mix[(size_t)t * 2048 + 1536 + h * 128 + lane] = (bf16)f2bf(o0 / sum);
        mix[(size_t)t * 2048 + 1536 + h * 128 + lane + 64] = (bf16)f2bf(o1 / sum);
        asm volatile("s_waitcnt lgkmcnt(0)" ::: "memory");
    }
}

__global__ void __launch_bounds__(NWAVES * 64, 2) mega_fwd(Args args) {
    extern __shared__ __attribute__((aligned(16))) unsigned char lds_raw[];
    cg::grid_group grid = cg::this_grid();
    Frame F;
    F.lds = (LAS unsigned char*)lds_raw;
    F.wave = __builtin_amdgcn_readfirstlane((int)threadIdx.x >> 6);
    F.G = gridDim.x; { const int bx = blockIdx.x; F.vcu = (F.G % 8 == 0) ? (bx % 8) * (F.G / 8) + bx / 8 : bx; }
    unsigned char* ws = args.ws; unsigned char* dob = (unsigned char*)args.out;
    const float* x = args.in[0]; const float* mem = args.in[1];
    const float *ln_mix_pre = args.in[2], *ln_mix_post = args.in[3], *ln_ffn_pre = args.in[4], *ln_ffn_post = args.in[5], *ln_mem = args.in[6];
    bf16* H = (bf16*)(dob + DO_H); bf16* MERGED = H; bf16* MEMN = (bf16*)(dob + DO_MEMN);
    bf16 *WCAT = (bf16*)(dob + DO_WCAT), *WOUT = (bf16*)(dob + DO_WOUT), *WGU = (bf16*)(dob + DO_WGU), *WD = (bf16*)(dob + DO_WD);
    bf16 *WIN = (bf16*)(ws + WS_WIN), *WKV = (bf16*)(ws + WS_WKV), *MEMKV = (bf16*)(ws + WS_MEMKV), *MIX = (bf16*)(ws + WS_MIX);
    bf16 *GV = (bf16*)(ws + WS_GV), *KB = (bf16*)(ws + WS_KB), *VB = (bf16*)(ws + WS_VB), *GATES = (bf16*)(ws + WS_GATES);
    float* KMEAN = (float*)(ws + WS_KMEAN);
    float *Y = (float*)(ws + WS_Y), *FF = (float*)(ws + WS_F), *X1 = (float*)(ws + WS_X1); bf16 *HID = (bf16*)(ws + WS_HID), *H2 = (bf16*)(ws + WS_H2);
    const int gw = F.vcu * NWAVES + F.wave, NGW = F.G * NWAVES;

#define IN(k) (args.ph_lo <= (k) && (k) < args.ph_hi)
#define SEAM(k) do { if (IN(k) && IN((k) + 1)) grid.sync(); } while (0)
    if (IN(0)) {
        LAS float* scr = (LAS float*)(F.lds + F.wave * 16384);
        const int lane0 = opq(lane_id());
        constexpr int I_IN = 16 * (INW / 32), I_KV = 16 * 32, I_A = 12 * 32, I_C = 8 * 32, I_O = 16 * 32, I_G = 16 * (DFF / 32), I_D = (DFF / 64) * 32;
        constexpr int NITEMS = I_IN + I_KV + 2 * I_A + I_C + I_O + 2 * I_G + I_D;
        for (int it = gw; it < NITEMS; it += NGW) {
            int r = it;
            if (r < I_IN) { p0_transpose_item(args.in[7], 1024, INW, WIN, 1024, 0, 0, scr, r, lane0); continue; } r -= I_IN;
            if (r < I_KV) { p0_transpose_item(args.in[13], 1024, 1024, WKV, 1024, 0, 0, scr, r, lane0); continue; } r -= I_KV;
            if (r < I_A) { p0_transpose_item(args.in[14], 768, 1024, WCAT, 2048, 0, 0, scr, r, lane0); continue; } r -= I_A;
            if (r < I_A) { p0_transpose_item(args.in[15], 768, 1024, WCAT, 2048, 768, 0, scr, r, lane0); continue; } r -= I_A;
            if (r < I_C) { p0_transpose_item(args.in[16], 512, 1024, WCAT, 2048, 1536, 0, scr, r, lane0); continue; } r -= I_C;
            if (r < I_O) { p0_transpose_item(args.in[17], 1024, 1024, WOUT, 1024, 0, 0, scr, r, lane0); continue; } r -= I_O;
            if (r < I_G) { p0_transpose_item(args.in[18], 1024, DFF, WGU, 1024, 0, 1, scr, r, lane0); continue; } r -= I_G;
            if (r < I_G) { p0_transpose_item(args.in[19], 1024, DFF, WGU, 1024, 0, 2, scr, r, lane0); continue; } r -= I_G;
            p0_transpose_item(args.in[20], DFF, 1024, WD, DFF, 0, 0, scr, r, lane0);
        }
        for (int m = gw; m < T; m += NGW) rms_row_bf16(x + (size_t)m * DM, ln_mix_pre, H + (size_t)m * DM, lane0);
        for (int m = gw; m < TM; m += NGW) rms_row_bf16(mem + (size_t)m * DM, ln_mem, MEMN + (size_t)m * DM, lane0);
        for (int i = blockIdx.x * (NWAVES * 64) + F.wave * 64 + lane0; i < BATCH * NBLK * 768; i += F.G * NWAVES * 64) KMEAN[i] = 0.f;
    }
    SEAM(0);
    if (IN(1)) {
        pg8::Gemm g{H, WIN, T, INW, 1024}; pg8::StaticOrder S; S.init(T, INW, F.G, (int)blockIdx.x);
        pg8::EpiProj E{MIX, GV, KB, VB, GATES, KMEAN};
        if (DBG_P1 & 1) pg8::gemm_phase<pg8::EpiProj, pg8::StaticOrder, true, true>(F.lds, g, S, E, F.wave);
        pg8::Gemm g2{MEMN, WKV, TM, 1024, 1024}; pg8::StaticOrder S2; S2.init(TM, 1024, F.G, (int)blockIdx.x);
        pg8::EpiBf16Plain E2{MEMKV, 1024};
        if (DBG_P1 & 2) pg8::gemm_phase<pg8::EpiBf16Plain, pg8::StaticOrder, true, true>(F.lds, g2, S2, E2, F.wave);
    }
    SEAM(1);
    if (IN(2)) {
#if DBG_NAIVE_GMLP
    gmlp_body(F, GV, args.in[8], args.in[9], args.in[10], args.in[11], MIX);
#else
    mix2::gmlp_phase(F.lds, F.wave, F.vcu, F.G, GV, args.in[8], args.in[9], args.in[10], args.in[11], MIX);
#endif
#if DBG_NAIVE_MOBA
    moba_body(F, MIX, KB, VB, KMEAN, args.in[12]);
#else
    { __syncthreads();
      const mattn::AttnTensors AT{(const mattn::bf16*)MIX, (const mattn::bf16*)KB, (const mattn::bf16*)VB, (mattn::bf16*)MIX, KMEAN, args.in[12]};
      mattn::attn_phase<8>((char*)lds_raw, AT, F.vcu, F.G);
      __syncthreads(); }
#endif
#if DBG_NAIVE_MEMATTN
    memattn_body(F, MIX, MEMKV);
#else
    mix2::memattn_phase(F.lds, F.wave, F.vcu, F.G, MIX, MEMKV);
#endif
    }
    SEAM(2);
    if (IN(3)) {
        pg8::Gemm g{MIX, WCAT, T, 1024, 2048}; pg8::StaticOrder S; S.init(T, 1024, F.G, (int)blockIdx.x);
        pg8::EpiMerge E{GATES, MERGED};
        pg8::gemm_phase<pg8::EpiMerge, pg8::StaticOrder, true, true, true>(F.lds, g, S, E, F.wave);
    }
    SEAM(3);
    if (IN(4)) {
        pg8::Gemm g{MERGED, WOUT, T, 1024, 1024}; pg8::StaticOrder S; S.init(T, 1024, F.G, (int)blockIdx.x);
        pg8::EpiF32 E{Y, 1024};
        pg8::gemm_phase<pg8::EpiF32, pg8::StaticOrder, true, true>(F.lds, g, S, E, F.wave);
    }
    SEAM(4);
    if (IN(5)) for (int m = gw; m < T; m += NGW) post_norm_row(x + (size_t)m * DM, Y + (size_t)m * DM, ln_mix_post, X1 + (size_t)m * DM, ln_ffn_pre, H2 + (size_t)m * DM, lane_id());
    SEAM(5);
    if (IN(6)) {
        pg8::Gemm g{H2, WGU, T, 2 * DFF, 1024}; pg8::StaticOrder S; S.init(T, 2 * DFF, F.G, (int)blockIdx.x);
        pg8::EpiSwiGLU E{HID, DFF};
        pg8::gemm_phase<pg8::EpiSwiGLU, pg8::StaticOrder, true, true>(F.lds, g, S, E, F.wave);
    }
    SEAM(6);
    if (IN(7)) {
        pg8::Gemm g{HID, WD, T, 1024, DFF}; pg8::StaticOrder S; S.init(T, 1024, F.G, (int)blockIdx.x);
        pg8::EpiF32 E{FF, 1024};
        pg8::gemm_phase<pg8::EpiF32, pg8::StaticOrder, true, true>(F.lds, g, S, E, F.wave);
    }
    SEAM(7);
    if (IN(8)) for (int m = gw; m < T; m += NGW) post_norm_row(X1 + (size_t)m * DM, FF + (size_t)m * DM, ln_ffn_post, args.out + (size_t)m * DM, nullptr, nullptr, lane_id());
}

extern "C" void kernel_launch(void* const* d_in, const int* in_sizes, int n_in, void* d_out, int out_size, void* d_ws, size_t ws_size, hipStream_t stream) {
    static int grid = 0;
    if (grid == 0) {
        if (n_in != 21 || out_size != T * DM || ws_size < WS_NEED) { fprintf(stderr, "kernel_launch: unexpected shapes (n_in %d out %d ws %zu)\n", n_in, out_size, ws_size); grid = -1; return; }
        int dev = 0, cus = 0, per_cu = 0;
        if (hipGetDevice(&dev) != hipSuccess || hipDeviceGetAttribute(&cus, hipDeviceAttributeMultiprocessorCount, dev) != hipSuccess) { grid = -1; return; }
        if (hipFuncSetAttribute((const void*)mega_fwd, hipFuncAttributeMaxDynamicSharedMemorySize, LDS_BYTES) != hipSuccess) { fprintf(stderr, "kernel_launch: hipFuncSetAttribute failed\n"); grid = -1; return; }
        if (hipOccupancyMaxActiveBlocksPerMultiprocessor(&per_cu, (const void*)mega_fwd, NWAVES * 64, LDS_BYTES) != hipSuccess || per_cu < 1) { fprintf(stderr, "kernel_launch: occupancy query says %d\n", per_cu); per_cu = 1; }
        (void)hipGetLastError();
        grid = cus;
    }
    if (grid < 0) return;
    Args a{};
    for (int i = 0; i < 21; ++i) a.in[i] = (const float*)d_in[i];
    a.out = (float*)d_out; a.ws = (unsigned char*)d_ws;
#ifndef MK_PER_PHASE
#define MK_PER_PHASE 0
#endif
    if (MK_PER_PHASE) {
        for (int p = 0; p < 9; ++p) { a.ph_lo = p; a.ph_hi = p + 1; hipLaunchKernelGGL(mega_fwd, dim3(grid), dim3(NWAVES * 64), LDS_BYTES, stream, a); }
    } else {
        a.ph_lo = 0; a.ph_hi = 9;
        void* kargs[] = {&a};
        hipError_t e = hipLaunchCooperativeKernel((const void*)mega_fwd, dim3(grid), dim3(NWAVES * 64), kargs, LDS_BYTES, stream);
        if (e != hipSuccess) fprintf(stderr, "kernel_launch: cooperative launch failed: %s (grid %d)\n", hipGetErrorString(e), grid);
    }
}
```

```cpp
#include <hip/hip_runtime.h>
#include <hip/hip_cooperative_groups.h>
#include <cstdio>
#include <cstdint>
namespace cg = cooperative_groups;

typedef unsigned short bf16;
typedef unsigned v4u __attribute__((ext_vector_type(4)));
typedef float f32x4 __attribute__((ext_vector_type(4)));
#define LAS __attribute__((address_space(3)))
#define GAS __attribute__((address_space(1)))

constexpr int BATCH = 16, SEQ = 2048, DM = 1024, T = BATCH * SEQ;
constexpr int MEMLEN = 256, TM = BATCH * MEMLEN;
constexpr int CHUNK = 128;
constexpr int NH = 12, MBLK = 256, NBLK = SEQ / MBLK;
constexpr int MH = 4;
constexpr int DFF = 2816, INW = 7424;
constexpr float EPS = 1e-6f;
constexpr float LOG2E = 1.4426950408889634f;
constexpr float C2Q = 0.125f * LOG2E;
constexpr float C2M = 0.08838834764831845f * LOG2E;

constexpr size_t MiB = 1u << 20;
constexpr size_t DO_H = 0;
constexpr size_t DO_MEMN = 64 * MiB;
constexpr size_t DO_WCAT = 72 * MiB;
constexpr size_t DO_WOUT = 76 * MiB;
constexpr size_t DO_WGU = 78 * MiB;
constexpr size_t DO_WD = 89 * MiB;
constexpr size_t WS_CTL = 0;
constexpr size_t WS_KMEAN = 256 * 1024;
constexpr size_t WS_WIN = 1 * MiB;
constexpr size_t WS_WKV = 16 * MiB;
constexpr size_t WS_MEMKV = 18 * MiB;
constexpr size_t WS_MIX = 26 * MiB;
constexpr size_t WS_GV = 154 * MiB;
constexpr size_t WS_KB = 202 * MiB;
constexpr size_t WS_VB = 250 * MiB;
constexpr size_t WS_GATES = 298 * MiB;
constexpr size_t WS_Y = 26 * MiB;
constexpr size_t WS_HID = 26 * MiB;
constexpr size_t WS_F = 202 * MiB;
constexpr size_t WS_H2 = 320 * MiB;
constexpr size_t WS_X1 = 384 * MiB;
constexpr size_t WS_NEED = 512 * MiB;

__device__ __forceinline__ float bf2f(bf16 v) { return __uint_as_float((unsigned)v << 16); }
__device__ __forceinline__ unsigned f2bf(float f) { unsigned u = __float_as_uint(f); return (u + 0x7fffu + ((u >> 16) & 1u)) >> 16; }
__device__ __forceinline__ unsigned pk2(float lo, float hi) { return f2bf(lo) | (f2bf(hi) << 16); }
__device__ __forceinline__ float wave_sum(float v) {
#pragma unroll
    for (int o = 1; o < 64; o <<= 1) v += __shfl_xor(v, o);
    return v;
}
__device__ __forceinline__ float wave_max(float v) {
#pragma unroll
    for (int o = 1; o < 64; o <<= 1) v = fmaxf(v, __shfl_xor(v, o));
    return v;
}
__device__ __forceinline__ float fast_sigmoid(float x) { return __builtin_amdgcn_rcpf(1.0f + __builtin_amdgcn_exp2f(-LOG2E * x)); }
__device__ __forceinline__ float gelu_tanh(float x) {
    const float u = 0.7978845608028654f * (x + 0.044715f * x * x * x);
    return x * __builtin_amdgcn_rcpf(1.0f + __builtin_amdgcn_exp2f(-2.0f * LOG2E * u));
}
__device__ __forceinline__ int t5_bucket(int n) {
    if (n < 16) return n;
    int large = 16 + (int)(logf((float)n / 16.0f) / 2.0794415416798357f * 16.0f);
    return large < 31 ? large : 31;
}
namespace pg8 {
#define PG8_LAS __attribute__((address_space(3)))
typedef unsigned short bf16_t;
typedef short bf16x8 __attribute__((ext_vector_type(8)));
typedef float f32x4 __attribute__((ext_vector_type(4)));
typedef unsigned u32x4 __attribute__((ext_vector_type(4)));
constexpr int BM = 256, BK = 64, HALF = 128, HTB = HALF * BK * 2  , STAGE_BYTES = 8 * HTB, NXCD = 8, WGM = 8;

__host__ __device__ __forceinline__ int lds_byte(int r, int c) { const int st = (r >> 4) * 2 + (c >> 5), rr = r & 15, cc = c & 31, ob = rr * 64 + cc * 2; return st * 1024 + (ob ^ (((ob >> 9) & 1) << 5)); }
__host__ __device__ __forceinline__ void stage_rc(int b, int& R, int& C) { const int st = b / 1024, sb = b % 1024, swz = sb ^ (((sb >> 9) & 1) << 5); R = (st >> 1) * 16 + swz / 64; C = (st & 1) * 32 + (swz % 64) / 2; }
__host__ __device__ __forceinline__ int perm32(int rho) { const int n = rho >> 4, i = rho & 15; return 8 * (i >> 2) + 4 * n + (i & 3); }

struct Unit { int pm, pn; };
struct Gemm { const bf16_t* A; const bf16_t* Bt; int M, N, K; };

struct StaticOrder {
    int nM, nN, nwg, G, c;
    __host__ __device__ void init(int M, int N, int G_, int c_) { nM = M / BM; nN = N / BM; nwg = nM * nN; G = G_; c = c_; }
    __host__ __device__ bool next(int i, Unit& u) const {
        const long L = (long)i * G + c; if (L >= nwg) return false;
        int wgid = (int)L; { const int q = nwg / NXCD, r = nwg % NXCD, xcd = wgid % NXCD, off = wgid / NXCD; wgid = (xcd < r ? xcd * (q + 1) : r * (q + 1) + (xcd - r) * q) + off; }
        const int nig = WGM * nN, gid = wgid / nig, fm = gid * WGM, gsz = (nM - fm) < WGM ? (nM - fm) : WGM;
        u.pm = fm + ((wgid % nig) % gsz); u.pn = (wgid % nig) / gsz; return true;
    }
    __device__ __forceinline__ void a_ready(const Unit&) const {}
    __device__ __forceinline__ void done(const Unit&) const {}
};
#ifndef DBG_RAW
#define DBG_RAW 0
#endif
#ifndef DBG_NO_KMEAN
#define DBG_NO_KMEAN 0
#endif
typedef float f32x2_t __attribute__((ext_vector_type(2))); typedef __bf16 bf16x2_t __attribute__((ext_vector_type(2)));
__device__ __forceinline__ unsigned cvt_pk_bf16(float lo, float hi) { f32x2_t v = {lo, hi}; bf16x2_t b = __builtin_convertvector(v, bf16x2_t); return __builtin_bit_cast(unsigned, b); }

template <int ACT> __device__ __forceinline__ f32x4 act4(f32x4 v, float sc) {
    if (ACT == 0) return v * sc;
    f32x4 o;
#pragma unroll
    for (int j = 0; j < 4; ++j) o[j] = (ACT == 1) ? gelu_tanh(v[j]) : fast_sigmoid(v[j]);
    return o;
}
template <int ACT> __device__ __forceinline__ void store_tile_bf16(const f32x4 (&acc)[2][2][4][2], bf16_t* base, int ld, int row0, int col0, float sc) {
#pragma unroll
    for (int ai = 0; ai < 2; ++ai)
#pragma unroll
        for (int m = 0; m < 4; ++m) { bf16_t* rowp = base + (size_t)(row0 + ai * HALF + m * 16) * ld + col0;
#pragma unroll
            for (int bj = 0; bj < 2; ++bj) { const f32x4 v0 = act4<ACT>(acc[ai][bj][m][0], sc), v1 = act4<ACT>(acc[ai][bj][m][1], sc);
                u32x4 w; w.x = cvt_pk_bf16(v0[0], v0[1]); w.y = cvt_pk_bf16(v0[2], v0[3]); w.z = cvt_pk_bf16(v1[0], v1[1]); w.w = cvt_pk_bf16(v1[2], v1[3]);
                *(u32x4*)(rowp + bj * HALF) = w; } }
}
struct EpiProj {
    static constexpr bool PERM = true, AFTER_DRAIN = false;
    bf16_t *mix, *gv, *kb, *vb, *gates; float* kmean;
    __device__ __forceinline__ void operator()(const f32x4 (&acc)[2][2][4][2], const Unit& u, int wr, int wc, int fr, int fq) const {
        const int pn = u.pn, row0 = u.pm * BM + wr * 64 + fr, cw = wc * 32 + 8 * fq;
#if DBG_RAW
        if (pn < 3) store_tile_bf16<0>(acc, mix, 2048, row0, pn * 256 + cw, 1.f);
        else if (pn < 6) store_tile_bf16<0>(acc, gv, 768, row0, (pn - 3) * 256 + cw, 1.f);
        else if (pn < 9) store_tile_bf16<0>(acc, mix, 2048, row0, 768 + (pn - 6) * 256 + cw, 1.f);
#else
        if (pn < 3) store_tile_bf16<1>(acc, mix, 2048, row0, pn * 256 + cw, 1.f);
        else if (pn < 6) store_tile_bf16<1>(acc, gv, 768, row0, (pn - 3) * 256 + cw, 1.f);
        else if (pn < 9) store_tile_bf16<0>(acc, mix, 2048, row0, 768 + (pn - 6) * 256 + cw, C2Q);
#endif
        else if (pn < 12) {
            store_tile_bf16<0>(acc, kb, 768, row0, (pn - 9) * 256 + cw, 1.f);
#pragma unroll
            for (int bj = 0; bj < 2; ++bj)
#pragma unroll
                for (int n = 0; n < 2; ++n) { f32x4 s = (f32x4){0.f, 0.f, 0.f, 0.f};
#pragma unroll
                    for (int ai = 0; ai < 2; ++ai)
#pragma unroll
                        for (int m = 0; m < 4; ++m) s += acc[ai][bj][m][n];
#pragma unroll
                    for (int j = 0; j < 4; ++j) { float v = s[j]; v += __shfl_xor(v, 1); v += __shfl_xor(v, 2); v += __shfl_xor(v, 4); v += __shfl_xor(v, 8);
                        if (fr == 0 && !DBG_NO_KMEAN) atomicAdd(kmean + (size_t)u.pm * 768 + (pn - 9) * 256 + bj * HALF + cw + 4 * n + j, v * (1.0f / 256.0f)); } }
        }
        else if (pn < 15) store_tile_bf16<0>(acc, vb, 768, row0, (pn - 12) * 256 + cw, 1.f);
#if DBG_RAW
        else if (pn < 17) store_tile_bf16<0>(acc, mix, 2048, row0, 1536 + (pn - 15) * 256 + cw, 1.f);
        else store_tile_bf16<0>(acc, gates, 3072, row0, (pn - 17) * 256 + cw, 1.f);
#else
        else if (pn < 17) store_tile_bf16<0>(acc, mix, 2048, row0, 1536 + (pn - 15) * 256 + cw, C2M);
        else store_tile_bf16<2>(acc, gates, 3072, row0, (pn - 17) * 256 + cw, 1.f);
#endif
    }
};
struct EpiBf16Plain {
    static constexpr bool PERM = true, AFTER_DRAIN = false;
    bf16_t* O; int ld;
    __device__ __forceinline__ void operator()(const f32x4 (&acc)[2][2][4][2], const Unit& u, int wr, int wc, int fr, int fq) const {
        store_tile_bf16<0>(acc, O, ld, u.pm * BM + wr * 64 + fr, u.pn * BM + wc * 32 + 8 * fq, 1.f);
    }
};
struct EpiF32 {
    static constexpr bool PERM = false, AFTER_DRAIN = false;
    float* O; int ld;
    __device__ __forceinline__ void operator()(const f32x4 (&acc)[2][2][4][2], const Unit& u, int wr, int wc, int fr, int fq) const {
        const int row0 = u.pm * BM + wr * 64 + fr, col0 = u.pn * BM + wc * 32 + 4 * fq;
#pragma unroll
        for (int ai = 0; ai < 2; ++ai)
#pragma unroll
            for (int m = 0; m < 4; ++m) { float* rowp = O + (size_t)(row0 + ai * HALF + m * 16) * ld + col0;
#pragma unroll
                for (int bj = 0; bj < 2; ++bj)
#pragma unroll
                    for (int n = 0; n < 2; ++n) *(f32x4*)(rowp + bj * HALF + n * 16) = acc[ai][bj][m][n]; }
    }
};
struct EpiSwiGLU {
    static constexpr bool PERM = true, AFTER_DRAIN = false;
    bf16_t* O; int ld;
    __device__ __forceinline__ void operator()(const f32x4 (&acc)[2][2][4][2], const Unit& u, int wr, int wc, int fr, int fq) const {
        const int row0 = u.pm * BM + wr * 64 + fr, col0 = u.pn * HALF + wc * 32 + 8 * fq;
#pragma unroll
        for (int ai = 0; ai < 2; ++ai)
#pragma unroll
            for (int m = 0; m < 4; ++m) { f32x4 h[2];
#pragma unroll
                for (int n = 0; n < 2; ++n)
#pragma unroll
                    for (int j = 0; j < 4; ++j) { const float g = acc[ai][0][m][n][j]; h[n][j] = g * fast_sigmoid(g) * acc[ai][1][m][n][j]; }
                u32x4 w; w.x = cvt_pk_bf16(h[0][0], h[0][1]); w.y = cvt_pk_bf16(h[0][2], h[0][3]); w.z = cvt_pk_bf16(h[1][0], h[1][1]); w.w = cvt_pk_bf16(h[1][2], h[1][3]);
                *(u32x4*)(O + (size_t)(row0 + ai * HALF + m * 16) * ld + col0) = w; }
    }
};
struct EpiMerge {
    static constexpr bool PERM = true, AFTER_DRAIN = false;
    const bf16_t* gates; bf16_t* O;
    __device__ __forceinline__ bool want_mid(int t) const { return t == 12 || t == 24; }
    __device__ __forceinline__ void mid(f32x4 (&acc)[2][2][4][2], const Unit& u, int t, int wr, int wc, int fr, int fq) const {
        const int seg = (t == 12) ? 0 : 1;
        int row0 = u.pm * BM + wr * 64 + fr; asm volatile("" : "+v"(row0));
        const int col0 = u.pn * BM + wc * 32 + 8 * fq;
#pragma unroll
        for (int ai = 0; ai < 2; ++ai)
#pragma unroll
            for (int m = 0; m < 4; ++m) { const bf16_t* gp = gates + (size_t)(row0 + ai * HALF + m * 16) * 3072 + seg * 1024 + col0;
#pragma unroll
                for (int bj = 0; bj < 2; ++bj) { const u32x4 ga = *(const u32x4*)(gp + bj * HALF), gb = *(const u32x4*)(gp + 1024 + bj * HALF);
#pragma unroll
                    for (int e = 0; e < 8; ++e) { const unsigned wa = ga[e >> 1], wb = gb[e >> 1];
                        const float a = __uint_as_float((e & 1) ? (wa & 0xffff0000u) : (wa << 16)), b = __uint_as_float((e & 1) ? (wb & 0xffff0000u) : (wb << 16));
                        acc[ai][bj][m][e >> 2][e & 3] *= a * __builtin_amdgcn_rcpf(b); } } }
    }
    __device__ __forceinline__ void operator()(const f32x4 (&acc)[2][2][4][2], const Unit& u, int wr, int wc, int fr, int fq) const {
        int row0 = u.pm * BM + wr * 64 + fr; asm volatile("" : "+v"(row0));
        const int col0 = u.pn * BM + wc * 32 + 8 * fq;
#pragma unroll
        for (int ai = 0; ai < 2; ++ai)
#pragma unroll
            for (int m = 0; m < 4; ++m) { const size_t r = (size_t)(row0 + ai * HALF + m * 16);
#pragma unroll
                for (int bj = 0; bj < 2; ++bj) { const u32x4 ga = *(const u32x4*)(gates + r * 3072 + 2048 + col0 + bj * HALF); float o[8];
#pragma unroll
                    for (int e = 0; e < 8; ++e) { const unsigned wa = ga[e >> 1]; o[e] = acc[ai][bj][m][e >> 2][e & 3] * __uint_as_float((e & 1) ? (wa & 0xffff0000u) : (wa << 16)); }
                    u32x4 w; w.x = cvt_pk_bf16(o[0], o[1]); w.y = cvt_pk_bf16(o[2], o[3]); w.z = cvt_pk_bf16(o[4], o[5]); w.w = cvt_pk_bf16(o[6], o[7]);
                    *(u32x4*)(O + r * 1024 + col0 + bj * HALF) = w; } }
    }
};
template <class Epi, class Sched, bool ALIGN_EPI = false, bool SP2 = false, bool MID = false>
__device__ __forceinline__ void gemm_phase(PG8_LAS unsigned char* lds, const Gemm g, const Sched& S, const Epi& E, int wave_id) {
    int tid_ = wave_id * 64 + (int)__builtin_amdgcn_mbcnt_hi(~0u, __builtin_amdgcn_mbcnt_lo(~0u, 0u)); asm volatile("" : "+v"(tid_));
    const int tid = tid_, wid = __builtin_amdgcn_readfirstlane(tid >> 6), lane = tid & 63, wr = wid >> 2, wc = wid & 3, fr = lane & 15, fq = lane >> 4;
    const int K = g.K, nt = K / BK;
    unsigned voffA[2], voffB[2];
#pragma unroll
    for (int i = 0; i < 2; ++i) { int R, C; stage_rc(tid * 16 + i * 8192, R, C); const int Rb = Epi::PERM ? ((R & ~31) + perm32(R & 31)) : R;
        voffA[i] = (unsigned)(R * K + C) * 2u; voffB[i] = (unsigned)(Rb * K + C) * 2u; }
    const size_t kstep = (size_t)(BK * 2);
    const size_t hstep = (size_t)HALF * K * 2;
    const size_t tstep = 2 * hstep;
    const unsigned ldsw = (unsigned)wid * 1024u;
    const int aoff = lds_byte(wr * 64 + fr, fq * 8), boff = lds_byte(wc * 32 + fr, fq * 8);
#define PG8_SA(b, h) (((b) * 2 + (h)) * HTB)
#define PG8_SB(b, h) ((4 + (b) * 2 + (h)) * HTB)
#define PG8_STAGE(bufoff, gbase, voff) do { _Pragma("unroll") for (int _i = 0; _i < 2; ++_i) \
        __builtin_amdgcn_global_load_lds((const unsigned*)((const char*)(gbase) + (voff)[_i]), (PG8_LAS unsigned*)(lds + (bufoff) + ldsw + _i * 8192), 16, 0, 0); } while (0)
#define PG8_LDA(dst, b, h) do { _Pragma("unroll") for (int m = 0; m < 4; ++m) _Pragma("unroll") for (int k = 0; k < 2; ++k) dst[m][k] = *(const PG8_LAS bf16x8*)(lds + PG8_SA(b, h) + aoff + m * 2048 + k * 1024); } while (0)
#define PG8_LDB(dst, b, h) do { _Pragma("unroll") for (int n = 0; n < 2; ++n) _Pragma("unroll") for (int k = 0; k < 2; ++k) dst[n][k] = *(const PG8_LAS bf16x8*)(lds + PG8_SB(b, h) + boff + n * 2048 + k * 1024); } while (0)
#define PG8_MMA(ai, bj, At, Bt) do { __builtin_amdgcn_s_setprio(1); _Pragma("unroll") for (int m = 0; m < 4; ++m) _Pragma("unroll") for (int n = 0; n < 2; ++n) _Pragma("unroll") for (int k = 0; k < 2; ++k) \
        acc[ai][bj][m][n] = __builtin_amdgcn_mfma_f32_16x16x32_bf16(Bt[n][k], At[m][k], acc[ai][bj][m][n], 0, 0, 0); __builtin_amdgcn_s_setprio(0); } while (0)
#define PG8_WAIT_V(n) asm volatile("s_waitcnt vmcnt(" #n ")" ::: "memory")
#define PG8_WAIT_L(n) asm volatile("s_waitcnt lgkmcnt(" #n ")" ::: "memory")
#define PG8_BAR __builtin_amdgcn_s_barrier()
#define PG8_SCHED __builtin_amdgcn_sched_barrier(0)
    Unit cur, nxt; int ui = 0;
    if (!S.next(0, cur)) return;
    f32x4 acc[2][2][4][2];
#pragma unroll
    for (int a = 0; a < 2; ++a)
#pragma unroll
        for (int b = 0; b < 2; ++b)
#pragma unroll
            for (int m = 0; m < 4; ++m)
#pragma unroll
                for (int n = 0; n < 2; ++n) acc[a][b][m][n] = (f32x4){0.f, 0.f, 0.f, 0.f};
    bf16x8 At[4][2], B0[2][2], B1[2][2];
    const char* cA = (const char*)g.A + (size_t)cur.pm * tstep; const char* cB = (const char*)g.Bt + (size_t)cur.pn * tstep;
    S.a_ready(cur);
    if constexpr (SP2) {
        PG8_STAGE(PG8_SB(0, 0), cB, voffB); PG8_STAGE(PG8_SB(0, 1), cB + hstep, voffB); PG8_STAGE(PG8_SA(0, 0), cA, voffA); PG8_STAGE(PG8_SA(0, 1), cA + hstep, voffA);
        if (wr == 1) PG8_BAR;
        PG8_WAIT_V(2); PG8_BAR;
        PG8_STAGE(PG8_SB(1, 0), cB + kstep, voffB); PG8_STAGE(PG8_SA(1, 0), cA + kstep, voffA); PG8_STAGE(PG8_SB(1, 1), cB + hstep + kstep, voffB);
        PG8_WAIT_V(6); PG8_BAR;
    } else {
        PG8_STAGE(PG8_SB(0, 0), cB, voffB); PG8_STAGE(PG8_SA(0, 0), cA, voffA); PG8_STAGE(PG8_SB(0, 1), cB + hstep, voffB); PG8_STAGE(PG8_SA(0, 1), cA + hstep, voffA);
        if (wr == 1) PG8_BAR;
        PG8_WAIT_V(4); PG8_BAR;
        PG8_STAGE(PG8_SB(1, 0), cB + kstep, voffB); PG8_STAGE(PG8_SA(1, 0), cA + kstep, voffA); PG8_STAGE(PG8_SB(1, 1), cB + hstep + kstep, voffB);
        PG8_WAIT_V(6); PG8_BAR;
    }
    for (;;) {
        const bool has_next = S.next(ui + 1, nxt);
        const char* nA = has_next ? (const char*)g.A + (size_t)nxt.pm * tstep : cA; const char* nB = has_next ? (const char*)g.Bt + (size_t)nxt.pn * tstep : cB;
        for (int t = 0; t < nt; t += 2) {
            const bool last = (t == nt - 2);
            const char* a1 = cA + (size_t)(t + 1) * kstep;
            const char* a2 = last ? nA : cA + (size_t)(t + 2) * kstep; const char* b2 = last ? nB : cB + (size_t)(t + 2) * kstep;
            const char* a3 = a2 + kstep; const char* b3 = b2 + kstep;
            if (last && has_next) S.a_ready(nxt);
            if constexpr (SP2) {
            PG8_LDB(B0, 0, 0); PG8_LDB(B1, 0, 1); PG8_SCHED; PG8_LDA(At, 0, 0); PG8_STAGE(PG8_SA(1, 1), a1 + hstep, voffA);
            PG8_WAIT_V(8); PG8_WAIT_L(0); PG8_BAR; PG8_MMA(0, 0, At, B0); PG8_MMA(0, 1, At, B1); PG8_BAR; PG8_SCHED;
            PG8_LDA(At, 0, 1); PG8_STAGE(PG8_SB(0, 0), b2, voffB); PG8_STAGE(PG8_SB(0, 1), b2 + hstep, voffB); PG8_STAGE(PG8_SA(0, 0), a2, voffA);
            PG8_WAIT_V(8); PG8_WAIT_L(0); PG8_BAR; PG8_MMA(1, 0, At, B0); PG8_MMA(1, 1, At, B1); PG8_BAR; PG8_SCHED;
            PG8_LDB(B0, 1, 0); PG8_LDB(B1, 1, 1); PG8_SCHED; PG8_LDA(At, 1, 0); PG8_STAGE(PG8_SA(0, 1), a2 + hstep, voffA);
            PG8_WAIT_V(8); PG8_WAIT_L(0); PG8_BAR; PG8_MMA(0, 0, At, B0); PG8_MMA(0, 1, At, B1); PG8_BAR; PG8_SCHED;
            PG8_LDA(At, 1, 1); PG8_STAGE(PG8_SB(1, 0), b3, voffB); PG8_STAGE(PG8_SB(1, 1), b3 + hstep, voffB); PG8_STAGE(PG8_SA(1, 0), a3, voffA);
            PG8_WAIT_V(8); PG8_WAIT_L(0); PG8_BAR; PG8_MMA(1, 0, At, B0); PG8_MMA(1, 1, At, B1); PG8_BAR; PG8_SCHED;
            } else {
            PG8_LDB(B0, 0, 0); PG8_SCHED; PG8_LDA(At, 0, 0); PG8_STAGE(PG8_SA(1, 1), a1 + hstep, voffA);
            PG8_WAIT_L(8); PG8_BAR; PG8_WAIT_L(0); PG8_MMA(0, 0, At, B0); PG8_BAR; PG8_SCHED;
            PG8_LDB(B1, 0, 1); PG8_STAGE(PG8_SB(0, 0), b2, voffB);
            PG8_BAR; PG8_WAIT_L(0); PG8_MMA(0, 1, At, B1); PG8_BAR;
            PG8_LDA(At, 0, 1); PG8_STAGE(PG8_SA(0, 0), a2, voffA);
            PG8_BAR; PG8_WAIT_L(0); PG8_MMA(1, 0, At, B0); PG8_BAR; PG8_SCHED;
            PG8_STAGE(PG8_SB(0, 1), b2 + hstep, voffB);
            PG8_WAIT_V(6); PG8_BAR; PG8_MMA(1, 1, At, B1); PG8_BAR;
            PG8_LDB(B0, 1, 0); PG8_SCHED; PG8_LDA(At, 1, 0); PG8_STAGE(PG8_SA(0, 1), a2 + hstep, voffA);
            PG8_WAIT_L(8); PG8_BAR; PG8_WAIT_L(0); PG8_MMA(0, 0, At, B0); PG8_BAR; PG8_SCHED;
            PG8_LDB(B1, 1, 1); PG8_STAGE(PG8_SB(1, 0), b3, voffB);
            PG8_BAR; PG8_WAIT_L(0); PG8_MMA(0, 1, At, B1); PG8_BAR;
            PG8_LDA(At, 1, 1); PG8_STAGE(PG8_SA(1, 0), a3, voffA);
            PG8_BAR; PG8_WAIT_L(0); PG8_MMA(1, 0, At, B0); PG8_BAR; PG8_SCHED;
            PG8_STAGE(PG8_SB(1, 1), b3 + hstep, voffB);
            PG8_WAIT_V(6); PG8_BAR; PG8_MMA(1, 1, At, B1); PG8_BAR;
            }
            if constexpr (MID) { if (E.want_mid(t + 2)) E.mid(acc, cur, t + 2, wr, wc, fr, fq); }
        }
        if constexpr (ALIGN_EPI) { if (wr == 0) PG8_BAR; }
        if constexpr (!Epi::AFTER_DRAIN) { E(acc, cur, wr, wc, fr, fq); S.done(cur); }
        if (!has_next) break;
#pragma unroll
        for (int a = 0; a < 2; ++a)
#pragma unroll
            for (int b = 0; b < 2; ++b)
#pragma unroll
                for (int m = 0; m < 4; ++m)
#pragma unroll
                    for (int n = 0; n < 2; ++n) acc[a][b][m][n] = (f32x4){0.f, 0.f, 0.f, 0.f};
        cur = nxt; cA = nA; cB = nB; ++ui;
        if constexpr (ALIGN_EPI) { if (wr == 1) PG8_BAR; }
    }
    PG8_WAIT_V(0);
    if constexpr (!ALIGN_EPI) { if (wr == 0) PG8_BAR; }
    PG8_BAR;
    if constexpr (Epi::AFTER_DRAIN) { E.fused(acc, cur, wr, wc, fr, fq, lds, wid, lane); S.done(cur); }
#undef PG8_SA
#undef PG8_SB
#undef PG8_STAGE
#undef PG8_LDA
#undef PG8_LDB
#undef PG8_MMA
#undef PG8_WAIT_V
#undef PG8_WAIT_L
#undef PG8_BAR
#undef PG8_SCHED
}
}
#include <hip/hip_bf16.h>
#include <cmath>
namespace mattn {
using bf16=__hip_bfloat16;
using bf16x8=__attribute__((ext_vector_type(8)))short;
using s16x4=__attribute__((ext_vector_type(4)))short;
using f32x16=__attribute__((ext_vector_type(16)))float;
using u32x4=__attribute__((ext_vector_type(4)))unsigned;
typedef float f32x4_t __attribute__((ext_vector_type(4)));
constexpr int SEQ=2048,D=64,QP=2048,KP=768,QCOL=768,NHEADS=12;
constexpr int NW=8,QBLK=32,QB=QBLK*NW,KVBLK=64,NQB=SEQ/QB;
__device__ __forceinline__ int crow(int r,int hi){return (r&3)+8*(r>>2)+4*hi;}
#define SBAR() __builtin_amdgcn_sched_barrier(0)
constexpr int NSLOT=3, SLOTB=8192;
constexpr int LDS_K=0, LDS_V=NSLOT*SLOTB, LDS_WS=2*NSLOT*SLOTB, LDS_OST=LDS_WS+NW*64*4, LDS_TAB=LDS_OST+NW*4096, LDS_BYTES=LDS_TAB+2048;
constexpr float C2=0.125f*1.4426950408889634f;
__device__ __forceinline__ void glds16(const void*gsrc,unsigned lds_dst){unsigned keep;
  asm volatile("s_mov_b32 %0, m0\n\ts_mov_b32 m0, %2\n\ts_nop 0\n\tglobal_load_lds_dwordx4 %1, off\n\ts_mov_b32 m0, %0":"=&s"(keep):"v"(gsrc),"s"(lds_dst):"memory");}
__device__ __forceinline__ float max3f(float a,float b,float c){float r;asm("v_max3_f32 %0, %1, %2, %3":"=v"(r):"v"(a),"v"(b),"v"(c));return r;}
__device__ __forceinline__ float max2f(float a,float b){float r;asm("v_max_f32_e32 %0, %1, %2":"=v"(r):"v"(a),"v"(b));return r;}
__device__ __forceinline__ float fadd_s(float a,float b){float r;asm("v_add_f32_e32 %0, %1, %2":"=v"(r):"v"(a),"v"(b));return r;}
__device__ __forceinline__ float fsub_s(float a,float b){float r;asm("v_sub_f32_e32 %0, %1, %2":"=v"(r):"v"(a),"v"(b));return r;}
typedef float f32x2_t __attribute__((ext_vector_type(2))); typedef __bf16 bf16x2_t __attribute__((ext_vector_type(2)));
__device__ __forceinline__ unsigned cvtpk_s(float lo,float hi){f32x2_t v={lo,hi};bf16x2_t b=__builtin_convertvector(v,bf16x2_t);return __builtin_bit_cast(unsigned,b);}
#define WAIT_BAR(N) asm volatile("s_waitcnt vmcnt(" #N ") lgkmcnt(0)\n\ts_barrier":::"memory")

__device__ __forceinline__ void qkt(f32x16&p0,f32x16&p1,const char*Kslot,const bf16x8*qr,const f32x16&negm,int r32,int hi){
  const char*kb=Kslot+hi*1024+r32*16;
  #pragma unroll
  for(int d0=0;d0<4;++d0){
    const bf16x8 b0=*reinterpret_cast<const bf16x8*>(kb+d0*2048);
    const bf16x8 b1=*reinterpret_cast<const bf16x8*>(kb+d0*2048+512);
    if(d0==0){p0=__builtin_amdgcn_mfma_f32_32x32x16_bf16(b0,qr[0],negm,0,0,0);p1=__builtin_amdgcn_mfma_f32_32x32x16_bf16(b1,qr[0],negm,0,0,0);}
    else{p0=__builtin_amdgcn_mfma_f32_32x32x16_bf16(b0,qr[d0],p0,0,0,0);p1=__builtin_amdgcn_mfma_f32_32x32x16_bf16(b1,qr[d0],p1,0,0,0);}}
}
typedef __attribute__((address_space(3))) const char* lds_cptr;
typedef short v4i16_t __attribute__((ext_vector_type(4)));
__device__ __forceinline__ void kload8(bf16x8*kf,lds_cptr kp){
  kf[0]=*(const __attribute__((address_space(3))) bf16x8*)(kp);      kf[1]=*(const __attribute__((address_space(3))) bf16x8*)(kp+512);
  kf[2]=*(const __attribute__((address_space(3))) bf16x8*)(kp+2048); kf[3]=*(const __attribute__((address_space(3))) bf16x8*)(kp+2560);
  kf[4]=*(const __attribute__((address_space(3))) bf16x8*)(kp+4096); kf[5]=*(const __attribute__((address_space(3))) bf16x8*)(kp+4608);
  kf[6]=*(const __attribute__((address_space(3))) bf16x8*)(kp+6144); kf[7]=*(const __attribute__((address_space(3))) bf16x8*)(kp+6656);
}
__device__ __forceinline__ void kload2(bf16x8*kf,lds_cptr kp,int j){ kf[2*j]=*(const __attribute__((address_space(3))) bf16x8*)(kp+j*2048); kf[2*j+1]=*(const __attribute__((address_space(3))) bf16x8*)(kp+j*2048+512); }
__device__ __forceinline__ s16x4 vtr(lds_cptr p){ return __builtin_bit_cast(s16x4,__builtin_amdgcn_ds_read_tr16_b64_v4i16((__attribute__((address_space(3))) v4i16_t*)p)); }
__device__ __forceinline__ float rowmax(const f32x16&p0,const f32x16&p1){
  float a=max3f(p0[0],p0[1],p1[0]),b=max3f(p0[2],p0[3],p1[1]);a=max3f(a,p1[2],p1[3]);
  #pragma unroll
  for(int r=4;r<16;r+=4){a=max3f(a,p0[r],p0[r+1]);b=max3f(b,p0[r+2],p0[r+3]);a=max3f(a,p1[r],p1[r+1]);b=max3f(b,p1[r+2],p1[r+3]);}
  const float m=max2f(a,b);
  auto rr=__builtin_amdgcn_permlane32_swap(__float_as_uint(m),__float_as_uint(m),false,false);
  return max2f(__uint_as_float(rr[0]),__uint_as_float(rr[1]));
}
__device__ __forceinline__ void pv(f32x16*o,int vb,bf16x8 pa0,bf16x8 pa1,bf16x8 pa2,bf16x8 pa3){
  #pragma unroll
  for(int d0=0;d0<2;++d0){s16x4 lo[4],hi[4];
    #pragma unroll
    for(int ks=0;ks<4;++ks){
      asm volatile("ds_read_b64_tr_b16 %0,%1 offset:%c2":"=&v"(lo[ks]):"v"(vb),"i"(d0*4096+ks*1024):"memory");
      asm volatile("ds_read_b64_tr_b16 %0,%1 offset:%c2":"=&v"(hi[ks]):"v"(vb),"i"(d0*4096+ks*1024+512):"memory");}
    asm volatile("s_waitcnt lgkmcnt(0)":::"memory");SBAR();
    #define PK(k) (bf16x8){lo[k][0],lo[k][1],lo[k][2],lo[k][3],hi[k][0],hi[k][1],hi[k][2],hi[k][3]}
    o[d0]=__builtin_amdgcn_mfma_f32_32x32x16_bf16(pa0,PK(0),o[d0],0,0,0);
    o[d0]=__builtin_amdgcn_mfma_f32_32x32x16_bf16(pa1,PK(1),o[d0],0,0,0);
    o[d0]=__builtin_amdgcn_mfma_f32_32x32x16_bf16(pa2,PK(2),o[d0],0,0,0);
    o[d0]=__builtin_amdgcn_mfma_f32_32x32x16_bf16(pa3,PK(3),o[d0],0,0,0);
    #undef PK
  }
}

#ifndef ATTN_STORE16
#define ATTN_STORE16(p,v) (*(u32x4*)(p)=(v))
#endif
template<int THRL> __device__ __forceinline__ void attn_unit(int b,int h,int qb,const bf16*Q,const bf16*__restrict__ K,const bf16*__restrict__ V,bf16*O,const float*__restrict__ kmean,const float*__restrict__ relb,char*shm){
  const int tid=threadIdx.x,lane=tid&63,r32=lane&31,hi=lane>>5; const int wid=__builtin_amdgcn_readfirstlane(tid>>6);
  const long rowbase=(long)b*SEQ; const int q0=qb*QB;
  const bf16*Qw=Q+(rowbase+q0+wid*QBLK)*QP+QCOL+h*D;
  const bf16*Kh=K+rowbase*KP+h*D,*Vh=V+rowbase*KP+h*D;
  const unsigned lds0=(unsigned)(uintptr_t)shm;
  float*wsf=(float*)(shm+LDS_WS)+wid*64;
  float*tabR=(float*)(shm+LDS_TAB);
  { const int j_=tid, dist_=383-j_; float v_=-INFINITY; if(dist_>=0){ const int dd_=dist_<128?dist_:128; v_=relb[t5_bucket(dd_)*NHEADS+h]*1.4426950408889634f; } tabR[j_]=v_; }
  const float b31=relb[31*NHEADS+h]*1.4426950408889634f;
  const int qw0=q0+wid*QBLK;
  const bf16*ksrc=Kh+(long)lane*KP+wid*8;
  const bf16*vsrc=Vh+(long)(16*(wid&3)+(lane>>2))*KP+(wid>>2)*32+(lane&3)*8;
  const unsigned kdst=lds0+LDS_K+wid*1024, vdst=lds0+LDS_V+wid*1024;
  #define DMA_K(t,slot) glds16(ksrc+(long)(t)*KVBLK*KP,(unsigned)__builtin_amdgcn_readfirstlane(kdst+(slot)))
  #define DMA_V(t,slot) glds16(vsrc+(long)(t)*KVBLK*KP,(unsigned)__builtin_amdgcn_readfirstlane(vdst+(slot)))
  const int vb0=(int)(lds0+LDS_V)+((lane>>4)&1)*32+(lane&3)*8+(4*hi+((lane&15)>>2))*64;
  const char*Kbase=shm+LDS_K; bf16x8 kf[8];
  const lds_cptr shm3=(lds_cptr)shm; const lds_cptr kp0=shm3+LDS_K+hi*1024+r32*16; const lds_cptr vp0=shm3+LDS_V+((lane>>4)&1)*32+(lane&3)*8+(4*hi+((lane&15)>>2))*64;
  const int NT=(q0+QB)/KVBLK;
  DMA_K(0,0);DMA_V(0,0);DMA_K(1,SLOTB);
  bf16x8 qr[4];
  #pragma unroll
  for(int d0=0;d0<4;++d0)qr[d0]=*reinterpret_cast<const bf16x8*>(&Qw[(long)r32*QP+d0*16+hi*8]);
  unsigned sel=0u;
  if(qb>0){ float gt[7];
    _Pragma("unroll") for(int n=0;n<7;++n){ float a_=0.f; if(n<qb){ const float*km=kmean+n*768+8*hi;
        _Pragma("unroll") for(int d0=0;d0<4;++d0){ const f32x4_t k0=*(const f32x4_t*)(km+16*d0), k1=*(const f32x4_t*)(km+16*d0+4);
          _Pragma("unroll") for(int j=0;j<4;++j){ a_+=__uint_as_float(((unsigned)(unsigned short)qr[d0][j])<<16)*k0[j]; a_+=__uint_as_float(((unsigned)(unsigned short)qr[d0][j+4])<<16)*k1[j]; } }
        a_+=__shfl_xor(a_,32); } gt[n]=a_; }
    _Pragma("unroll") for(int n=0;n<7;++n) if(n<qb){ int rank=0;
      _Pragma("unroll") for(int m=0;m<7;++m) if(m!=n&&m<qb) rank+=(gt[m]>gt[n]||(gt[m]==gt[n]&&m<n))?1:0;
      if(rank<3) sel|=1u<<n; } }
  float mhat=0.f,l_reg=0.f;f32x16 o[2];o[0]=f32x16{};o[1]=f32x16{};f32x16 cin;
  const int qabs=qw0+r32; bool near_=false;
  #define TILE_SETUP(t) do{ const int k0_=64*(t); const bool above_=k0_>qw0+31, far_=(qw0-k0_-63)>=128; \
    const bool lsel_=((t)>=4*qb)||(((sel>>((t)>>2))&1u)!=0u); \
    const float c0_=(above_||!lsel_)?-INFINITY:((far_?b31:0.f)-mhat); \
    _Pragma("unroll") for(int r=0;r<16;++r)cin[r]=c0_; asm volatile("":"+v"(cin)); near_=!above_&&!far_; }while(0)
  #define NEARADD(P0,P1,t) do{ if(near_){ const float*tp_=tabR+(383-(qabs-64*(t)-4*hi)); \
    _Pragma("unroll") for(int r=0;r<16;++r){ P0[r]+=tp_[(r&3)+8*(r>>2)]; P1[r]+=tp_[(r&3)+8*(r>>2)+32]; } } }while(0)
  bool resc=false;
  #define START(P0,P1) do{ const float rm=rowmax(P0,P1); resc=false; \
    { const float dl=(rm==-INFINITY)?0.f:rm; mhat=fadd_s(mhat,dl);     \
      _Pragma("unroll") for(int r=0;r<16;++r){P0[r]=fsub_s(P0[r],dl);P1[r]=fsub_s(P1[r],dl);} } \
    _Pragma("unroll") for(int r=0;r<16;++r)P0[r]=__builtin_amdgcn_exp2f(P0[r]); }while(0)
  #define RESC() do{ if(resc){ asm volatile("s_waitcnt lgkmcnt(0)":::"memory"); \
      _Pragma("unroll") for(int d_=0;d_<2;++d_) _Pragma("unroll") for(int r=0;r<16;++r)o[d_][r]*=wsf[crow(r,hi)]; } }while(0)
  f32x16 pA0,pA1,pB0,pB1;
  int sl_prev=0,sl_cur=0,sl_next=SLOTB;
  #define ROT() do{sl_prev=sl_cur;sl_cur=sl_next;sl_next=(sl_next==(NSLOT-1)*SLOTB)?0:sl_next+SLOTB;}while(0)
  DMA_K(2,2*SLOTB);
  WAIT_BAR(3);
  TILE_SETUP(0); qkt(pA0,pA1,Kbase,qr,cin,r32,hi);asm volatile("s_nop 15\n\ts_nop 7":"+v"(pA0),"+v"(pA1));NEARADD(pA0,pA1,0);asm volatile("s_nop 1":"+v"(pA0),"+v"(pA1));
  START(pA0,pA1);
  _Pragma("unroll") for(int r=0;r<16;++r)pA1[r]=__builtin_amdgcn_exp2f(pA1[r]);
  WAIT_BAR(0);
  DMA_K(3,0);DMA_V(1,SLOTB);
  ROT();
  kload8(kf,kp0+sl_cur);
  WAIT_BAR(2);
  s16x4 vlo[8],vhi[8]; u32x4 pw0,pw1,pw2,pw3;
  #define PKW(P,B) cvtpk_s(P[B],P[B+1])
  #define PAF(k) __builtin_bit_cast(bf16x8,pw##k)
  #define VFR(i) (bf16x8){vlo[i][0],vlo[i][1],vlo[i][2],vlo[i][3],vhi[i][0],vhi[i][1],vhi[i][2],vhi[i][3]}
  #define PIN(x) asm volatile("":"+v"(x))
  #define MX3(a,b,c) __builtin_fmaxf(__builtin_fmaxf((a),(b)),(c))
  #define GAPA(MF,A0,A1,A2,A3,W0,W1,PW) do{ MF; sacc+=A0; sacc+=A1; sacc+=A2; sacc+=A3; PIN(sacc); W0; W1; PIN(PW); SBAR(); }while(0)
  #define EX(v) __builtin_amdgcn_exp2f(v)
  #define GAPB(MF,X,B) do{ MF; X[B]=EX(X[B]); X[B+1]=EX(X[B+1]); X[B+2]=EX(X[B+2]); X[B+3]=EX(X[B+3]); PIN(X); SBAR(); }while(0)
  #define VRD(i) do{ vlo[i]=vtr(vp_+(((i)>>2)*4096+((i)&3)*1024)); vhi[i]=vtr(vp_+(((i)>>2)*4096+((i)&3)*1024+512)); }while(0)
  #define KRD(G,j) do{ if(G){ kload2(kf,kp0+sl_next,j); SBAR(); } }while(0)
  #define STEP(C0,C1,P0,P1,t,GK,GV,GL) do{ TILE_SETUP(t); SBAR(); \
    const lds_cptr vp_=vp0+sl_prev; \
    VRD(0); SBAR(); float sacc=(P0[0]+P0[1]); \
    GAPA(C0=__builtin_amdgcn_mfma_f32_32x32x16_bf16(kf[0],qr[0],cin,0,0,0), P0[2],P0[3],P0[4],P0[5],     pw0[0]=PKW(P0,0), pw0[1]=PKW(P0,2), pw0); \
    VRD(4); SBAR(); GAPA(C1=__builtin_amdgcn_mfma_f32_32x32x16_bf16(kf[1],qr[0],cin,0,0,0), P0[6],P0[7],P0[8],P0[9],     pw0[2]=PKW(P0,4), pw0[3]=PKW(P0,6), pw0); \
    VRD(1); SBAR(); GAPA(C0=__builtin_amdgcn_mfma_f32_32x32x16_bf16(kf[2],qr[1],C0,0,0,0),   P0[10],P0[11],P0[12],P0[13], pw1[0]=PKW(P0,8), pw1[1]=PKW(P0,10), pw1); \
    VRD(5); SBAR(); GAPA(C1=__builtin_amdgcn_mfma_f32_32x32x16_bf16(kf[3],qr[1],C1,0,0,0),   P0[14],P0[15],P1[0],P1[1],   pw1[2]=PKW(P0,12),pw1[3]=PKW(P0,14), pw1); \
    VRD(2); SBAR(); GAPA(C0=__builtin_amdgcn_mfma_f32_32x32x16_bf16(kf[4],qr[2],C0,0,0,0),   P1[2],P1[3],P1[4],P1[5],     pw2[0]=PKW(P1,0), pw2[1]=PKW(P1,2), pw2); \
    VRD(6); SBAR(); GAPA(C1=__builtin_amdgcn_mfma_f32_32x32x16_bf16(kf[5],qr[2],C1,0,0,0),   P1[6],P1[7],P1[8],P1[9],     pw2[2]=PKW(P1,4), pw2[3]=PKW(P1,6), pw2); \
    VRD(3); SBAR(); GAPA(C0=__builtin_amdgcn_mfma_f32_32x32x16_bf16(kf[6],qr[3],C0,0,0,0),   P1[10],P1[11],P1[12],P1[13], pw3[0]=PKW(P1,8), pw3[1]=PKW(P1,10), pw3); \
    VRD(7); SBAR(); GAPA(C1=__builtin_amdgcn_mfma_f32_32x32x16_bf16(kf[7],qr[3],C1,0,0,0),   P1[14],P1[15],0.f,0.f,       pw3[2]=PKW(P1,12),pw3[3]=PKW(P1,14), pw3); \
    l_reg+=sacc; \
    if(GK){DMA_K((t)+3,sl_cur);} if(GV){DMA_V((t)+1,sl_next);} \
    NEARADD(C0,C1,t); \
    { float a=MX3(C0[0],C0[1],C1[0]),b=MX3(C0[2],C0[3],C1[1]); a=MX3(a,C1[2],C1[3]); \
      _Pragma("unroll") for(int r=4;r<16;r+=4){a=MX3(a,C0[r],C0[r+1]);b=MX3(b,C0[r+2],C0[r+3]);a=MX3(a,C1[r],C1[r+1]);b=MX3(b,C1[r+2],C1[r+3]);} \
      float rm=__builtin_fmaxf(a,b); { auto rr=__builtin_amdgcn_permlane32_swap(__float_as_uint(rm),__float_as_uint(rm),false,false); rm=__builtin_fmaxf(__uint_as_float(rr[0]),__uint_as_float(rr[1])); } \
      resc=false; \
      if(__builtin_expect(__any(rm>(float)THRL),0)){ const float dl=__builtin_fmaxf(rm,0.f); mhat+=dl; \
        _Pragma("unroll") for(int r=0;r<16;++r){C0[r]-=dl;C1[r]-=dl;} \
        const float f=__builtin_amdgcn_exp2f(-dl); l_reg*=f; if(hi==0)wsf[r32]=f; resc=true; } } \
    SBAR(); \
    GAPB(o[0]=__builtin_amdgcn_mfma_f32_32x32x16_bf16(PAF(0),VFR(0),o[0],0,0,0), C0,0); \
    GAPB(o[1]=__builtin_amdgcn_mfma_f32_32x32x16_bf16(PAF(0),VFR(4),o[1],0,0,0), C0,4); \
    KRD(GL,0); GAPB(o[0]=__builtin_amdgcn_mfma_f32_32x32x16_bf16(PAF(1),VFR(1),o[0],0,0,0), C0,8); \
    KRD(GL,1); GAPB(o[1]=__builtin_amdgcn_mfma_f32_32x32x16_bf16(PAF(1),VFR(5),o[1],0,0,0), C0,12); \
    KRD(GL,2); GAPB(o[0]=__builtin_amdgcn_mfma_f32_32x32x16_bf16(PAF(2),VFR(2),o[0],0,0,0), C1,0); \
    KRD(GL,3); GAPB(o[1]=__builtin_amdgcn_mfma_f32_32x32x16_bf16(PAF(2),VFR(6),o[1],0,0,0), C1,4); \
    GAPB(o[0]=__builtin_amdgcn_mfma_f32_32x32x16_bf16(PAF(3),VFR(3),o[0],0,0,0), C1,8); \
    GAPB(o[1]=__builtin_amdgcn_mfma_f32_32x32x16_bf16(PAF(3),VFR(7),o[1],0,0,0), C1,12); \
    }while(0)
  int t=1;
  for(;t+7<NT;t+=2){
    STEP(pB0,pB1,pA0,pA1,t,true,true,true);     WAIT_BAR(2); RESC(); ROT();
    STEP(pA0,pA1,pB0,pB1,t+1,true,true,true);   WAIT_BAR(2); RESC(); ROT();
  }
  #define ENDW(tt) do{ if((tt)+3<NT){WAIT_BAR(2);} else if((tt)+2<NT){WAIT_BAR(1);} else {WAIT_BAR(0);} }while(0)
  for(;t+1<NT;t+=2){
    STEP(pB0,pB1,pA0,pA1,t,(t+3<NT),(t+1<NT),(t+1<NT));       ENDW(t);   RESC(); ROT();
    STEP(pA0,pA1,pB0,pB1,t+1,(t+4<NT),(t+2<NT),(t+2<NT));     ENDW(t+1); RESC(); ROT();
  }
  STEP(pB0,pB1,pA0,pA1,NT-1,false,false,false); RESC();
  { float sacc=pB0[0]+pB0[1]; _Pragma("unroll") for(int r=2;r<16;++r)sacc+=pB0[r]; _Pragma("unroll") for(int r=0;r<16;++r)sacc+=pB1[r]; l_reg+=sacc;
    pw0=(u32x4){PKW(pB0,0),PKW(pB0,2),PKW(pB0,4),PKW(pB0,6)};pw1=(u32x4){PKW(pB0,8),PKW(pB0,10),PKW(pB0,12),PKW(pB0,14)};pw2=(u32x4){PKW(pB1,0),PKW(pB1,2),PKW(pB1,4),PKW(pB1,6)};pw3=(u32x4){PKW(pB1,8),PKW(pB1,10),PKW(pB1,12),PKW(pB1,14)};
    SBAR(); pv(o,vb0+sl_cur,PAF(0),PAF(1),PAF(2),PAF(3)); }
  #undef PKW
  #undef PAF
  #undef VFR
  #undef PIN
  #undef MX3
  #undef GAPA
  #undef GAPB
  #undef EX
  #undef VRD
  #undef KRD
  #undef STEP
  #undef ENDW
  {auto rr=__builtin_amdgcn_permlane32_swap(__float_as_uint(l_reg),__float_as_uint(l_reg),false,false);l_reg=__uint_as_float(rr[0])+__uint_as_float(rr[1]);}
  if(hi==0)wsf[32+r32]=l_reg;asm volatile("s_waitcnt lgkmcnt(0)":::"memory");
  float rli[16];
  #pragma unroll
  for(int r=0;r<16;++r)rli[r]=__builtin_amdgcn_rcpf(wsf[32+crow(r,hi)]);
  bf16*Ow=O+(rowbase+q0+wid*QBLK)*QP+QCOL+h*D;
  { bf16*stg=(bf16*)(shm+LDS_OST)+wid*2048;
    #pragma unroll
    for(int r=0;r<16;++r){const int orow=crow(r,hi);
      #pragma unroll
      for(int d0=0;d0<2;++d0)stg[orow*64+d0*32+r32]=__float2bfloat16(o[d0][r]*rli[r]);}
    asm volatile("s_waitcnt lgkmcnt(0)":::"memory");
    #pragma unroll
    for(int i=0;i<4;++i){const int row=i*8+(lane>>3),ch=lane&7; const u32x4 v=*(const u32x4*)(stg+row*64+ch*8); ATTN_STORE16(Ow+(long)row*QP+ch*8,v);} }
  asm volatile("s_waitcnt lgkmcnt(0)\n\ts_barrier":::"memory");
  #undef DMA_K
  #undef DMA_V
  #undef TILE_SETUP
  #undef NEARADD
  #undef START
  #undef RESC
  #undef ROT
}
constexpr int ATTN_LDS_BYTES=LDS_BYTES;
struct AttnTensors { const bf16* Q; const bf16* K; const bf16* V; bf16* O; const float* kmean; const float* relb; };
template<int THRL=8> __device__ __forceinline__ void attn_phase(char*lds,const AttnTensors&T,int vcu,int G){
  for(int p=vcu*3;p<768;p+=G*3){
    for(int i=0;i<3&&p+i<768;++i){ const int pr=p+i, bh=pr>>2, s=pr&3, b=bh/NHEADS, h=bh-b*NHEADS; const float*km=T.kmean+(long)b*8*768+h*64;
      attn_unit<THRL>(b,h,s,T.Q,T.K,T.V,T.O,km,T.relb,lds);
      attn_unit<THRL>(b,h,7-s,T.Q,T.K,T.V,T.O,km,T.relb,lds); } }
}
#undef SBAR
#undef WAIT_BAR
}
namespace mix2 {
typedef short bf16x8 __attribute__((ext_vector_type(8)));
typedef short s16x4 __attribute__((ext_vector_type(4)));
typedef float f32x16 __attribute__((ext_vector_type(16)));
typedef float f32x4v __attribute__((ext_vector_type(4)));
typedef unsigned u32x4 __attribute__((ext_vector_type(4)));
typedef unsigned u32x2 __attribute__((ext_vector_type(2)));
typedef __attribute__((address_space(3))) unsigned char* ldsp;
typedef __attribute__((address_space(3))) const unsigned char* ldscp;
__device__ __forceinline__ int crow(int r, int hi) { return (r & 3) + 8 * (r >> 2) + 4 * hi; }
__device__ __forceinline__ s16x4 vtr(ldscp p) { return __builtin_bit_cast(s16x4, __builtin_amdgcn_ds_read_tr16_b64_v4i16((__attribute__((address_space(3))) s16x4*)p)); }
__device__ __forceinline__ unsigned cvt2(float lo, float hi) { typedef float f2 __attribute__((ext_vector_type(2))); typedef __bf16 b2 __attribute__((ext_vector_type(2))); f2 v = {lo, hi}; b2 b = __builtin_convertvector(v, b2); return __builtin_bit_cast(unsigned, b); }
__device__ __forceinline__ float bflo(unsigned w) { return __uint_as_float(w << 16); }
__device__ __forceinline__ float bfhi(unsigned w) { return __uint_as_float(w & 0xffff0000u); }
#define MFMA32(a, b, c) __builtin_amdgcn_mfma_f32_32x32x16_bf16(a, b, c, 0, 0, 0)

constexpr int G_VN = 1024, G_W = 1024 + 32768;
__device__ __forceinline__ void gmlp_phase(ldsp lds, int wave, int vcu, int G, const bf16* gv, const float* gain, const float* bias, const float* wsp, const float* bsp, bf16* mix) {
    const int lane = (int)__builtin_amdgcn_mbcnt_hi(~0u, __builtin_amdgcn_mbcnt_lo(~0u, 0u)), tid = wave * 64 + lane, r32 = lane & 31, hi = lane >> 5;
    __attribute__((address_space(3))) float* stats = (__attribute__((address_space(3))) float*)lds;
    for (int chunk = vcu; chunk < T / CHUNK; chunk += G) {
        const int base = chunk * CHUNK;
        for (int rr = 0; rr < 16; ++rr) { const int row = wave * 16 + rr;
            const unsigned long long* gp = (const unsigned long long*)(gv + (size_t)(base + row) * 768) + lane;
            float v[12]; float s = 0.f;
#pragma unroll
            for (int j = 0; j < 3; ++j) { const unsigned long long w = gp[64 * j]; const unsigned lo = (unsigned)w, hw = (unsigned)(w >> 32);
                v[4 * j] = bflo(lo); v[4 * j + 1] = bfhi(lo); v[4 * j + 2] = bflo(hw); v[4 * j + 3] = bfhi(hw); s += (v[4 * j] + v[4 * j + 1]) + (v[4 * j + 2] + v[4 * j + 3]); }
            const float mu = wave_sum(s) * (1.f / 768.f); float q = 0.f;
#pragma unroll
            for (int j = 0; j < 12; ++j) { const float d = v[j] - mu; q += d * d; }
            const float rstd = rsqrtf(wave_sum(q) * (1.f / 768.f) + EPS);
            if (lane == 0) { stats[2 * row] = mu; stats[2 * row + 1] = rstd; } }
        __syncthreads();
        for (int g = 0; g < 6; ++g) {
#pragma unroll
            for (int k = 0; k < 4; ++k) { const int id = tid + 512 * k, s = id >> 4, c = id & 15, ch = g * 128 + c * 8;
                const u32x4 w = *(const u32x4*)(gv + (size_t)(base + s) * 768 + ch);
                const f32x4v g0 = *(const f32x4v*)(gain + ch), g1 = *(const f32x4v*)(gain + ch + 4), b0 = *(const f32x4v*)(bias + ch), b1 = *(const f32x4v*)(bias + ch + 4);
                const float mu = stats[2 * s], rs = stats[2 * s + 1];
                u32x4 o;
                o.x = cvt2((bflo(w.x) - mu) * rs * g0[0] + b0[0], (bfhi(w.x) - mu) * rs * g0[1] + b0[1]);
                o.y = cvt2((bflo(w.y) - mu) * rs * g0[2] + b0[2], (bfhi(w.y) - mu) * rs * g0[3] + b0[3]);
                o.z = cvt2((bflo(w.z) - mu) * rs * g1[0] + b1[0], (bfhi(w.z) - mu) * rs * g1[1] + b1[1]);
                o.w = cvt2((bflo(w.w) - mu) * rs * g1[2] + b1[2], (bfhi(w.w) - mu) * rs * g1[3] + b1[3]);
                *(__attribute__((address_space(3))) u32x4*)(lds + G_VN + (c >> 2) * 8192 + s * 64 + (c & 3) * 16) = o;
                const int t = s;
                const f32x4v w0 = *(const f32x4v*)(wsp + (size_t)g * 16384 + t * 128 + c * 8), w1 = *(const f32x4v*)(wsp + (size_t)g * 16384 + t * 128 + c * 8 + 4);
                float wv[8] = {w0[0], w0[1], w0[2], w0[3], w1[0], w1[1], w1[2], w1[3]};
#pragma unroll
                for (int j = 0; j < 8; ++j) if (c * 8 + j > t) wv[j] = 0.f;
                u32x4 ow; ow.x = cvt2(wv[0], wv[1]); ow.y = cvt2(wv[2], wv[3]); ow.z = cvt2(wv[4], wv[5]); ow.w = cvt2(wv[6], wv[7]);
                *(__attribute__((address_space(3))) u32x4*)(lds + G_W + t * 256 + ((c ^ (t & 15)) << 4)) = ow; }
            __syncthreads();
            const int tb = wave & 3, dh = wave >> 2;
            f32x16 acc0 = {}, acc1 = {};
            const int trow = 32 * tb + r32;
            ldscp vb = (ldscp)(lds + G_VN + (2 * dh) * 8192 + (8 * hi + ((lane & 15) >> 2)) * 64 + ((lane >> 4) & 1) * 32 + (lane & 3) * 8);
            for (int ks = 0; ks <= 2 * tb + 1; ++ks) {
                const bf16x8 a = *(__attribute__((address_space(3))) const bf16x8*)(lds + G_W + trow * 256 + (((2 * ks + hi) ^ (trow & 15)) << 4));
                const s16x4 l0 = vtr(vb + ks * 1024), h0 = vtr(vb + ks * 1024 + 256), l1 = vtr(vb + 8192 + ks * 1024), h1 = vtr(vb + 8192 + ks * 1024 + 256);
                const bf16x8 v0 = {l0[0], l0[1], l0[2], l0[3], h0[0], h0[1], h0[2], h0[3]}, v1 = {l1[0], l1[1], l1[2], l1[3], h1[0], h1[1], h1[2], h1[3]};
                acc0 = MFMA32(a, v0, acc0); acc1 = MFMA32(a, v1, acc1);
            }
#pragma unroll
            for (int r = 0; r < 16; ++r) { const int tl = 32 * tb + crow(r, hi); const float bs = bsp[g * CHUNK + tl];
                bf16* mp = mix + (size_t)(base + tl) * 2048 + g * 128 + dh * 64 + r32;
                mp[0] = (bf16)f2bf(bf2f(mp[0]) * (acc0[r] + bs)); mp[32] = (bf16)f2bf(bf2f(mp[32]) * (acc1[r] + bs)); }
            __syncthreads();
        }
    }
}

constexpr int M_V = 65536, M_WS = 131072, M_LDS = 131072 + 2048;
__device__ __forceinline__ void memattn_phase(ldsp lds, int wave, int vcu, int G, bf16* mix, const bf16* memkv) {
    const int lane = (int)__builtin_amdgcn_mbcnt_hi(~0u, __builtin_amdgcn_mbcnt_lo(~0u, 0u)), tid = wave * 64 + lane, r32 = lane & 31, hi = lane >> 5;
    __attribute__((address_space(3))) float* wsf = (__attribute__((address_space(3))) float*)(lds + M_WS) + wave * 64;
    for (int task = vcu; task < BATCH * MH * 4; task += G) {
        const int bh = task >> 2, jq = task & 3, b = bh >> 2, h = bh & 3;
#pragma unroll
        for (int k = 0; k < 8; ++k) { const int id = tid + 512 * k, row = id >> 4, c = id & 15;
            const bf16* src = memkv + (size_t)(b * MEMLEN + row) * 1024 + h * 128 + c * 8;
            const u32x4 kk = *(const u32x4*)src, vv = *(const u32x4*)(src + 512);
            *(__attribute__((address_space(3))) u32x4*)(lds + row * 256 + ((c ^ (row & 15)) << 4)) = kk;
            *(__attribute__((address_space(3))) u32x4*)(lds + M_V + (c >> 2) * 16384 + row * 64 + (c & 3) * 16) = vv; }
        __syncthreads();
        for (int qi = 0; qi < 2; ++qi) {
            const int t0 = b * SEQ + (2 * jq + qi) * 256 + wave * 32;
            bf16x8 qr[8];
#pragma unroll
            for (int d0 = 0; d0 < 8; ++d0) qr[d0] = *(const bf16x8*)(mix + (size_t)(t0 + r32) * 2048 + 1536 + h * 128 + d0 * 16 + hi * 8);
            f32x16 o[4]; o[0] = f32x16{}; o[1] = f32x16{}; o[2] = f32x16{}; o[3] = f32x16{};
            float mrow = -INFINITY, lsum = 0.f;
            ldscp vb = (ldscp)(lds + M_V + (4 * hi + ((lane & 15) >> 2)) * 64 + ((lane >> 4) & 1) * 32 + (lane & 3) * 8);
            for (int kc = 0; kc < 4; ++kc) {
                f32x16 p0 = {}, p1 = {};
                const int krow = kc * 64 + r32;
#pragma unroll
                for (int d0 = 0; d0 < 8; ++d0) { const int sw = ((2 * d0 + hi) ^ (r32 & 15)) << 4;
                    const bf16x8 k0 = *(__attribute__((address_space(3))) const bf16x8*)(lds + krow * 256 + sw), k1 = *(__attribute__((address_space(3))) const bf16x8*)(lds + (krow + 32) * 256 + sw);
                    p0 = MFMA32(k0, qr[d0], p0); p1 = MFMA32(k1, qr[d0], p1); }
                float mx = fmaxf(p0[0], p1[0]);
#pragma unroll
                for (int r = 1; r < 16; ++r) mx = fmaxf(mx, fmaxf(p0[r], p1[r]));
                mx = fmaxf(mx, __shfl_xor(mx, 32));
                const float mn = fmaxf(mrow, mx), alpha = __builtin_amdgcn_exp2f(mrow - mn); mrow = mn;
                float ps = 0.f;
#pragma unroll
                for (int r = 0; r < 16; ++r) { p0[r] = __builtin_amdgcn_exp2f(p0[r] - mn); p1[r] = __builtin_amdgcn_exp2f(p1[r] - mn); ps += p0[r] + p1[r]; }
                lsum = lsum * alpha + ps;
                if (hi == 0) wsf[r32] = alpha;
                u32x4 pw0, pw1, pw2, pw3;
                pw0 = (u32x4){cvt2(p0[0], p0[1]), cvt2(p0[2], p0[3]), cvt2(p0[4], p0[5]), cvt2(p0[6], p0[7])};
                pw1 = (u32x4){cvt2(p0[8], p0[9]), cvt2(p0[10], p0[11]), cvt2(p0[12], p0[13]), cvt2(p0[14], p0[15])};
                pw2 = (u32x4){cvt2(p1[0], p1[1]), cvt2(p1[2], p1[3]), cvt2(p1[4], p1[5]), cvt2(p1[6], p1[7])};
                pw3 = (u32x4){cvt2(p1[8], p1[9]), cvt2(p1[10], p1[11]), cvt2(p1[12], p1[13]), cvt2(p1[14], p1[15])};
                if (kc > 0) {
#pragma unroll
                    for (int r = 0; r < 16; ++r) { const float f = wsf[crow(r, hi)];
#pragma unroll
                        for (int dq = 0; dq < 4; ++dq) o[dq][r] *= f; } }
#pragma unroll
                for (int dq = 0; dq < 4; ++dq) {
#pragma unroll
                    for (int ks = 0; ks < 4; ++ks) { ldscp vp = vb + dq * 16384 + (kc * 64 + ks * 16) * 64;
                        const s16x4 l = vtr(vp), hh = vtr(vp + 512);
                        const bf16x8 vf = {l[0], l[1], l[2], l[3], hh[0], hh[1], hh[2], hh[3]};
                        const u32x4 pa = ks == 0 ? pw0 : (ks == 1 ? pw1 : (ks == 2 ? pw2 : pw3));
                        o[dq] = MFMA32(__builtin_bit_cast(bf16x8, pa), vf, o[dq]); } }
            }
            lsum += __shfl_xor(lsum, 32);
            if (hi == 0) wsf[32 + r32] = 1.0f / lsum;
#pragma unroll
            for (int r = 0; r < 16; ++r) { const float f = wsf[32 + crow(r, hi)];
                bf16* op = mix + (size_t)(t0 + crow(r, hi)) * 2048 + 1536 + h * 128 + r32;
#pragma unroll
                for (int dq = 0; dq < 4; ++dq) op[dq * 32] = (bf16)f2bf(o[dq][r] * f); }
        }
        __syncthreads();
    }
}
#undef MFMA32
}
typedef GAS unsigned gu32;
#define RLX_AGENT __ATOMIC_RELAXED, __HIP_MEMORY_SCOPE_AGENT
#define XB_TMO      128
#define XB_XCNT(j)  (256  + 64 * (j))
#define XB_XSUB(j)  (1280 + 64 * (j))
#define XB_XGEN(j)  (2304 + 64 * (j))
#define XB_TOP      3328
#define XB_TOPGEN   3392
#define XCD_BAR_WORDS 3456
#define XB_SPIN_CAP (1u << 18)

__device__ __forceinline__ unsigned xb_ld(unsigned* p)              { return __hip_atomic_load(p, __ATOMIC_RELAXED, __HIP_MEMORY_SCOPE_AGENT); }
__device__ __forceinline__ unsigned xb_add(unsigned* p, unsigned v) { return __hip_atomic_fetch_add(p, v, __ATOMIC_RELAXED, __HIP_MEMORY_SCOPE_AGENT); }
__device__ __forceinline__ unsigned xb_xcc_id() { return (unsigned)__builtin_amdgcn_s_getreg((3 << 11) | 20) & 0xFu; }
#define XB_SPIN(cond, bar) do { unsigned _sp = 0; while (cond) { __builtin_amdgcn_s_sleep(1); \
    if ((++_sp & 255u) == 0u) { if (xb_ld(&(bar)[XB_TMO])) break; if (_sp > XB_SPIN_CAP) { atomicAdd(&(bar)[XB_TMO], 1u); break; } } } } while (0)

struct XcdBarrier {
    unsigned* bar; unsigned x;
    volatile LAS unsigned* st;
};

__device__ __forceinline__ int xb_lane() { return (int)__builtin_amdgcn_mbcnt_hi(~0u, __builtin_amdgcn_mbcnt_lo(~0u, 0u)); }
__device__ __forceinline__ XcdBarrier xcd_barrier_post(unsigned* bar, volatile LAS unsigned* st, int wave_id) {
    XcdBarrier b; b.bar = bar; b.x = xb_xcc_id(); b.st = st;
    if (wave_id == 0 && xb_lane() == 0) (void)xb_add(&bar[XB_XCNT(b.x)], 1u);
    return b;
}
__device__ __forceinline__ void xcd_barrier_complete(unsigned* bar, unsigned x, unsigned& nloc, unsigned& nx) {
    const unsigned G = gridDim.x * gridDim.y * gridDim.z;
    unsigned sum, cnt, mine, sp = 0u;
    for (;;) {
        sum = 0u; cnt = 0u; mine = 0u;
#pragma unroll
        for (unsigned j = 0; j < 16; ++j) { const unsigned c = xb_ld(&bar[XB_XCNT(j)]); sum += c; cnt += (c > 0u) ? 1u : 0u; mine = (j == x) ? c : mine; }
        if (sum == G) break;
        __builtin_amdgcn_s_sleep(1);
        if ((++sp & 255u) == 0u) { if (xb_ld(&bar[XB_TMO])) break; if (sp > XB_SPIN_CAP) { atomicAdd(&bar[XB_TMO], 1u); break; } }
    }
    nloc = mine > 0u ? mine : 1u; nx = cnt > 0u ? cnt : 1u;
}

__device__ __forceinline__ void xcd_barrier(const XcdBarrier& b, int wave_id) {
    asm volatile("s_waitcnt vmcnt(0)" ::: "memory");
    __syncthreads();
    if (wave_id == 0 && xb_lane() == 0) {
        unsigned* bar = b.bar;
        __builtin_amdgcn_s_waitcnt(0);
        unsigned nloc = b.st[0], nx = b.st[1];
        if (nloc == 0u) { xcd_barrier_complete(bar, b.x, nloc, nx); b.st[0] = nloc; b.st[1] = nx; }
        const unsigned old = xb_add(&bar[XB_XSUB(b.x)], 1u);
        const unsigned gen = old / nloc;
        if (old + 1u == (gen + 1u) * nloc) {
            __builtin_amdgcn_fence(__ATOMIC_RELEASE, "agent");
            asm volatile("s_waitcnt vmcnt(0)" ::: "memory");
            const unsigned og = xb_add(&bar[XB_TOP], 1u);
            const unsigned tg = og / nx;
            if (og + 1u == (tg + 1u) * nx) xb_add(&bar[XB_TOPGEN], 1u);
            else XB_SPIN(xb_ld(&bar[XB_TOPGEN]) == tg, bar);
            __builtin_amdgcn_fence(__ATOMIC_ACQUIRE, "agent");
            xb_add(&bar[XB_XGEN(b.x)], 1u);
            asm volatile("s_waitcnt vmcnt(0)" ::: "memory");
        } else {
            XB_SPIN(xb_ld(&bar[XB_XGEN(b.x)]) == gen, bar);
            __builtin_amdgcn_fence(__ATOMIC_ACQUIRE, "agent");
            asm volatile("s_waitcnt vmcnt(0)" ::: "memory");
        }
    }
    __syncthreads();
}
#ifndef DBG_NAIVE_GMLP
#define DBG_NAIVE_GMLP 0
#endif
#ifndef DBG_NAIVE_MEMATTN
#define DBG_NAIVE_MEMATTN 0
#endif
#ifndef DBG_NAIVE_MOBA
#define DBG_NAIVE_MOBA 0
#endif
#ifndef DBG_P1
#define DBG_P1 3
#endif
constexpr int NWAVES = 8;
constexpr int RING_BYTES = 131072;
constexpr int LDS_BYTES = 147456;

struct Args { const float* in[21]; float* out; unsigned char* ws; int ph_lo, ph_hi; };

__device__ __forceinline__ int opq(int v) { asm volatile("" : "+v"(v)); return v; }
__device__ __forceinline__ int lane_id() { return (int)__builtin_amdgcn_mbcnt_hi(~0u, __builtin_amdgcn_mbcnt_lo(~0u, 0u)); }
struct Frame {
    LAS unsigned char* lds;
    int wave, vcu, G;
};

__device__ __forceinline__ void p0_transpose_item(const float* W, int K, int N, bf16* WT, int ldt, int col_off, int mode, LAS float* scr, int item, int lane) {
    const int nblk = N / 32, kb = item / nblk, nb = item % nblk, k0 = 64 * kb, n0 = 32 * nb;
#pragma unroll 8
    for (int i = 0; i < 32; ++i) { const int kk = 2 * i + (lane >> 5); scr[kk * 33 + (lane & 31)] = W[(size_t)(k0 + kk) * N + n0 + (lane & 31)]; }
    asm volatile("s_waitcnt lgkmcnt(0)" ::: "memory");
    const int c = lane & 7;
    const int rbase = mode ? ((n0 / 128) * 256 + (n0 % 128) + (mode == 2 ? 128 : 0)) : n0;
#pragma unroll
    for (int j = 0; j < 4; ++j) { const int n = (lane >> 3) + 8 * j; const LAS float* s = scr + (8 * c) * 33 + n;
        v4u o; o.x = pk2(s[0 * 33], s[1 * 33]); o.y = pk2(s[2 * 33], s[3 * 33]); o.z = pk2(s[4 * 33], s[5 * 33]); o.w = pk2(s[6 * 33], s[7 * 33]);
        *(v4u*)(WT + (size_t)(rbase + n) * ldt + col_off + k0 + 8 * c) = o; }
    asm volatile("s_waitcnt lgkmcnt(0)" ::: "memory");
}
__device__ __forceinline__ void rms_row_bf16(const float* xrow, const float* g, bf16* orow, int lane_) {
    const int lane = opq(lane_);
    const f32x4* xr = (const f32x4*)xrow + lane;
    f32x4 v[4]; float s = 0.f;
#pragma unroll
    for (int j = 0; j < 4; ++j) { v[j] = xr[64 * j]; s += (v[j].x * v[j].x + v[j].y * v[j].y) + (v[j].z * v[j].z + v[j].w * v[j].w); }
    const float r = rsqrtf(wave_sum(s) * (1.f / DM) + EPS);
    unsigned long long* o8 = (unsigned long long*)orow + lane;
#pragma unroll
    for (int j = 0; j < 4; ++j) { const f32x4 gg = ((const f32x4*)g)[lane + 64 * j];
        o8[64 * j] = (unsigned long long)pk2(v[j].x * r * gg.x, v[j].y * r * gg.y) | ((unsigned long long)pk2(v[j].z * r * gg.z, v[j].w * r * gg.w) << 32); }
}
__device__ __forceinline__ void post_norm_row(const float* xin, const float* y, const float* g1, float* x1out, const float* g2, bf16* h2, int lane_) {
    const int lane = opq(lane_);
    const f32x4* yr = (const f32x4*)y + lane; const f32x4* xr = (const f32x4*)xin + lane;
    f32x4 v[4]; float s = 0.f;
#pragma unroll
    for (int j = 0; j < 4; ++j) { v[j] = yr[64 * j]; s += (v[j].x * v[j].x + v[j].y * v[j].y) + (v[j].z * v[j].z + v[j].w * v[j].w); }
    const float r = rsqrtf(wave_sum(s) * (1.f / DM) + EPS);
    float s2 = 0.f;
#pragma unroll
    for (int j = 0; j < 4; ++j) { const f32x4 gg = ((const f32x4*)g1)[lane + 64 * j]; const f32x4 xx = xr[64 * j];
        v[j] = xx + v[j] * r * gg; ((f32x4*)x1out)[lane + 64 * j] = v[j];
        s2 += (v[j].x * v[j].x + v[j].y * v[j].y) + (v[j].z * v[j].z + v[j].w * v[j].w); }
    if (h2) {
        const float r2 = rsqrtf(wave_sum(s2) * (1.f / DM) + EPS);
        unsigned long long* o8 = (unsigned long long*)h2 + lane;
#pragma unroll
        for (int j = 0; j < 4; ++j) { const f32x4 gg = ((const f32x4*)g2)[lane + 64 * j];
            o8[64 * j] = (unsigned long long)pk2(v[j].x * r2 * gg.x, v[j].y * r2 * gg.y) | ((unsigned long long)pk2(v[j].z * r2 * gg.z, v[j].w * r2 * gg.w) << 32); }
    }
}

__device__ __forceinline__ void gmlp_body(Frame& F, const bf16* gv, const float* gain, const float* bias, const float* wsp, const float* bsp, bf16* mix) {
    LAS float* stats = (LAS float*)F.lds;
    LAS float* vn = (LAS float*)(F.lds + 1024);
    LAS float* wl = (LAS float*)(F.lds + 1024 + 65536);
    const int lane = opq(lane_id()), tid = F.wave * 64 + lane;
    for (int chunk = F.vcu; chunk < T / CHUNK; chunk += F.G) {
        const int base = chunk * CHUNK;
        for (int r = F.wave; r < CHUNK; r += NWAVES) {
            float v[12]; float s = 0.f;
#pragma unroll
            for (int j = 0; j < 12; ++j) { v[j] = bf2f(gv[(size_t)(base + r) * 768 + lane + 64 * j]); s += v[j]; }
            const float mu = wave_sum(s) * (1.f / 768.f); float q = 0.f;
#pragma unroll
            for (int j = 0; j < 12; ++j) { const float d = v[j] - mu; q += d * d; }
            const float rstd = rsqrtf(wave_sum(q) * (1.f / 768.f) + EPS);
            if (lane == 0) { stats[2 * r] = mu; stats[2 * r + 1] = rstd; }
        }
        __syncthreads();
        for (int g = 0; g < 6; ++g) {
            for (int i = tid; i < CHUNK * 128; i += NWAVES * 64) { const int s = i >> 7, d = i & 127, ch = g * 128 + d;
                vn[i] = (bf2f(gv[(size_t)(base + s) * 768 + ch]) - stats[2 * s]) * stats[2 * s + 1] * gain[ch] + bias[ch];
                wl[i] = wsp[(size_t)g * CHUNK * CHUNK + i]; }
            __syncthreads();
            const int d = tid & 127, tq = tid >> 7;
            for (int i = 0; i < 32; ++i) { const int tl = tq + 4 * i; float a = 0.f;
                for (int s = 0; s <= tl; ++s) a += wl[tl * 128 + s] * vn[s * 128 + d];
                a += bsp[g * CHUNK + tl];
                const size_t o = (size_t)(base + tl) * 2048 + g * 128 + d;
                mix[o] = (bf16)f2bf(bf2f(mix[o]) * a); }
            __syncthreads();
        }
    }
}
__device__ __forceinline__ void moba_body(Frame& F, bf16* mix, const bf16* kb, const bf16* vb, const float* kmean, const float* relb) {
    LAS float* lg = (LAS float*)F.lds + F.wave * 1024;
    const int lane = opq(lane_id());
    for (int w = F.vcu * NWAVES + F.wave; w < BATCH * NH * SEQ; w += F.G * NWAVES) {
        const int s = w % SEQ, bh = w / SEQ, h = bh % NH, b = bh / NH;
        const int t = b * SEQ + s, cur = s / MBLK;
        float q[64];
#pragma unroll
        for (int d = 0; d < 64; ++d) q[d] = bf2f(mix[(size_t)t * 2048 + 768 + h * 64 + d]);
        float gt[8];
#pragma unroll
        for (int n = 0; n < 8; ++n) { float a = 0.f;
            if (n < cur) { const float* km = kmean + (size_t)(b * NBLK + n) * 768 + h * 64;
#pragma unroll
                for (int d = 0; d < 64; ++d) a += q[d] * km[d]; }
            gt[n] = a; }
        unsigned sel = 0;
#pragma unroll
        for (int n = 0; n < 8; ++n) if (n < cur) { int rank = 0;
#pragma unroll
            for (int m = 0; m < 8; ++m) if (m < cur && m != n) rank += (gt[m] > gt[n] || (gt[m] == gt[n] && m < n)) ? 1 : 0;
            if (rank < 3) sel |= 1u << n; }
        int nslot = 0; float mx = -INFINITY;
        for (int n = 0; n <= cur; ++n) {
            if (n < cur && !((sel >> n) & 1u)) continue;
#pragma unroll
            for (int i = 0; i < 4; ++i) { const int j = lane + 64 * i, kp = n * MBLK + j, dist = s - kp; float l = -INFINITY;
                if (dist >= 0) { const bf16* kr = kb + (size_t)(b * SEQ + kp) * 768 + h * 64; float a = 0.f;
#pragma unroll
                    for (int d = 0; d < 64; ++d) a += q[d] * bf2f(kr[d]);
                    l = a + relb[t5_bucket(dist) * NH + h] * LOG2E; }
                lg[nslot * 256 + j] = l; mx = fmaxf(mx, l); }
            ++nslot;
        }
        mx = wave_max(mx);
        float sum = 0.f; const int nk = nslot * 256;
        for (int j = lane; j < nk; j += 64) { const float p = exp2f(lg[j] - mx); lg[j] = p; sum += p; }
        sum = wave_sum(sum);
        asm volatile("s_waitcnt lgkmcnt(0)" ::: "memory");
        float o = 0.f; int slot = 0;
        for (int n = 0; n <= cur; ++n) {
            if (n < cur && !((sel >> n) & 1u)) continue;
            const int jmax = (n == cur) ? (s - cur * MBLK + 1) : MBLK;
            for (int j = 0; j < jmax; ++j) o += lg[slot * 256 + j] * bf2f(vb[(size_t)(b * SEQ + n * MBLK + j) * 768 + h * 64 + lane]);
            ++slot;
        }
        mix[(size_t)t * 2048 + 768 + h * 64 + lane] = (bf16)f2bf(o / sum);
        asm volatile("s_waitcnt lgkmcnt(0)" ::: "memory");
    }
}
__device__ __forceinline__ void memattn_body(Frame& F, bf16* mix, const bf16* memkv) {
    LAS float* lg = (LAS float*)(F.lds + 32768) + F.wave * 256;
    const int lane = opq(lane_id());
    for (int w = F.vcu * NWAVES + F.wave; w < BATCH * MH * SEQ; w += F.G * NWAVES) {
        const int s = w % SEQ, bh = w / SEQ, h = bh % MH, b = bh / MH;
        const int t = b * SEQ + s;
        float mx = -INFINITY;
#pragma unroll
        for (int i = 0; i < 4; ++i) { const int m = lane + 64 * i;
            const bf16* kr = memkv + (size_t)(b * MEMLEN + m) * 1024 + h * 128; float a = 0.f;
            for (int d = 0; d < 128; ++d) a += bf2f(mix[(size_t)t * 2048 + 1536 + h * 128 + d]) * bf2f(kr[d]);
            lg[m] = a; mx = fmaxf(mx, a); }
        mx = wave_max(mx);
        float sum = 0.f;
#pragma unroll
        for (int i = 0; i < 4; ++i) { const int m = lane + 64 * i; const float p = exp2f(lg[m] - mx); lg[m] = p; sum += p; }
        sum = wave_sum(sum);
        asm volatile("s_waitcnt lgkmcnt(0)" ::: "memory");
        float o0 = 0.f, o1 = 0.f;
        for (int m = 0; m < MEMLEN; ++m) { const bf16* vr = memkv + (size_t)(b * MEMLEN + m) * 1024 + 512 + h * 128;
            const float p = lg[m]; o0 += p * bf2f(vr[lane]); o1 += p * bf2f(vr[lane + 64]); }
        mix[(size_t)t * 2048 + 1536 + h * 128 + lane] = (bf16)f2bf(o0 / sum);
        mix[(size_t)t * 2048 + 1536 + h * 128 + lane + 64] = (bf16)f2bf(o1 / sum);
        asm volatile("s_waitcnt lgkmcnt(0)" ::: "memory");
    }
}

__global__ void __launch_bounds__(NWAVES * 64, 2) mega_fwd(Args args) {
    extern __shared__ __attribute__((aligned(16))) unsigned char lds_raw[];
    cg::grid_group grid = cg::this_grid();
    Frame F;
    F.lds = (LAS unsigned char*)lds_raw;
    F.wave = __builtin_amdgcn_readfirstlane((int)threadIdx.x >> 6);
    F.G = gridDim.x; { const int bx = blockIdx.x; F.vcu = (F.G % 8 == 0) ? (bx % 8) * (F.G / 8) + bx / 8 : bx; }
    unsigned char* ws = args.ws; unsigned char* dob = (unsigned char*)args.out;
    const float* x = args.in[0]; const float* mem = args.in[1];
    const float *ln_mix_pre = args.in[2], *ln_mix_post = args.in[3], *ln_ffn_pre = args.in[4], *ln_ffn_post = args.in[5], *ln_mem = args.in[6];
    bf16* H = (bf16*)(dob + DO_H); bf16* MERGED = H; bf16* MEMN = (bf16*)(dob + DO_MEMN);
    bf16 *WCAT = (bf16*)(dob + DO_WCAT), *WOUT = (bf16*)(dob + DO_WOUT), *WGU = (bf16*)(dob + DO_WGU), *WD = (bf16*)(dob + DO_WD);
    bf16 *WIN = (bf16*)(ws + WS_WIN), *WKV = (bf16*)(ws + WS_WKV), *MEMKV = (bf16*)(ws + WS_MEMKV), *MIX = (bf16*)(ws + WS_MIX);
    bf16 *GV = (bf16*)(ws + WS_GV), *KB = (bf16*)(ws + WS_KB), *VB = (bf16*)(ws + WS_VB), *GATES = (bf16*)(ws + WS_GATES);
    float* KMEAN = (float*)(ws + WS_KMEAN);
    float *Y = (float*)(ws + WS_Y), *FF = (float*)(ws + WS_F), *X1 = (float*)(ws + WS_X1); bf16 *HID = (bf16*)(ws + WS_HID), *H2 = (bf16*)(ws + WS_H2);
    const int gw = F.vcu * NWAVES + F.wave, NGW = F.G * NWAVES;
    volatile LAS unsigned* MISC = (volatile LAS unsigned*)(F.lds + (LDS_BYTES - 64));
    if (F.wave == 0 && lane_id() == 0) { MISC[0] = 0u; MISC[1] = 0u; }
    __syncthreads();
    unsigned* barw = (unsigned*)(ws + WS_CTL) + 4096;
    XcdBarrier bar; bar.bar = barw; bar.x = 0; bar.st = MISC;

#define IN(k) (args.ph_lo <= (k) && (k) < args.ph_hi)
#define SEAM(k) do { if (IN(k) && IN((k) + 1)) { if ((k) == 0) { grid.sync(); bar = xcd_barrier_post(barw, MISC, F.wave); } else xcd_barrier(bar, F.wave); } } while (0)
    if (IN(0)) {
        LAS float* scr = (LAS float*)(F.lds + F.wave * 16384);
        const int lane0 = opq(lane_id());
        constexpr int I_IN = 16 * (INW / 32), I_KV = 16 * 32, I_A = 12 * 32, I_C = 8 * 32, I_O = 16 * 32, I_G = 16 * (DFF / 32), I_D = (DFF / 64) * 32;
        constexpr int NITEMS = I_IN + I_KV + 2 * I_A + I_C + I_O + 2 * I_G + I_D;
        for (int it = gw; it < NITEMS; it += NGW) {
            int r = it;
            if (r < I_IN) { p0_transpose_item(args.in[7], 1024, INW, WIN, 1024, 0, 0, scr, r, lane0); continue; } r -= I_IN;
            if (r < I_KV) { p0_transpose_item(args.in[13], 1024, 1024, WKV, 1024, 0, 0, scr, r, lane0); continue; } r -= I_KV;
            if (r < I_A) { p0_transpose_item(args.in[14], 768, 1024, WCAT, 2048, 0, 0, scr, r, lane0); continue; } r -= I_A;
            if (r < I_A) { p0_transpose_item(args.in[15], 768, 1024, WCAT, 2048, 768, 0, scr, r, lane0); continue; } r -= I_A;
            if (r < I_C) { p0_transpose_item(args.in[16], 512, 1024, WCAT, 2048, 1536, 0, scr, r, lane0); continue; } r -= I_C;
            if (r < I_O) { p0_transpose_item(args.in[17], 1024, 1024, WOUT, 1024, 0, 0, scr, r, lane0); continue; } r -= I_O;
            if (r < I_G) { p0_transpose_item(args.in[18], 1024, DFF, WGU, 1024, 0, 1, scr, r, lane0); continue; } r -= I_G;
            if (r < I_G) { p0_transpose_item(args.in[19], 1024, DFF, WGU, 1024, 0, 2, scr, r, lane0); continue; } r -= I_G;
            p0_transpose_item(args.in[20], DFF, 1024, WD, DFF, 0, 0, scr, r, lane0);
        }
        for (int m = gw; m < T; m += NGW) rms_row_bf16(x + (size_t)m * DM, ln_mix_pre, H + (size_t)m * DM, lane0);
        for (int m = gw; m < TM; m += NGW) rms_row_bf16(mem + (size_t)m * DM, ln_mem, MEMN + (size_t)m * DM, lane0);
        if (blockIdx.x == 0) for (int i = F.wave * 64 + lane0; i < XCD_BAR_WORDS; i += NWAVES * 64) barw[i] = 0u;
        for (int i = blockIdx.x * (NWAVES * 64) + F.wave * 64 + lane0; i < BATCH * NBLK * 768; i += F.G * NWAVES * 64) KMEAN[i] = 0.f;
    }
    SEAM(0);
    if (IN(1)) {
        pg8::Gemm g{H, WIN, T, INW, 1024}; pg8::StaticOrder S; S.init(T, INW, F.G, (int)blockIdx.x);
        pg8::EpiProj E{MIX, GV, KB, VB, GATES, KMEAN};
        if (DBG_P1 & 1) pg8::gemm_phase<pg8::EpiProj, pg8::StaticOrder, true, true>(F.lds, g, S, E, F.wave);
        pg8::Gemm g2{MEMN, WKV, TM, 1024, 1024}; pg8::StaticOrder S2; S2.init(TM, 1024, F.G, (int)blockIdx.x);
        pg8::EpiBf16Plain E2{MEMKV, 1024};
        if (DBG_P1 & 2) pg8::gemm_phase<pg8::EpiBf16Plain, pg8::StaticOrder, true, true>(F.lds, g2, S2, E2, F.wave);
    }
    SEAM(1);
    if (IN(2)) {
#if DBG_NAIVE_GMLP
    gmlp_body(F, GV, args.in[8], args.in[9], args.in[10], args.in[11], MIX);
#else
    mix2::gmlp_phase(F.lds, F.wave, F.vcu, F.G, GV, args.in[8], args.in[9], args.in[10], args.in[11], MIX);
#endif
#if DBG_NAIVE_MOBA
    moba_body(F, MIX, KB, VB, KMEAN, args.in[12]);
#else
    { __syncthreads();
      const mattn::AttnTensors AT{(const mattn::bf16*)MIX, (const mattn::bf16*)KB, (const mattn::bf16*)VB, (mattn::bf16*)MIX, KMEAN, args.in[12]};
      mattn::attn_phase<8>((char*)lds_raw, AT, F.vcu, F.G);
      __syncthreads(); }
#endif
#if DBG_NAIVE_MEMATTN
    memattn_body(F, MIX, MEMKV);
#else
    mix2::memattn_phase(F.lds, F.wave, F.vcu, F.G, MIX, MEMKV);
#endif
    }
    SEAM(2);
    if (IN(3)) {
        pg8::Gemm g{MIX, WCAT, T, 1024, 2048}; pg8::StaticOrder S; S.init(T, 1024, F.G, (int)blockIdx.x);
        pg8::EpiMerge E{GATES, MERGED};
        pg8::gemm_phase<pg8::EpiMerge, pg8::StaticOrder, true, true, true>(F.lds, g, S, E, F.wave);
    }
    SEAM(3);
    if (IN(4)) {
        pg8::Gemm g{MERGED, WOUT, T, 1024, 1024}; pg8::StaticOrder S; S.init(T, 1024, F.G, (int)blockIdx.x);
        pg8::EpiF32 E{Y, 1024};
        pg8::gemm_phase<pg8::EpiF32, pg8::StaticOrder, true, true>(F.lds, g, S, E, F.wave);
    }
    SEAM(4);
    if (IN(5)) for (int m = gw; m < T; m += NGW) post_norm_row(x + (size_t)m * DM, Y + (size_t)m * DM, ln_mix_post, X1 + (size_t)m * DM, ln_ffn_pre, H2 + (size_t)m * DM, lane_id());
    SEAM(5);
    if (IN(6)) {
        pg8::Gemm g{H2, WGU, T, 2 * DFF, 1024}; pg8::StaticOrder S; S.init(T, 2 * DFF, F.G, (int)blockIdx.x);
        pg8::EpiSwiGLU E{HID, DFF};
        pg8::gemm_phase<pg8::EpiSwiGLU, pg8::StaticOrder, true, true>(F.lds, g, S, E, F.wave);
    }
    SEAM(6);
    if (IN(7)) {
        pg8::Gemm g{HID, WD, T, 1024, DFF}; pg8::StaticOrder S; S.init(T, 1024, F.G, (int)blockIdx.x);
        pg8::EpiF32 E{FF, 1024};
        pg8::gemm_phase<pg8::EpiF32, pg8::StaticOrder, true, true>(F.lds, g, S, E, F.wave);
    }
    SEAM(7);
    if (IN(8)) for (int m = gw; m < T; m += NGW) post_norm_row(X1 + (size_t)m * DM, FF + (size_t)m * DM, ln_ffn_post, args.out + (size_t)m * DM, nullptr, nullptr, lane_id());
}

extern "C" void kernel_launch(void* const* d_in, const int* in_sizes, int n_in, void* d_out, int out_size, void* d_ws, size_t ws_size, hipStream_t stream) {
    static int grid = 0;
    if (grid == 0) {
        if (n_in != 21 || out_size != T * DM || ws_size < WS_NEED) { fprintf(stderr, "kernel_launch: unexpected shapes (n_in %d out %d ws %zu)\n", n_in, out_size, ws_size); grid = -1; return; }
        int dev = 0, cus = 0, per_cu = 0;
        if (hipGetDevice(&dev) != hipSuccess || hipDeviceGetAttribute(&cus, hipDeviceAttributeMultiprocessorCount, dev) != hipSuccess) { grid = -1; return; }
        if (hipFuncSetAttribute((const void*)mega_fwd, hipFuncAttributeMaxDynamicSharedMemorySize, LDS_BYTES) != hipSuccess) { fprintf(stderr, "kernel_launch: hipFuncSetAttribute failed\n"); grid = -1; return; }
        if (hipOccupancyMaxActiveBlocksPerMultiprocessor(&per_cu, (const void*)mega_fwd, NWAVES * 64, LDS_BYTES) != hipSuccess || per_cu < 1) { fprintf(stderr, "kernel_launch: occupancy query says %d\n", per_cu); per_cu = 1; }
        (void)hipGetLastError();
        grid = cus;
    }
    if (grid < 0) return;
    Args a{};
    for (int i = 0; i < 21; ++i) a.in[i] = (const float*)d_in[i];
    a.out = (float*)d_out; a.ws = (unsigned char*)d_ws;
#ifndef MK_PER_PHASE
#define MK_PER_PHASE 0
#endif
    if (MK_PER_PHASE) {
        for (int p = 0; p < 9; ++p) { a.ph_lo = p; a.ph_hi = p + 1; hipLaunchKernelGGL(mega_fwd, dim3(grid), dim3(NWAVES * 64), LDS_BYTES, stream, a); }
    } else {
        a.ph_lo = 0; a.ph_hi = 9;
        void* kargs[] = {&a};
        hipError_t e = hipLaunchCooperativeKernel((const void*)mega_fwd, dim3(grid), dim3(NWAVES * 64), kargs, LDS_BYTES, stream);
        if (e != hipSuccess) fprintf(stderr, "kernel_launch: cooperative launch failed: %s (grid %d)\n", hipGetErrorString(e), grid);
    }
}
```

```cpp
#include <hip/hip_runtime.h>
#include <hip/hip_cooperative_groups.h>
#include <cstdio>
#include <cstdint>
namespace cg = cooperative_groups;

typedef unsigned short bf16;
typedef unsigned v4u __attribute__((ext_vector_type(4)));
typedef float f32x4 __attribute__((ext_vector_type(4)));
#define LAS __attribute__((address_space(3)))
#define GAS __attribute__((address_space(1)))

constexpr int BATCH = 16, SEQ = 2048, DM = 1024, T = BATCH * SEQ;
constexpr int MEMLEN = 256, TM = BATCH * MEMLEN;
constexpr int CHUNK = 128;
constexpr int NH = 12, MBLK = 256, NBLK = SEQ / MBLK;
constexpr int MH = 4;
constexpr int DFF = 2816, INW = 7424;
constexpr float EPS = 1e-6f;
constexpr float LOG2E = 1.4426950408889634f;
constexpr float C2Q = 0.125f * LOG2E;
constexpr float C2M = 0.08838834764831845f * LOG2E;

constexpr size_t MiB = 1u << 20;
constexpr size_t DO_H = 0;
constexpr size_t DO_MEMN = 64 * MiB;
constexpr size_t DO_WCAT = 72 * MiB;
constexpr size_t DO_WOUT = 76 * MiB;
constexpr size_t DO_WGU = 78 * MiB;
constexpr size_t DO_WD = 89 * MiB;
constexpr size_t WS_CTL = 0;
constexpr size_t WS_KMEAN = 256 * 1024;
constexpr size_t WS_WIN = 1 * MiB;
constexpr size_t WS_WKV = 16 * MiB;
constexpr size_t WS_MEMKV = 18 * MiB;
constexpr size_t WS_MIX = 26 * MiB;
constexpr size_t WS_GV = 154 * MiB;
constexpr size_t WS_KB = 202 * MiB;
constexpr size_t WS_VB = 250 * MiB;
constexpr size_t WS_GATES = 298 * MiB;
constexpr size_t WS_Y = 26 * MiB;
constexpr size_t WS_HID = 26 * MiB;
constexpr size_t WS_F = 202 * MiB;
constexpr size_t WS_H2 = 320 * MiB;
constexpr size_t WS_X1 = 384 * MiB;
constexpr size_t WS_NEED = 512 * MiB;

__device__ __forceinline__ float bf2f(bf16 v) { return __uint_as_float((unsigned)v << 16); }
__device__ __forceinline__ unsigned f2bf(float f) { unsigned u = __float_as_uint(f); return (u + 0x7fffu + ((u >> 16) & 1u)) >> 16; }
__device__ __forceinline__ unsigned pk2(float lo, float hi) { return f2bf(lo) | (f2bf(hi) << 16); }
__device__ __forceinline__ float wave_sum(float v) {
#pragma unroll
    for (int o = 1; o < 64; o <<= 1) v += __shfl_xor(v, o);
    return v;
}
__device__ __forceinline__ float wave_max(float v) {
#pragma unroll
    for (int o = 1; o < 64; o <<= 1) v = fmaxf(v, __shfl_xor(v, o));
    return v;
}
__device__ __forceinline__ float fast_sigmoid(float x) { return __builtin_amdgcn_rcpf(1.0f + __builtin_amdgcn_exp2f(-LOG2E * x)); }
__device__ __forceinline__ float gelu_tanh(float x) {
    const float u = 0.7978845608028654f * (x + 0.044715f * x * x * x);
    return x * __builtin_amdgcn_rcpf(1.0f + __builtin_amdgcn_exp2f(-2.0f * LOG2E * u));
}
__device__ __forceinline__ int t5_bucket(int n) {
    if (n < 16) return n;
    int large = 16 + (int)(logf((float)n / 16.0f) / 2.0794415416798357f * 16.0f);
    return large < 31 ? large : 31;
}
namespace pg8 {
#define PG8_LAS __attribute__((address_space(3)))
typedef unsigned short bf16_t;
typedef short bf16x8 __attribute__((ext_vector_type(8)));
typedef float f32x4 __attribute__((ext_vector_type(4)));
typedef unsigned u32x4 __attribute__((ext_vector_type(4)));
constexpr int BM = 256, BK = 64, HALF = 128, HTB = HALF * BK * 2  , STAGE_BYTES = 8 * HTB, NXCD = 8, WGM = 8;

__host__ __device__ __forceinline__ int lds_byte(int r, int c) { const int st = (r >> 4) * 2 + (c >> 5), rr = r & 15, cc = c & 31, ob = rr * 64 + cc * 2; return st * 1024 + (ob ^ (((ob >> 9) & 1) << 5)); }
__host__ __device__ __forceinline__ void stage_rc(int b, int& R, int& C) { const int st = b / 1024, sb = b % 1024, swz = sb ^ (((sb >> 9) & 1) << 5); R = (st >> 1) * 16 + swz / 64; C = (st & 1) * 32 + (swz % 64) / 2; }
__host__ __device__ __forceinline__ int perm32(int rho) { const int n = rho >> 4, i = rho & 15; return 8 * (i >> 2) + 4 * n + (i & 3); }

struct Unit { int pm, pn; };
struct Gemm { const bf16_t* A; const bf16_t* Bt; int M, N, K; };

struct StaticOrder {
    int nM, nN, nwg, G, c;
    __host__ __device__ void init(int M, int N, int G_, int c_) { nM = M / BM; nN = N / BM; nwg = nM * nN; G = G_; c = c_; }
    __host__ __device__ bool next(int i, Unit& u) const {
        const long L = (long)i * G + c; if (L >= nwg) return false;
        int wgid = (int)L; { const int q = nwg / NXCD, r = nwg % NXCD, xcd = wgid % NXCD, off = wgid / NXCD; wgid = (xcd < r ? xcd * (q + 1) : r * (q + 1) + (xcd - r) * q) + off; }
        const int nig = WGM * nN, gid = wgid / nig, fm = gid * WGM, gsz = (nM - fm) < WGM ? (nM - fm) : WGM;
        u.pm = fm + ((wgid % nig) % gsz); u.pn = (wgid % nig) / gsz; return true;
    }
    __device__ __forceinline__ void a_ready(const Unit&) const {}
    __device__ __forceinline__ void done(const Unit&) const {}
};
#ifndef DBG_RAW
#define DBG_RAW 0
#endif
#ifndef DBG_NO_KMEAN
#define DBG_NO_KMEAN 0
#endif
typedef float f32x2_t __attribute__((ext_vector_type(2))); typedef __bf16 bf16x2_t __attribute__((ext_vector_type(2)));
__device__ __forceinline__ unsigned cvt_pk_bf16(float lo, float hi) { f32x2_t v = {lo, hi}; bf16x2_t b = __builtin_convertvector(v, bf16x2_t); return __builtin_bit_cast(unsigned, b); }

typedef float f32x2 __attribute__((ext_vector_type(2)));
__device__ __forceinline__ f32x2 gelu_pk(f32x2 x) {
    constexpr float A = -2.0f * LOG2E * 0.7978845608028654f, B = A * 0.044715f;
    const f32x2 q = x * ((x * x) * B + A);
    f32x2 d; d.x = __builtin_amdgcn_exp2f(q.x); d.y = __builtin_amdgcn_exp2f(q.y); d = d + 1.0f;
    f32x2 r; r.x = __builtin_amdgcn_rcpf(d.x); r.y = __builtin_amdgcn_rcpf(d.y);
    return x * r;
}
__device__ __forceinline__ f32x2 sigmoid_pk(f32x2 x) {
    const f32x2 q = x * (-LOG2E);
    f32x2 d; d.x = __builtin_amdgcn_exp2f(q.x); d.y = __builtin_amdgcn_exp2f(q.y); d = d + 1.0f;
    f32x2 r; r.x = __builtin_amdgcn_rcpf(d.x); r.y = __builtin_amdgcn_rcpf(d.y);
    return r;
}
template <int ACT> __device__ __forceinline__ f32x4 act4(f32x4 v, float sc) {
    if (ACT == 0) return v * sc;
    const f32x2 a = (ACT == 1) ? gelu_pk((f32x2){v[0], v[1]}) : sigmoid_pk((f32x2){v[0], v[1]});
    const f32x2 b = (ACT == 1) ? gelu_pk((f32x2){v[2], v[3]}) : sigmoid_pk((f32x2){v[2], v[3]});
    return (f32x4){a.x, a.y, b.x, b.y};
}
template <int ACT> __device__ __forceinline__ void store_tile_bf16(const f32x4 (&acc)[2][2][4][2], bf16_t* base, int ld, int row0, int col0, float sc) {
#pragma unroll
    for (int ai = 0; ai < 2; ++ai)
#pragma unroll
        for (int m = 0; m < 4; ++m) { bf16_t* rowp = base + (size_t)(row0 + ai * HALF + m * 16) * ld + col0;
#pragma unroll
            for (int bj = 0; bj < 2; ++bj) { const f32x4 v0 = act4<ACT>(acc[ai][bj][m][0], sc), v1 = act4<ACT>(acc[ai][bj][m][1], sc);
                u32x4 w; w.x = cvt_pk_bf16(v0[0], v0[1]); w.y = cvt_pk_bf16(v0[2], v0[3]); w.z = cvt_pk_bf16(v1[0], v1[1]); w.w = cvt_pk_bf16(v1[2], v1[3]);
                *(u32x4*)(rowp + bj * HALF) = w; } }
}
__device__ __forceinline__ size_t gate_tile_off(int pm, int seg, int pn, int wave) { return ((((size_t)pm * 3 + seg) * 4 + pn) * 8 + wave) * (16 * 512); }
__device__ __forceinline__ void store_gate_tile(const f32x4 (&acc)[2][2][4][2], bf16_t* tile, int lane) {
#pragma unroll
    for (int ai = 0; ai < 2; ++ai)
#pragma unroll
        for (int m = 0; m < 4; ++m)
#pragma unroll
            for (int bj = 0; bj < 2; ++bj) { const f32x4 v0 = act4<2>(acc[ai][bj][m][0], 1.f), v1 = act4<2>(acc[ai][bj][m][1], 1.f);
                u32x4 w; w.x = cvt_pk_bf16(v0[0], v0[1]); w.y = cvt_pk_bf16(v0[2], v0[3]); w.z = cvt_pk_bf16(v1[0], v1[1]); w.w = cvt_pk_bf16(v1[2], v1[3]);
                *(u32x4*)(tile + ((ai * 4 + m) * 2 + bj) * 512 + lane * 8) = w; }
}
struct EpiProj {
    static constexpr bool PERM = true, AFTER_DRAIN = false;
    bf16_t *mix, *gv, *kb, *vb, *gates; float* kmean;
    __device__ __forceinline__ void operator()(const f32x4 (&acc)[2][2][4][2], const Unit& u, int wr, int wc, int fr, int fq) const {
        const int pn = u.pn, row0 = u.pm * BM + wr * 64 + fr, cw = wc * 32 + 8 * fq;
#if DBG_RAW
        if (pn < 3) store_tile_bf16<0>(acc, mix, 2048, row0, pn * 256 + cw, 1.f);
        else if (pn < 6) store_tile_bf16<0>(acc, gv, 768, row0, (pn - 3) * 256 + cw, 1.f);
        else if (pn < 9) store_tile_bf16<0>(acc, mix, 2048, row0, 768 + (pn - 6) * 256 + cw, 1.f);
#else
        if (pn < 3) store_tile_bf16<1>(acc, mix, 2048, row0, pn * 256 + cw, 1.f);
        else if (pn < 6) store_tile_bf16<1>(acc, gv, 768, row0, (pn - 3) * 256 + cw, 1.f);
        else if (pn < 9) store_tile_bf16<0>(acc, mix, 2048, row0, 768 + (pn - 6) * 256 + cw, C2Q);
#endif
        else if (pn < 12) {
            store_tile_bf16<0>(acc, kb, 768, row0, (pn - 9) * 256 + cw, 1.f);
#pragma unroll
            for (int bj = 0; bj < 2; ++bj)
#pragma unroll
                for (int n = 0; n < 2; ++n) { f32x4 s = (f32x4){0.f, 0.f, 0.f, 0.f};
#pragma unroll
                    for (int ai = 0; ai < 2; ++ai)
#pragma unroll
                        for (int m = 0; m < 4; ++m) s += acc[ai][bj][m][n];
#pragma unroll
                    for (int j = 0; j < 4; ++j) { float v = s[j]; v += __shfl_xor(v, 1); v += __shfl_xor(v, 2); v += __shfl_xor(v, 4); v += __shfl_xor(v, 8);
                        if (fr == 0 && !DBG_NO_KMEAN) atomicAdd(kmean + (size_t)u.pm * 768 + (pn - 9) * 256 + bj * HALF + cw + 4 * n + j, v * (1.0f / 256.0f)); } }
        }
        else if (pn < 15) store_tile_bf16<0>(acc, vb, 768, row0, (pn - 12) * 256 + cw, 1.f);
#if DBG_RAW
        else if (pn < 17) store_tile_bf16<0>(acc, mix, 2048, row0, 1536 + (pn - 15) * 256 + cw, 1.f);
        else store_tile_bf16<0>(acc, gates, 3072, row0, (pn - 17) * 256 + cw, 1.f);
#else
        else if (pn < 17) store_tile_bf16<0>(acc, mix, 2048, row0, 1536 + (pn - 15) * 256 + cw, C2M);
        else store_gate_tile(acc, gates + gate_tile_off(u.pm, (pn - 17) >> 2, (pn - 17) & 3, wr * 4 + wc), fq * 16 + fr);
#endif
    }
};
struct EpiBf16Plain {
    static constexpr bool PERM = true, AFTER_DRAIN = false;
    bf16_t* O; int ld;
    __device__ __forceinline__ void operator()(const f32x4 (&acc)[2][2][4][2], const Unit& u, int wr, int wc, int fr, int fq) const {
        store_tile_bf16<0>(acc, O, ld, u.pm * BM + wr * 64 + fr, u.pn * BM + wc * 32 + 8 * fq, 1.f);
    }
};
struct EpiF32 {
    static constexpr bool PERM = false, AFTER_DRAIN = false;
    float* O; int ld;
    __device__ __forceinline__ void operator()(const f32x4 (&acc)[2][2][4][2], const Unit& u, int wr, int wc, int fr, int fq) const {
        const int row0 = u.pm * BM + wr * 64 + fr, col0 = u.pn * BM + wc * 32 + 4 * fq;
#pragma unroll
        for (int ai = 0; ai < 2; ++ai)
#pragma unroll
            for (int m = 0; m < 4; ++m) { float* rowp = O + (size_t)(row0 + ai * HALF + m * 16) * ld + col0;
#pragma unroll
                for (int bj = 0; bj < 2; ++bj)
#pragma unroll
                    for (int n = 0; n < 2; ++n) *(f32x4*)(rowp + bj * HALF + n * 16) = acc[ai][bj][m][n]; }
    }
};
struct EpiSwiGLU {
    static constexpr bool PERM = true, AFTER_DRAIN = false;
    bf16_t* O; int ld;
    __device__ __forceinline__ void operator()(const f32x4 (&acc)[2][2][4][2], const Unit& u, int wr, int wc, int fr, int fq) const {
        const int row0 = u.pm * BM + wr * 64 + fr, col0 = u.pn * HALF + wc * 32 + 8 * fq;
#pragma unroll
        for (int ai = 0; ai < 2; ++ai)
#pragma unroll
            for (int m = 0; m < 4; ++m) { f32x4 h[2];
#pragma unroll
                for (int n = 0; n < 2; ++n)
#pragma unroll
                    for (int j = 0; j < 4; ++j) { const float g = acc[ai][0][m][n][j]; h[n][j] = g * fast_sigmoid(g) * acc[ai][1][m][n][j]; }
                u32x4 w; w.x = cvt_pk_bf16(h[0][0], h[0][1]); w.y = cvt_pk_bf16(h[0][2], h[0][3]); w.z = cvt_pk_bf16(h[1][0], h[1][1]); w.w = cvt_pk_bf16(h[1][2], h[1][3]);
                *(u32x4*)(O + (size_t)(row0 + ai * HALF + m * 16) * ld + col0) = w; }
    }
};
struct EpiMerge {
    static constexpr bool PERM = true, AFTER_DRAIN = false;
    const bf16_t* gates; bf16_t* O;
    __device__ __forceinline__ bool want_mid(int t) const { return t == 12 || t == 24; }
    __device__ __forceinline__ void mid(f32x4 (&acc)[2][2][4][2], const Unit& u, int t, int wr, int wc, int fr, int fq) const {
        const int seg = (t == 12) ? 0 : 1;
        int lane8 = (fq * 16 + fr) * 8; asm volatile("" : "+v"(lane8));
        const bf16_t* ga_p = gates + gate_tile_off(u.pm, seg, u.pn, wr * 4 + wc) + lane8;
        const bf16_t* gb_p = gates + gate_tile_off(u.pm, seg + 1, u.pn, wr * 4 + wc) + lane8;
#pragma unroll
        for (int ai = 0; ai < 2; ++ai)
#pragma unroll
            for (int m = 0; m < 4; ++m)
#pragma unroll
                for (int bj = 0; bj < 2; ++bj) { const int jo = ((ai * 4 + m) * 2 + bj) * 512; const u32x4 ga = *(const u32x4*)(ga_p + jo), gb = *(const u32x4*)(gb_p + jo);
#pragma unroll
                    for (int e = 0; e < 8; ++e) { const unsigned wa = ga[e >> 1], wb = gb[e >> 1];
                        const float a = __uint_as_float((e & 1) ? (wa & 0xffff0000u) : (wa << 16)), b = __uint_as_float((e & 1) ? (wb & 0xffff0000u) : (wb << 16));
                        acc[ai][bj][m][e >> 2][e & 3] *= a * __builtin_amdgcn_rcpf(b); } }
    }
    __device__ __forceinline__ void operator()(const f32x4 (&acc)[2][2][4][2], const Unit& u, int wr, int wc, int fr, int fq) const {
        int row0 = u.pm * BM + wr * 64 + fr; asm volatile("" : "+v"(row0));
        const int col0 = u.pn * BM + wc * 32 + 8 * fq;
        const bf16_t* ga_p = gates + gate_tile_off(u.pm, 2, u.pn, wr * 4 + wc) + (fq * 16 + fr) * 8;
#pragma unroll
        for (int ai = 0; ai < 2; ++ai)
#pragma unroll
            for (int m = 0; m < 4; ++m) { const size_t r = (size_t)(row0 + ai * HALF + m * 16);
#pragma unroll
                for (int bj = 0; bj < 2; ++bj) { const u32x4 ga = *(const u32x4*)(ga_p + ((ai * 4 + m) * 2 + bj) * 512); float o[8];
#pragma unroll
                    for (int e = 0; e < 8; ++e) { const unsigned wa = ga[e >> 1]; o[e] = acc[ai][bj][m][e >> 2][e & 3] * __uint_as_float((e & 1) ? (wa & 0xffff0000u) : (wa << 16)); }
                    u32x4 w; w.x = cvt_pk_bf16(o[0], o[1]); w.y = cvt_pk_bf16(o[2], o[3]); w.z = cvt_pk_bf16(o[4], o[5]); w.w = cvt_pk_bf16(o[6], o[7]);
                    *(u32x4*)(O + r * 1024 + col0 + bj * HALF) = w; } }
    }
};
template <class Epi, class Sched, bool ALIGN_EPI = false, bool SP2 = false, bool MID = false>
__device__ __forceinline__ void gemm_phase(PG8_LAS unsigned char* lds, const Gemm g, const Sched& S, const Epi& E, int wave_id) {
    int tid_ = wave_id * 64 + (int)__builtin_amdgcn_mbcnt_hi(~0u, __builtin_amdgcn_mbcnt_lo(~0u, 0u)); asm volatile("" : "+v"(tid_));
    const int tid = tid_, wid = __builtin_amdgcn_readfirstlane(tid >> 6), lane = tid & 63, wr = wid >> 2, wc = wid & 3, fr = lane & 15, fq = lane >> 4;
    const int K = g.K, nt = K / BK;
    unsigned voffA[2], voffB[2];
#pragma unroll
    for (int i = 0; i < 2; ++i) { int R, C; stage_rc(tid * 16 + i * 8192, R, C); const int Rb = Epi::PERM ? ((R & ~31) + perm32(R & 31)) : R;
        voffA[i] = (unsigned)(R * K + C) * 2u; voffB[i] = (unsigned)(Rb * K + C) * 2u; }
    const size_t kstep = (size_t)(BK * 2);
    const size_t hstep = (size_t)HALF * K * 2;
    const size_t tstep = 2 * hstep;
    const unsigned ldsw = (unsigned)wid * 1024u;
    const int aoff = lds_byte(wr * 64 + fr, fq * 8), boff = lds_byte(wc * 32 + fr, fq * 8);
#define PG8_SA(b, h) (((b) * 2 + (h)) * HTB)
#define PG8_SB(b, h) ((4 + (b) * 2 + (h)) * HTB)
#define PG8_STAGE(bufoff, gbase, voff) do { _Pragma("unroll") for (int _i = 0; _i < 2; ++_i) \
        __builtin_amdgcn_global_load_lds((const unsigned*)((const char*)(gbase) + (voff)[_i]), (PG8_LAS unsigned*)(lds + (bufoff) + ldsw + _i * 8192), 16, 0, 0); } while (0)
#define PG8_LDA(dst, b, h) do { _Pragma("unroll") for (int m = 0; m < 4; ++m) _Pragma("unroll") for (int k = 0; k < 2; ++k) dst[m][k] = *(const PG8_LAS bf16x8*)(lds + PG8_SA(b, h) + aoff + m * 2048 + k * 1024); } while (0)
#define PG8_LDB(dst, b, h) do { _Pragma("unroll") for (int n = 0; n < 2; ++n) _Pragma("unroll") for (int k = 0; k < 2; ++k) dst[n][k] = *(const PG8_LAS bf16x8*)(lds + PG8_SB(b, h) + boff + n * 2048 + k * 1024); } while (0)
#define PG8_MMA(ai, bj, At, Bt) do { __builtin_amdgcn_s_setprio(1); _Pragma("unroll") for (int m = 0; m < 4; ++m) _Pragma("unroll") for (int n = 0; n < 2; ++n) _Pragma("unroll") for (int k = 0; k < 2; ++k) \
        acc[ai][bj][m][n] = __builtin_amdgcn_mfma_f32_16x16x32_bf16(Bt[n][k], At[m][k], acc[ai][bj][m][n], 0, 0, 0); __builtin_amdgcn_s_setprio(0); } while (0)
#define PG8_WAIT_V(n) asm volatile("s_waitcnt vmcnt(" #n ")" ::: "memory")
#define PG8_WAIT_L(n) asm volatile("s_waitcnt lgkmcnt(" #n ")" ::: "memory")
#define PG8_BAR __builtin_amdgcn_s_barrier()
#define PG8_SCHED __builtin_amdgcn_sched_barrier(0)
    Unit cur, nxt; int ui = 0;
    if (!S.next(0, cur)) return;
    f32x4 acc[2][2][4][2];
#pragma unroll
    for (int a = 0; a < 2; ++a)
#pragma unroll
        for (int b = 0; b < 2; ++b)
#pragma unroll
            for (int m = 0; m < 4; ++m)
#pragma unroll
                for (int n = 0; n < 2; ++n) acc[a][b][m][n] = (f32x4){0.f, 0.f, 0.f, 0.f};
    bf16x8 At[4][2], B0[2][2], B1[2][2];
    const char* cA = (const char*)g.A + (size_t)cur.pm * tstep; const char* cB = (const char*)g.Bt + (size_t)cur.pn * tstep;
    S.a_ready(cur);
    if constexpr (SP2) {
        PG8_STAGE(PG8_SB(0, 0), cB, voffB); PG8_STAGE(PG8_SB(0, 1), cB + hstep, voffB); PG8_STAGE(PG8_SA(0, 0), cA, voffA); PG8_STAGE(PG8_SA(0, 1), cA + hstep, voffA);
        if (wr == 1) PG8_BAR;
        PG8_WAIT_V(2); PG8_BAR;
        PG8_STAGE(PG8_SB(1, 0), cB + kstep, voffB); PG8_STAGE(PG8_SA(1, 0), cA + kstep, voffA); PG8_STAGE(PG8_SB(1, 1), cB + hstep + kstep, voffB);
        PG8_WAIT_V(6); PG8_BAR;
    } else {
        PG8_STAGE(PG8_SB(0, 0), cB, voffB); PG8_STAGE(PG8_SA(0, 0), cA, voffA); PG8_STAGE(PG8_SB(0, 1), cB + hstep, voffB); PG8_STAGE(PG8_SA(0, 1), cA + hstep, voffA);
        if (wr == 1) PG8_BAR;
        PG8_WAIT_V(4); PG8_BAR;
        PG8_STAGE(PG8_SB(1, 0), cB + kstep, voffB); PG8_STAGE(PG8_SA(1, 0), cA + kstep, voffA); PG8_STAGE(PG8_SB(1, 1), cB + hstep + kstep, voffB);
        PG8_WAIT_V(6); PG8_BAR;
    }
    for (;;) {
        const bool has_next = S.next(ui + 1, nxt);
        const char* nA = has_next ? (const char*)g.A + (size_t)nxt.pm * tstep : cA; const char* nB = has_next ? (const char*)g.Bt + (size_t)nxt.pn * tstep : cB;
        for (int t = 0; t < nt; t += 2) {
            const bool last = (t == nt - 2);
            const char* a1 = cA + (size_t)(t + 1) * kstep;
            const char* a2 = last ? nA : cA + (size_t)(t + 2) * kstep; const char* b2 = last ? nB : cB + (size_t)(t + 2) * kstep;
            const char* a3 = a2 + kstep; const char* b3 = b2 + kstep;
            if (last && has_next) S.a_ready(nxt);
            if constexpr (SP2) {
            PG8_LDB(B0, 0, 0); PG8_LDB(B1, 0, 1); PG8_SCHED; PG8_LDA(At, 0, 0); PG8_STAGE(PG8_SA(1, 1), a1 + hstep, voffA);
            PG8_WAIT_V(8); PG8_WAIT_L(0); PG8_BAR; PG8_MMA(0, 0, At, B0); PG8_MMA(0, 1, At, B1); PG8_BAR; PG8_SCHED;
            PG8_LDA(At, 0, 1); PG8_STAGE(PG8_SB(0, 0), b2, voffB); PG8_STAGE(PG8_SB(0, 1), b2 + hstep, voffB); PG8_STAGE(PG8_SA(0, 0), a2, voffA);
            PG8_WAIT_V(8); PG8_WAIT_L(0); PG8_BAR; PG8_MMA(1, 0, At, B0); PG8_MMA(1, 1, At, B1); PG8_BAR; PG8_SCHED;
            PG8_LDB(B0, 1, 0); PG8_LDB(B1, 1, 1); PG8_SCHED; PG8_LDA(At, 1, 0); PG8_STAGE(PG8_SA(0, 1), a2 + hstep, voffA);
            PG8_WAIT_V(8); PG8_WAIT_L(0); PG8_BAR; PG8_MMA(0, 0, At, B0); PG8_MMA(0, 1, At, B1); PG8_BAR; PG8_SCHED;
            PG8_LDA(At, 1, 1); PG8_STAGE(PG8_SB(1, 0), b3, voffB); PG8_STAGE(PG8_SB(1, 1), b3 + hstep, voffB); PG8_STAGE(PG8_SA(1, 0), a3, voffA);
            PG8_WAIT_V(8); PG8_WAIT_L(0); PG8_BAR; PG8_MMA(1, 0, At, B0); PG8_MMA(1, 1, At, B1); PG8_BAR; PG8_SCHED;
            } else {
            PG8_LDB(B0, 0, 0); PG8_SCHED; PG8_LDA(At, 0, 0); PG8_STAGE(PG8_SA(1, 1), a1 + hstep, voffA);
            PG8_WAIT_L(8); PG8_BAR; PG8_WAIT_L(0); PG8_MMA(0, 0, At, B0); PG8_BAR; PG8_SCHED;
            PG8_LDB(B1, 0, 1); PG8_STAGE(PG8_SB(0, 0), b2, voffB);
            PG8_BAR; PG8_WAIT_L(0); PG8_MMA(0, 1, At, B1); PG8_BAR;
            PG8_LDA(At, 0, 1); PG8_STAGE(PG8_SA(0, 0), a2, voffA);
            PG8_BAR; PG8_WAIT_L(0); PG8_MMA(1, 0, At, B0); PG8_BAR; PG8_SCHED;
            PG8_STAGE(PG8_SB(0, 1), b2 + hstep, voffB);
            PG8_WAIT_V(6); PG8_BAR; PG8_MMA(1, 1, At, B1); PG8_BAR;
            PG8_LDB(B0, 1, 0); PG8_SCHED; PG8_LDA(At, 1, 0); PG8_STAGE(PG8_SA(0, 1), a2 + hstep, voffA);
            PG8_WAIT_L(8); PG8_BAR; PG8_WAIT_L(0); PG8_MMA(0, 0, At, B0); PG8_BAR; PG8_SCHED;
            PG8_LDB(B1, 1, 1); PG8_STAGE(PG8_SB(1, 0), b3, voffB);
            PG8_BAR; PG8_WAIT_L(0); PG8_MMA(0, 1, At, B1); PG8_BAR;
            PG8_LDA(At, 1, 1); PG8_STAGE(PG8_SA(1, 0), a3, voffA);
            PG8_BAR; PG8_WAIT_L(0); PG8_MMA(1, 0, At, B0); PG8_BAR; PG8_SCHED;
            PG8_STAGE(PG8_SB(1, 1), b3 + hstep, voffB);
            PG8_WAIT_V(6); PG8_BAR; PG8_MMA(1, 1, At, B1); PG8_BAR;
            }
            if constexpr (MID) { if (E.want_mid(t + 2)) E.mid(acc, cur, t + 2, wr, wc, fr, fq); }
        }
        if constexpr (ALIGN_EPI) { if (wr == 0) PG8_BAR; }
        if constexpr (!Epi::AFTER_DRAIN) { E(acc, cur, wr, wc, fr, fq); S.done(cur); }
        if (!has_next) break;
#pragma unroll
        for (int a = 0; a < 2; ++a)
#pragma unroll
            for (int b = 0; b < 2; ++b)
#pragma unroll
                for (int m = 0; m < 4; ++m)
#pragma unroll
                    for (int n = 0; n < 2; ++n) acc[a][b][m][n] = (f32x4){0.f, 0.f, 0.f, 0.f};
        cur = nxt; cA = nA; cB = nB; ++ui;
        if constexpr (ALIGN_EPI) { if (wr == 1) PG8_BAR; }
    }
    PG8_WAIT_V(0);
    if constexpr (!ALIGN_EPI) { if (wr == 0) PG8_BAR; }
    PG8_BAR;
    if constexpr (Epi::AFTER_DRAIN) { E.fused(acc, cur, wr, wc, fr, fq, lds, wid, lane); S.done(cur); }
#undef PG8_SA
#undef PG8_SB
#undef PG8_STAGE
#undef PG8_LDA
#undef PG8_LDB
#undef PG8_MMA
#undef PG8_WAIT_V
#undef PG8_WAIT_L
#undef PG8_BAR
#undef PG8_SCHED
}
}
#include <hip/hip_bf16.h>
#include <cmath>
namespace mattn {
using bf16=__hip_bfloat16;
using bf16x8=__attribute__((ext_vector_type(8)))short;
using s16x4=__attribute__((ext_vector_type(4)))short;
using f32x16=__attribute__((ext_vector_type(16)))float;
using u32x4=__attribute__((ext_vector_type(4)))unsigned;
typedef float f32x4_t __attribute__((ext_vector_type(4)));
constexpr int SEQ=2048,D=64,QP=2048,KP=768,QCOL=768,NHEADS=12;
constexpr int NW=8,QBLK=32,QB=QBLK*NW,KVBLK=64,NQB=SEQ/QB;
__device__ __forceinline__ int crow(int r,int hi){return (r&3)+8*(r>>2)+4*hi;}
#define SBAR() __builtin_amdgcn_sched_barrier(0)
constexpr int NSLOT=3, SLOTB=8192;
constexpr int LDS_K=0, LDS_V=NSLOT*SLOTB, LDS_WS=2*NSLOT*SLOTB, LDS_OST=LDS_WS+NW*64*4, LDS_TAB=LDS_OST+NW*4096, LDS_BYTES=LDS_TAB+2048;
constexpr float C2=0.125f*1.4426950408889634f;
__device__ __forceinline__ void glds16(const void*gsrc,unsigned lds_dst){unsigned keep;
  asm volatile("s_mov_b32 %0, m0\n\ts_mov_b32 m0, %2\n\ts_nop 0\n\tglobal_load_lds_dwordx4 %1, off\n\ts_mov_b32 m0, %0":"=&s"(keep):"v"(gsrc),"s"(lds_dst):"memory");}
__device__ __forceinline__ float max3f(float a,float b,float c){float r;asm("v_max3_f32 %0, %1, %2, %3":"=v"(r):"v"(a),"v"(b),"v"(c));return r;}
__device__ __forceinline__ float max2f(float a,float b){float r;asm("v_max_f32_e32 %0, %1, %2":"=v"(r):"v"(a),"v"(b));return r;}
__device__ __forceinline__ float fadd_s(float a,float b){float r;asm("v_add_f32_e32 %0, %1, %2":"=v"(r):"v"(a),"v"(b));return r;}
__device__ __forceinline__ float fsub_s(float a,float b){float r;asm("v_sub_f32_e32 %0, %1, %2":"=v"(r):"v"(a),"v"(b));return r;}
typedef float f32x2_t __attribute__((ext_vector_type(2))); typedef __bf16 bf16x2_t __attribute__((ext_vector_type(2)));
__device__ __forceinline__ unsigned cvtpk_s(float lo,float hi){f32x2_t v={lo,hi};bf16x2_t b=__builtin_convertvector(v,bf16x2_t);return __builtin_bit_cast(unsigned,b);}
#define WAIT_BAR(N) asm volatile("s_waitcnt vmcnt(" #N ") lgkmcnt(0)\n\ts_barrier":::"memory")

__device__ __forceinline__ void qkt(f32x16&p0,f32x16&p1,const char*Kslot,const bf16x8*qr,const f32x16&negm,int r32,int hi){
  const char*kb=Kslot+hi*1024+r32*16;
  #pragma unroll
  for(int d0=0;d0<4;++d0){
    const bf16x8 b0=*reinterpret_cast<const bf16x8*>(kb+d0*2048);
    const bf16x8 b1=*reinterpret_cast<const bf16x8*>(kb+d0*2048+512);
    if(d0==0){p0=__builtin_amdgcn_mfma_f32_32x32x16_bf16(b0,qr[0],negm,0,0,0);p1=__builtin_amdgcn_mfma_f32_32x32x16_bf16(b1,qr[0],negm,0,0,0);}
    else{p0=__builtin_amdgcn_mfma_f32_32x32x16_bf16(b0,qr[d0],p0,0,0,0);p1=__builtin_amdgcn_mfma_f32_32x32x16_bf16(b1,qr[d0],p1,0,0,0);}}
}
typedef __attribute__((address_space(3))) const char* lds_cptr;
typedef short v4i16_t __attribute__((ext_vector_type(4)));
__device__ __forceinline__ void kload8(bf16x8*kf,lds_cptr kp){
  kf[0]=*(const __attribute__((address_space(3))) bf16x8*)(kp);      kf[1]=*(const __attribute__((address_space(3))) bf16x8*)(kp+512);
  kf[2]=*(const __attribute__((address_space(3))) bf16x8*)(kp+2048); kf[3]=*(const __attribute__((address_space(3))) bf16x8*)(kp+2560);
  kf[4]=*(const __attribute__((address_space(3))) bf16x8*)(kp+4096); kf[5]=*(const __attribute__((address_space(3))) bf16x8*)(kp+4608);
  kf[6]=*(const __attribute__((address_space(3))) bf16x8*)(kp+6144); kf[7]=*(const __attribute__((address_space(3))) bf16x8*)(kp+6656);
}
__device__ __forceinline__ void kload2(bf16x8*kf,lds_cptr kp,int j){ kf[2*j]=*(const __attribute__((address_space(3))) bf16x8*)(kp+j*2048); kf[2*j+1]=*(const __attribute__((address_space(3))) bf16x8*)(kp+j*2048+512); }
__device__ __forceinline__ s16x4 vtr(lds_cptr p){ return __builtin_bit_cast(s16x4,__builtin_amdgcn_ds_read_tr16_b64_v4i16((__attribute__((address_space(3))) v4i16_t*)p)); }
__device__ __forceinline__ float rowmax(const f32x16&p0,const f32x16&p1){
  float a=max3f(p0[0],p0[1],p1[0]),b=max3f(p0[2],p0[3],p1[1]);a=max3f(a,p1[2],p1[3]);
  #pragma unroll
  for(int r=4;r<16;r+=4){a=max3f(a,p0[r],p0[r+1]);b=max3f(b,p0[r+2],p0[r+3]);a=max3f(a,p1[r],p1[r+1]);b=max3f(b,p1[r+2],p1[r+3]);}
  const float m=max2f(a,b);
  auto rr=__builtin_amdgcn_permlane32_swap(__float_as_uint(m),__float_as_uint(m),false,false);
  return max2f(__uint_as_float(rr[0]),__uint_as_float(rr[1]));
}
__device__ __forceinline__ void pv(f32x16*o,int vb,bf16x8 pa0,bf16x8 pa1,bf16x8 pa2,bf16x8 pa3){
  #pragma unroll
  for(int d0=0;d0<2;++d0){s16x4 lo[4],hi[4];
    #pragma unroll
    for(int ks=0;ks<4;++ks){
      asm volatile("ds_read_b64_tr_b16 %0,%1 offset:%c2":"=&v"(lo[ks]):"v"(vb),"i"(d0*4096+ks*1024):"memory");
      asm volatile("ds_read_b64_tr_b16 %0,%1 offset:%c2":"=&v"(hi[ks]):"v"(vb),"i"(d0*4096+ks*1024+512):"memory");}
    asm volatile("s_waitcnt lgkmcnt(0)":::"memory");SBAR();
    #define PK(k) (bf16x8){lo[k][0],lo[k][1],lo[k][2],lo[k][3],hi[k][0],hi[k][1],hi[k][2],hi[k][3]}
    o[d0]=__builtin_amdgcn_mfma_f32_32x32x16_bf16(pa0,PK(0),o[d0],0,0,0);
    o[d0]=__builtin_amdgcn_mfma_f32_32x32x16_bf16(pa1,PK(1),o[d0],0,0,0);
    o[d0]=__builtin_amdgcn_mfma_f32_32x32x16_bf16(pa2,PK(2),o[d0],0,0,0);
    o[d0]=__builtin_amdgcn_mfma_f32_32x32x16_bf16(pa3,PK(3),o[d0],0,0,0);
    #undef PK
  }
}

#ifndef ATTN_STORE16
#define ATTN_STORE16(p,v) (*(u32x4*)(p)=(v))
#endif
template<int THRL> __device__ __forceinline__ void attn_unit(int b,int h,int qb,const bf16*Q,const bf16*__restrict__ K,const bf16*__restrict__ V,bf16*O,const float*__restrict__ kmean,const float*__restrict__ relb,char*shm){
  const int tid=threadIdx.x,lane=tid&63,r32=lane&31,hi=lane>>5; const int wid=__builtin_amdgcn_readfirstlane(tid>>6);
  const long rowbase=(long)b*SEQ; const int q0=qb*QB;
  const bf16*Qw=Q+(rowbase+q0+wid*QBLK)*QP+QCOL+h*D;
  const bf16*Kh=K+rowbase*KP+h*D,*Vh=V+rowbase*KP+h*D;
  const unsigned lds0=(unsigned)(uintptr_t)shm;
  float*wsf=(float*)(shm+LDS_WS)+wid*64;
  float*tabR=(float*)(shm+LDS_TAB);
  { const int j_=tid, dist_=383-j_; float v_=-INFINITY; if(dist_>=0){ const int dd_=dist_<128?dist_:128; v_=relb[t5_bucket(dd_)*NHEADS+h]*1.4426950408889634f; } tabR[j_]=v_; }
  const float b31=relb[31*NHEADS+h]*1.4426950408889634f;
  const int qw0=q0+wid*QBLK;
  const bf16*ksrc=Kh+(long)lane*KP+wid*8;
  const bf16*vsrc=Vh+(long)(16*(wid&3)+(lane>>2))*KP+(wid>>2)*32+(lane&3)*8;
  const unsigned kdst=lds0+LDS_K+wid*1024, vdst=lds0+LDS_V+wid*1024;
  #define DMA_K(t,slot) glds16(ksrc+(long)(t)*KVBLK*KP,(unsigned)__builtin_amdgcn_readfirstlane(kdst+(slot)))
  #define DMA_V(t,slot) glds16(vsrc+(long)(t)*KVBLK*KP,(unsigned)__builtin_amdgcn_readfirstlane(vdst+(slot)))
  const int vb0=(int)(lds0+LDS_V)+((lane>>4)&1)*32+(lane&3)*8+(4*hi+((lane&15)>>2))*64;
  const char*Kbase=shm+LDS_K; bf16x8 kf[8];
  const lds_cptr shm3=(lds_cptr)shm; const lds_cptr kp0=shm3+LDS_K+hi*1024+r32*16; const lds_cptr vp0=shm3+LDS_V+((lane>>4)&1)*32+(lane&3)*8+(4*hi+((lane&15)>>2))*64;
  const int NT=(q0+QB)/KVBLK;
  DMA_K(0,0);DMA_V(0,0);DMA_K(1,SLOTB);
  bf16x8 qr[4];
  #pragma unroll
  for(int d0=0;d0<4;++d0)qr[d0]=*reinterpret_cast<const bf16x8*>(&Qw[(long)r32*QP+d0*16+hi*8]);
  unsigned sel=0u;
  if(qb>0){ float gt[7];
    _Pragma("unroll") for(int n=0;n<7;++n){ float a_=0.f; if(n<qb){ const float*km=kmean+n*768+8*hi;
        _Pragma("unroll") for(int d0=0;d0<4;++d0){ const f32x4_t k0=*(const f32x4_t*)(km+16*d0), k1=*(const f32x4_t*)(km+16*d0+4);
          _Pragma("unroll") for(int j=0;j<4;++j){ a_+=__uint_as_float(((unsigned)(unsigned short)qr[d0][j])<<16)*k0[j]; a_+=__uint_as_float(((unsigned)(unsigned short)qr[d0][j+4])<<16)*k1[j]; } }
        a_+=__shfl_xor(a_,32); } gt[n]=a_; }
    _Pragma("unroll") for(int n=0;n<7;++n) if(n<qb){ int rank=0;
      _Pragma("unroll") for(int m=0;m<7;++m) if(m!=n&&m<qb) rank+=(gt[m]>gt[n]||(gt[m]==gt[n]&&m<n))?1:0;
      if(rank<3) sel|=1u<<n; } }
  float mhat=0.f,l_reg=0.f;f32x16 o[2];o[0]=f32x16{};o[1]=f32x16{};f32x16 cin;
  const int qabs=qw0+r32; bool near_=false;
  #define TILE_SETUP(t) do{ const int k0_=64*(t); const bool above_=k0_>qw0+31, far_=(qw0-k0_-63)>=128; \
    const bool lsel_=((t)>=4*qb)||(((sel>>((t)>>2))&1u)!=0u); \
    const float c0_=(above_||!lsel_)?-INFINITY:((far_?b31:0.f)-mhat); \
    _Pragma("unroll") for(int r=0;r<16;++r)cin[r]=c0_; asm volatile("":"+v"(cin)); near_=!above_&&!far_; }while(0)
  #define NEARADD(P0,P1,t) do{ if(near_){ const float*tp_=tabR+(383-(qabs-64*(t)-4*hi)); \
    _Pragma("unroll") for(int r=0;r<16;++r){ P0[r]+=tp_[(r&3)+8*(r>>2)]; P1[r]+=tp_[(r&3)+8*(r>>2)+32]; } } }while(0)
  bool resc=false;
  #define START(P0,P1) do{ const float rm=rowmax(P0,P1); resc=false; \
    { const float dl=(rm==-INFINITY)?0.f:rm; mhat=fadd_s(mhat,dl);     \
      _Pragma("unroll") for(int r=0;r<16;++r){P0[r]=fsub_s(P0[r],dl);P1[r]=fsub_s(P1[r],dl);} } \
    _Pragma("unroll") for(int r=0;r<16;++r)P0[r]=__builtin_amdgcn_exp2f(P0[r]); }while(0)
  #define RESC() do{ if(resc){ asm volatile("s_waitcnt lgkmcnt(0)":::"memory"); \
      _Pragma("unroll") for(int d_=0;d_<2;++d_) _Pragma("unroll") for(int r=0;r<16;++r)o[d_][r]*=wsf[crow(r,hi)]; } }while(0)
  f32x16 pA0,pA1,pB0,pB1;
  int sl_prev=0,sl_cur=0,sl_next=SLOTB;
  #define ROT() do{sl_prev=sl_cur;sl_cur=sl_next;sl_next=(sl_next==(NSLOT-1)*SLOTB)?0:sl_next+SLOTB;}while(0)
  DMA_K(2,2*SLOTB);
  WAIT_BAR(3);
  TILE_SETUP(0); qkt(pA0,pA1,Kbase,qr,cin,r32,hi);asm volatile("s_nop 15\n\ts_nop 7":"+v"(pA0),"+v"(pA1));NEARADD(pA0,pA1,0);asm volatile("s_nop 1":"+v"(pA0),"+v"(pA1));
  START(pA0,pA1);
  _Pragma("unroll") for(int r=0;r<16;++r)pA1[r]=__builtin_amdgcn_exp2f(pA1[r]);
  WAIT_BAR(0);
  DMA_K(3,0);DMA_V(1,SLOTB);
  ROT();
  kload8(kf,kp0+sl_cur);
  WAIT_BAR(2);
  s16x4 vlo[8],vhi[8]; u32x4 pw0,pw1,pw2,pw3;
  #define PKW(P,B) cvtpk_s(P[B],P[B+1])
  #define PAF(k) __builtin_bit_cast(bf16x8,pw##k)
  #define VFR(i) (bf16x8){vlo[i][0],vlo[i][1],vlo[i][2],vlo[i][3],vhi[i][0],vhi[i][1],vhi[i][2],vhi[i][3]}
  #define PIN(x) asm volatile("":"+v"(x))
  #define MX3(a,b,c) __builtin_fmaxf(__builtin_fmaxf((a),(b)),(c))
  #define GAPA(MF,A0,A1,A2,A3,W0,W1,PW) do{ MF; sacc+=A0; sacc+=A1; sacc+=A2; sacc+=A3; PIN(sacc); W0; W1; PIN(PW); SBAR(); }while(0)
  #define EX(v) __builtin_amdgcn_exp2f(v)
  #define GAPB(MF,X,B) do{ MF; X[B]=EX(X[B]); X[B+1]=EX(X[B+1]); X[B+2]=EX(X[B+2]); X[B+3]=EX(X[B+3]); PIN(X); SBAR(); }while(0)
  #define VRD(i) do{ vlo[i]=vtr(vp_+(((i)>>2)*4096+((i)&3)*1024)); vhi[i]=vtr(vp_+(((i)>>2)*4096+((i)&3)*1024+512)); }while(0)
  #define KRD(G,j) do{ if(G){ kload2(kf,kp0+sl_next,j); SBAR(); } }while(0)
  #define STEP(C0,C1,P0,P1,t,GK,GV,GL) do{ TILE_SETUP(t); SBAR(); \
    const lds_cptr vp_=vp0+sl_prev; \
    VRD(0); SBAR(); float sacc=(P0[0]+P0[1]); \
    GAPA(C0=__builtin_amdgcn_mfma_f32_32x32x16_bf16(kf[0],qr[0],cin,0,0,0), P0[2],P0[3],P0[4],P0[5],     pw0[0]=PKW(P0,0), pw0[1]=PKW(P0,2), pw0); \
    VRD(4); SBAR(); GAPA(C1=__builtin_amdgcn_mfma_f32_32x32x16_bf16(kf[1],qr[0],cin,0,0,0), P0[6],P0[7],P0[8],P0[9],     pw0[2]=PKW(P0,4), pw0[3]=PKW(P0,6), pw0); \
    VRD(1); SBAR(); GAPA(C0=__builtin_amdgcn_mfma_f32_32x32x16_bf16(kf[2],qr[1],C0,0,0,0),   P0[10],P0[11],P0[12],P0[13], pw1[0]=PKW(P0,8), pw1[1]=PKW(P0,10), pw1); \
    VRD(5); SBAR(); GAPA(C1=__builtin_amdgcn_mfma_f32_32x32x16_bf16(kf[3],qr[1],C1,0,0,0),   P0[14],P0[15],P1[0],P1[1],   pw1[2]=PKW(P0,12),pw1[3]=PKW(P0,14), pw1); \
    VRD(2); SBAR(); GAPA(C0=__builtin_amdgcn_mfma_f32_32x32x16_bf16(kf[4],qr[2],C0,0,0,0),   P1[2],P1[3],P1[4],P1[5],     pw2[0]=PKW(P1,0), pw2[1]=PKW(P1,2), pw2); \
    VRD(6); SBAR(); GAPA(C1=__builtin_amdgcn_mfma_f32_32x32x16_bf16(kf[5],qr[2],C1,0,0,0),   P1[6],P1[7],P1[8],P1[9],     pw2[2]=PKW(P1,4), pw2[3]=PKW(P1,6), pw2); \
    VRD(3); SBAR(); GAPA(C0=__builtin_amdgcn_mfma_f32_32x32x16_bf16(kf[6],qr[3],C0,0,0,0),   P1[10],P1[11],P1[12],P1[13], pw3[0]=PKW(P1,8), pw3[1]=PKW(P1,10), pw3); \
    VRD(7); SBAR(); GAPA(C1=__builtin_amdgcn_mfma_f32_32x32x16_bf16(kf[7],qr[3],C1,0,0,0),   P1[14],P1[15],0.f,0.f,       pw3[2]=PKW(P1,12),pw3[3]=PKW(P1,14), pw3); \
    l_reg+=sacc; \
    if(GK){DMA_K((t)+3,sl_cur);} if(GV){DMA_V((t)+1,sl_next);} \
    NEARADD(C0,C1,t); \
    { float a=MX3(C0[0],C0[1],C1[0]),b=MX3(C0[2],C0[3],C1[1]); a=MX3(a,C1[2],C1[3]); \
      _Pragma("unroll") for(int r=4;r<16;r+=4){a=MX3(a,C0[r],C0[r+1]);b=MX3(b,C0[r+2],C0[r+3]);a=MX3(a,C1[r],C1[r+1]);b=MX3(b,C1[r+2],C1[r+3]);} \
      float rm=__builtin_fmaxf(a,b); { auto rr=__builtin_amdgcn_permlane32_swap(__float_as_uint(rm),__float_as_uint(rm),false,false); rm=__builtin_fmaxf(__uint_as_float(rr[0]),__uint_as_float(rr[1])); } \
      resc=false; \
      if(__builtin_expect(__any(rm>(float)THRL),0)){ const float dl=__builtin_fmaxf(rm,0.f); mhat+=dl; \
        _Pragma("unroll") for(int r=0;r<16;++r){C0[r]-=dl;C1[r]-=dl;} \
        const float f=__builtin_amdgcn_exp2f(-dl); l_reg*=f; if(hi==0)wsf[r32]=f; resc=true; } } \
    SBAR(); \
    GAPB(o[0]=__builtin_amdgcn_mfma_f32_32x32x16_bf16(PAF(0),VFR(0),o[0],0,0,0), C0,0); \
    GAPB(o[1]=__builtin_amdgcn_mfma_f32_32x32x16_bf16(PAF(0),VFR(4),o[1],0,0,0), C0,4); \
    KRD(GL,0); GAPB(o[0]=__builtin_amdgcn_mfma_f32_32x32x16_bf16(PAF(1),VFR(1),o[0],0,0,0), C0,8); \
    KRD(GL,1); GAPB(o[1]=__builtin_amdgcn_mfma_f32_32x32x16_bf16(PAF(1),VFR(5),o[1],0,0,0), C0,12); \
    KRD(GL,2); GAPB(o[0]=__builtin_amdgcn_mfma_f32_32x32x16_bf16(PAF(2),VFR(2),o[0],0,0,0), C1,0); \
    KRD(GL,3); GAPB(o[1]=__builtin_amdgcn_mfma_f32_32x32x16_bf16(PAF(2),VFR(6),o[1],0,0,0), C1,4); \
    GAPB(o[0]=__builtin_amdgcn_mfma_f32_32x32x16_bf16(PAF(3),VFR(3),o[0],0,0,0), C1,8); \
    GAPB(o[1]=__builtin_amdgcn_mfma_f32_32x32x16_bf16(PAF(3),VFR(7),o[1],0,0,0), C1,12); \
    }while(0)
  int t=1;
  for(;t+7<NT;t+=2){
    STEP(pB0,pB1,pA0,pA1,t,true,true,true);     WAIT_BAR(2); RESC(); ROT();
    STEP(pA0,pA1,pB0,pB1,t+1,true,true,true);   WAIT_BAR(2); RESC(); ROT();
  }
  #define ENDW(tt) do{ if((tt)+3<NT){WAIT_BAR(2);} else if((tt)+2<NT){WAIT_BAR(1);} else {WAIT_BAR(0);} }while(0)
  for(;t+1<NT;t+=2){
    STEP(pB0,pB1,pA0,pA1,t,(t+3<NT),(t+1<NT),(t+1<NT));       ENDW(t);   RESC(); ROT();
    STEP(pA0,pA1,pB0,pB1,t+1,(t+4<NT),(t+2<NT),(t+2<NT));     ENDW(t+1); RESC(); ROT();
  }
  STEP(pB0,pB1,pA0,pA1,NT-1,false,false,false); RESC();
  { float sacc=pB0[0]+pB0[1]; _Pragma("unroll") for(int r=2;r<16;++r)sacc+=pB0[r]; _Pragma("unroll") for(int r=0;r<16;++r)sacc+=pB1[r]; l_reg+=sacc;
    pw0=(u32x4){PKW(pB0,0),PKW(pB0,2),PKW(pB0,4),PKW(pB0,6)};pw1=(u32x4){PKW(pB0,8),PKW(pB0,10),PKW(pB0,12),PKW(pB0,14)};pw2=(u32x4){PKW(pB1,0),PKW(pB1,2),PKW(pB1,4),PKW(pB1,6)};pw3=(u32x4){PKW(pB1,8),PKW(pB1,10),PKW(pB1,12),PKW(pB1,14)};
    SBAR(); pv(o,vb0+sl_cur,PAF(0),PAF(1),PAF(2),PAF(3)); }
  #undef PKW
  #undef PAF
  #undef VFR
  #undef PIN
  #undef MX3
  #undef GAPA
  #undef GAPB
  #undef EX
  #undef VRD
  #undef KRD
  #undef STEP
  #undef ENDW
  {auto rr=__builtin_amdgcn_permlane32_swap(__float_as_uint(l_reg),__float_as_uint(l_reg),false,false);l_reg=__uint_as_float(rr[0])+__uint_as_float(rr[1]);}
  if(hi==0)wsf[32+r32]=l_reg;asm volatile("s_waitcnt lgkmcnt(0)":::"memory");
  float rli[16];
  #pragma unroll
  for(int r=0;r<16;++r)rli[r]=__builtin_amdgcn_rcpf(wsf[32+crow(r,hi)]);
  bf16*Ow=O+(rowbase+q0+wid*QBLK)*QP+QCOL+h*D;
  { bf16*stg=(bf16*)(shm+LDS_OST)+wid*2048;
    #pragma unroll
    for(int r=0;r<16;++r){const int orow=crow(r,hi);
      #pragma unroll
      for(int d0=0;d0<2;++d0)stg[orow*64+d0*32+r32]=__float2bfloat16(o[d0][r]*rli[r]);}
    asm volatile("s_waitcnt lgkmcnt(0)":::"memory");
    #pragma unroll
    for(int i=0;i<4;++i){const int row=i*8+(lane>>3),ch=lane&7; const u32x4 v=*(const u32x4*)(stg+row*64+ch*8); ATTN_STORE16(Ow+(long)row*QP+ch*8,v);} }
  asm volatile("s_waitcnt lgkmcnt(0)\n\ts_barrier":::"memory");
  #undef DMA_K
  #undef DMA_V
  #undef TILE_SETUP
  #undef NEARADD
  #undef START
  #undef RESC
  #undef ROT
}
constexpr int ATTN_LDS_BYTES=LDS_BYTES;
struct AttnTensors { const bf16* Q; const bf16* K; const bf16* V; bf16* O; const float* kmean; const float* relb; };
template<int THRL=8> __device__ __forceinline__ void attn_phase(char*lds,const AttnTensors&T,int vcu,int G){
  for(int p=vcu*3;p<768;p+=G*3){
    for(int i=0;i<3&&p+i<768;++i){ const int pr=p+i, bh=pr>>2, s=pr&3, b=bh/NHEADS, h=bh-b*NHEADS; const float*km=T.kmean+(long)b*8*768+h*64;
      attn_unit<THRL>(b,h,s,T.Q,T.K,T.V,T.O,km,T.relb,lds);
      attn_unit<THRL>(b,h,7-s,T.Q,T.K,T.V,T.O,km,T.relb,lds); } }
}
#undef SBAR
#undef WAIT_BAR
}
namespace mix2 {
typedef short bf16x8 __attribute__((ext_vector_type(8)));
typedef short s16x4 __attribute__((ext_vector_type(4)));
typedef float f32x16 __attribute__((ext_vector_type(16)));
typedef float f32x4v __attribute__((ext_vector_type(4)));
typedef unsigned u32x4 __attribute__((ext_vector_type(4)));
typedef unsigned u32x2 __attribute__((ext_vector_type(2)));
typedef __attribute__((address_space(3))) unsigned char* ldsp;
typedef __attribute__((address_space(3))) const unsigned char* ldscp;
__device__ __forceinline__ int crow(int r, int hi) { return (r & 3) + 8 * (r >> 2) + 4 * hi; }
__device__ __forceinline__ s16x4 vtr(ldscp p) { return __builtin_bit_cast(s16x4, __builtin_amdgcn_ds_read_tr16_b64_v4i16((__attribute__((address_space(3))) s16x4*)p)); }
__device__ __forceinline__ unsigned cvt2(float lo, float hi) { typedef float f2 __attribute__((ext_vector_type(2))); typedef __bf16 b2 __attribute__((ext_vector_type(2))); f2 v = {lo, hi}; b2 b = __builtin_convertvector(v, b2); return __builtin_bit_cast(unsigned, b); }
__device__ __forceinline__ float bflo(unsigned w) { return __uint_as_float(w << 16); }
__device__ __forceinline__ float bfhi(unsigned w) { return __uint_as_float(w & 0xffff0000u); }
#define MFMA32(a, b, c) __builtin_amdgcn_mfma_f32_32x32x16_bf16(a, b, c, 0, 0, 0)

constexpr int G_VN = 1024, G_W = 1024 + 32768, G_OUT = 1024 + 65536;
__device__ __forceinline__ void gmlp_phase(ldsp lds, int wave, int vcu, int G, const bf16* gv, const float* gain, const float* bias, const float* wsp, const float* bsp, bf16* mix, bf16* dummy = nullptr) {
    const int lane = (int)__builtin_amdgcn_mbcnt_hi(~0u, __builtin_amdgcn_mbcnt_lo(~0u, 0u)), tid = wave * 64 + lane, r32 = lane & 31, hi = lane >> 5;
    __attribute__((address_space(3))) float* stats = (__attribute__((address_space(3))) float*)lds;
    for (int chunk = vcu; chunk < T / CHUNK; chunk += G) {
        const int base = chunk * CHUNK;
#pragma unroll
        for (int bt = 0; bt < 2; ++bt) {
            unsigned long long w[8][3];
#pragma unroll
            for (int i = 0; i < 8; ++i) { const unsigned long long* gp = (const unsigned long long*)(gv + (size_t)(base + wave * 16 + bt * 8 + i) * 768) + lane;
#pragma unroll
                for (int jj = 0; jj < 3; ++jj) w[i][jj] = gp[64 * jj]; }
            float s[8], q[8];
#pragma unroll
            for (int i = 0; i < 8; ++i) { float a = 0.f, b = 0.f;
#pragma unroll
                for (int jj = 0; jj < 3; ++jj) { const unsigned lo = (unsigned)w[i][jj], hw = (unsigned)(w[i][jj] >> 32);
                    const float v0 = bflo(lo), v1 = bfhi(lo), v2 = bflo(hw), v3 = bfhi(hw); a += (v0 + v1) + (v2 + v3); b += (v0 * v0 + v1 * v1) + (v2 * v2 + v3 * v3); }
                s[i] = a; q[i] = b; }
#pragma unroll
            for (int o = 1; o < 64; o <<= 1) {
#pragma unroll
                for (int i = 0; i < 8; ++i) { s[i] += __shfl_xor(s[i], o); q[i] += __shfl_xor(q[i], o); } }
            if (lane < 8) { float mu = 0.f, qq = 0.f;
#pragma unroll
                for (int i = 0; i < 8; ++i) if (lane == i) { mu = s[i]; qq = q[i]; }
                mu *= (1.f / 768.f); const float var = fmaxf(qq * (1.f / 768.f) - mu * mu, 0.f);
                const int row = wave * 16 + bt * 8 + lane; stats[2 * row] = mu; stats[2 * row + 1] = rsqrtf(var + EPS); }
        }
        __syncthreads();
        u32x4 gvw[4], uw[4], uwn[4]; f32x4v ww[4][2];
#define GMLP_LOAD(gg, UW) do { _Pragma("unroll") for (int k = 0; k < 4; ++k) { const int id = tid + 512 * k, s_ = id >> 4, c_ = id & 15; \
            gvw[k] = *(const u32x4*)(gv + (size_t)(base + s_) * 768 + (gg) * 128 + c_ * 8); \
            ww[k][0] = *(const f32x4v*)(wsp + (size_t)(gg) * 16384 + s_ * 128 + c_ * 8); ww[k][1] = *(const f32x4v*)(wsp + (size_t)(gg) * 16384 + s_ * 128 + c_ * 8 + 4); \
            UW[k] = *(const u32x4*)(mix + (size_t)(base + s_) * 2048 + (gg) * 128 + c_ * 8); } } while (0)
        GMLP_LOAD(0, uw);
        for (int g = 0; g < 6; ++g) {
#pragma unroll
            for (int k = 0; k < 4; ++k) { const int id = tid + 512 * k, s = id >> 4, c = id & 15, ch = g * 128 + c * 8;
                const u32x4 w = gvw[k];
                const f32x4v g0 = *(const f32x4v*)(gain + ch), g1 = *(const f32x4v*)(gain + ch + 4), b0 = *(const f32x4v*)(bias + ch), b1 = *(const f32x4v*)(bias + ch + 4);
                const float mu = stats[2 * s], rs = stats[2 * s + 1];
                u32x4 o;
                o.x = cvt2((bflo(w.x) - mu) * rs * g0[0] + b0[0], (bfhi(w.x) - mu) * rs * g0[1] + b0[1]);
                o.y = cvt2((bflo(w.y) - mu) * rs * g0[2] + b0[2], (bfhi(w.y) - mu) * rs * g0[3] + b0[3]);
                o.z = cvt2((bflo(w.z) - mu) * rs * g1[0] + b1[0], (bfhi(w.z) - mu) * rs * g1[1] + b1[1]);
                o.w = cvt2((bflo(w.w) - mu) * rs * g1[2] + b1[2], (bfhi(w.w) - mu) * rs * g1[3] + b1[3]);
                *(__attribute__((address_space(3))) u32x4*)(lds + G_VN + (c >> 2) * 8192 + s * 64 + (c & 3) * 16) = o;
                const int t = s;
                float wv[8] = {ww[k][0][0], ww[k][0][1], ww[k][0][2], ww[k][0][3], ww[k][1][0], ww[k][1][1], ww[k][1][2], ww[k][1][3]};
#pragma unroll
                for (int jj = 0; jj < 8; ++jj) if (c * 8 + jj > t) wv[jj] = 0.f;
                u32x4 ow; ow.x = cvt2(wv[0], wv[1]); ow.y = cvt2(wv[2], wv[3]); ow.z = cvt2(wv[4], wv[5]); ow.w = cvt2(wv[6], wv[7]);
                *(__attribute__((address_space(3))) u32x4*)(lds + G_W + t * 256 + ((c ^ (t & 15)) << 4)) = ow; }
            __syncthreads();
            if (g < 5) GMLP_LOAD(g + 1, uwn);
            const int tb = wave & 3, dh = wave >> 2;
            f32x16 acc0 = {}, acc1 = {};
            const int trow = 32 * tb + r32;
            ldscp vb = (ldscp)(lds + G_VN + (2 * dh) * 8192 + (8 * hi + ((lane & 15) >> 2)) * 64 + ((lane >> 4) & 1) * 32 + (lane & 3) * 8);
            for (int ks = 0; ks <= 2 * tb + 1; ++ks) {
                const bf16x8 a = *(__attribute__((address_space(3))) const bf16x8*)(lds + G_W + trow * 256 + (((2 * ks + hi) ^ (trow & 15)) << 4));
                const s16x4 l0 = vtr(vb + ks * 1024), h0 = vtr(vb + ks * 1024 + 256), l1 = vtr(vb + 8192 + ks * 1024), h1 = vtr(vb + 8192 + ks * 1024 + 256);
                const bf16x8 v0 = {l0[0], l0[1], l0[2], l0[3], h0[0], h0[1], h0[2], h0[3]}, v1 = {l1[0], l1[1], l1[2], l1[3], h1[0], h1[1], h1[2], h1[3]};
                acc0 = MFMA32(a, v0, acc0); acc1 = MFMA32(a, v1, acc1);
            }
#pragma unroll
            for (int r = 0; r < 16; ++r) { const int tl = 32 * tb + crow(r, hi); const float bs = bsp[g * CHUNK + tl];
                __attribute__((address_space(3))) float* op = (__attribute__((address_space(3))) float*)(lds + G_OUT) + tl * 128 + dh * 64 + r32;
                op[0] = acc0[r] + bs; op[32] = acc1[r] + bs; }
            __syncthreads();
#pragma unroll
            for (int k = 0; k < 4; ++k) { const int id = tid + 512 * k, t = id >> 4, c = id & 15;
                const f32x4v m0 = *(__attribute__((address_space(3))) const f32x4v*)(lds + G_OUT + t * 512 + c * 32), m1 = *(__attribute__((address_space(3))) const f32x4v*)(lds + G_OUT + t * 512 + c * 32 + 16);
                const u32x4 u = uw[k]; u32x4 o;
                o.x = cvt2(bflo(u.x) * m0[0], bfhi(u.x) * m0[1]); o.y = cvt2(bflo(u.y) * m0[2], bfhi(u.y) * m0[3]);
                o.z = cvt2(bflo(u.z) * m1[0], bfhi(u.z) * m1[1]); o.w = cvt2(bflo(u.w) * m1[2], bfhi(u.w) * m1[3]);
                const size_t mo = (size_t)(base + t) * 2048 + g * 128 + c * 8;
                *(u32x4*)(dummy ? dummy + (mo & 0x7ffff8u) : mix + mo) = o; }
#pragma unroll
            for (int k = 0; k < 4; ++k) uw[k] = uwn[k];
        }
#undef GMLP_LOAD
        __syncthreads();
    }
}

constexpr int M_V = 65536, M_WS = 131072, M_LDS = 131072 + 2048;
__device__ __forceinline__ void memattn_phase(ldsp lds, int wave, int vcu, int G, bf16* mix, const bf16* memkv, bf16* dummy = nullptr) {
    const int lane = (int)__builtin_amdgcn_mbcnt_hi(~0u, __builtin_amdgcn_mbcnt_lo(~0u, 0u)), tid = wave * 64 + lane, r32 = lane & 31, hi = lane >> 5;
    __attribute__((address_space(3))) float* wsf = (__attribute__((address_space(3))) float*)(lds + M_WS) + wave * 64;
    for (int task = vcu; task < BATCH * MH * 4; task += G) {
        const int bh = task >> 2, jq = task & 3, b = bh >> 2, h = bh & 3;
#pragma unroll
        for (int k = 0; k < 8; ++k) { const int id = tid + 512 * k, row = id >> 4, c = id & 15;
            const bf16* src = memkv + (size_t)(b * MEMLEN + row) * 1024 + h * 128 + c * 8;
            const u32x4 kk = *(const u32x4*)src, vv = *(const u32x4*)(src + 512);
            *(__attribute__((address_space(3))) u32x4*)(lds + row * 256 + ((c ^ (row & 15)) << 4)) = kk;
            *(__attribute__((address_space(3))) u32x4*)(lds + M_V + (c >> 2) * 16384 + row * 64 + (c & 3) * 16) = vv; }
        __syncthreads();
        for (int qi = 0; qi < 2; ++qi) {
            const int t0 = b * SEQ + (2 * jq + qi) * 256 + wave * 32;
            bf16x8 qr[8];
#pragma unroll
            for (int d0 = 0; d0 < 8; ++d0) qr[d0] = *(const bf16x8*)(mix + (size_t)(t0 + r32) * 2048 + 1536 + h * 128 + d0 * 16 + hi * 8);
            f32x16 o[4]; o[0] = f32x16{}; o[1] = f32x16{}; o[2] = f32x16{}; o[3] = f32x16{};
            float mrow = -INFINITY, lsum = 0.f;
            ldscp vb = (ldscp)(lds + M_V + (4 * hi + ((lane & 15) >> 2)) * 64 + ((lane >> 4) & 1) * 32 + (lane & 3) * 8);
            for (int kc = 0; kc < 4; ++kc) {
                f32x16 p0 = {}, p1 = {};
                const int krow = kc * 64 + r32;
#pragma unroll
                for (int d0 = 0; d0 < 8; ++d0) { const int sw = ((2 * d0 + hi) ^ (r32 & 15)) << 4;
                    const bf16x8 k0 = *(__attribute__((address_space(3))) const bf16x8*)(lds + krow * 256 + sw), k1 = *(__attribute__((address_space(3))) const bf16x8*)(lds + (krow + 32) * 256 + sw);
                    p0 = MFMA32(k0, qr[d0], p0); p1 = MFMA32(k1, qr[d0], p1); }
                float mx = fmaxf(p0[0], p1[0]);
#pragma unroll
                for (int r = 1; r < 16; ++r) mx = fmaxf(mx, fmaxf(p0[r], p1[r]));
                mx = fmaxf(mx, __shfl_xor(mx, 32));
                const float mn = fmaxf(mrow, mx), alpha = __builtin_amdgcn_exp2f(mrow - mn); mrow = mn;
                float ps = 0.f;
#pragma unroll
                for (int r = 0; r < 16; ++r) { p0[r] = __builtin_amdgcn_exp2f(p0[r] - mn); p1[r] = __builtin_amdgcn_exp2f(p1[r] - mn); ps += p0[r] + p1[r]; }
                lsum = lsum * alpha + ps;
                if (hi == 0) wsf[r32] = alpha;
                u32x4 pw0, pw1, pw2, pw3;
                pw0 = (u32x4){cvt2(p0[0], p0[1]), cvt2(p0[2], p0[3]), cvt2(p0[4], p0[5]), cvt2(p0[6], p0[7])};
                pw1 = (u32x4){cvt2(p0[8], p0[9]), cvt2(p0[10], p0[11]), cvt2(p0[12], p0[13]), cvt2(p0[14], p0[15])};
                pw2 = (u32x4){cvt2(p1[0], p1[1]), cvt2(p1[2], p1[3]), cvt2(p1[4], p1[5]), cvt2(p1[6], p1[7])};
                pw3 = (u32x4){cvt2(p1[8], p1[9]), cvt2(p1[10], p1[11]), cvt2(p1[12], p1[13]), cvt2(p1[14], p1[15])};
                if (kc > 0) {
#pragma unroll
                    for (int r = 0; r < 16; ++r) { const float f = wsf[crow(r, hi)];
#pragma unroll
                        for (int dq = 0; dq < 4; ++dq) o[dq][r] *= f; } }
#pragma unroll
                for (int dq = 0; dq < 4; ++dq) {
#pragma unroll
                    for (int ks = 0; ks < 4; ++ks) { ldscp vp = vb + dq * 16384 + (kc * 64 + ks * 16) * 64;
                        const s16x4 l = vtr(vp), hh = vtr(vp + 512);
                        const bf16x8 vf = {l[0], l[1], l[2], l[3], hh[0], hh[1], hh[2], hh[3]};
                        const u32x4 pa = ks == 0 ? pw0 : (ks == 1 ? pw1 : (ks == 2 ? pw2 : pw3));
                        o[dq] = MFMA32(__builtin_bit_cast(bf16x8, pa), vf, o[dq]); } }
            }
            lsum += __shfl_xor(lsum, 32);
            if (hi == 0) wsf[32 + r32] = 1.0f / lsum;
#pragma unroll
            for (int r = 0; r < 16; ++r) { const float f = wsf[32 + crow(r, hi)];
                const size_t oo = (size_t)(t0 + crow(r, hi)) * 2048 + 1536 + h * 128 + r32; bf16* op = dummy ? dummy + (oo & 0x7fffffu) : mix + oo;
#pragma unroll
                for (int dq = 0; dq < 4; ++dq) op[dq * 32] = (bf16)f2bf(o[dq][r] * f); }
        }
        __syncthreads();
    }
}
#undef MFMA32
}
typedef GAS unsigned gu32;
#define RLX_AGENT __ATOMIC_RELAXED, __HIP_MEMORY_SCOPE_AGENT
#define XB_TMO      128
#define XB_XCNT(j)  (256  + 64 * (j))
#define XB_XSUB(j)  (1280 + 64 * (j))
#define XB_XGEN(j)  (2304 + 64 * (j))
#define XB_TOP      3328
#define XB_TOPGEN   3392
#define XCD_BAR_WORDS 3456
#define XB_SPIN_CAP (1u << 18)

__device__ __forceinline__ unsigned xb_ld(unsigned* p)              { return __hip_atomic_load(p, __ATOMIC_RELAXED, __HIP_MEMORY_SCOPE_AGENT); }
__device__ __forceinline__ unsigned xb_add(unsigned* p, unsigned v) { return __hip_atomic_fetch_add(p, v, __ATOMIC_RELAXED, __HIP_MEMORY_SCOPE_AGENT); }
__device__ __forceinline__ unsigned xb_xcc_id() { return (unsigned)__builtin_amdgcn_s_getreg((3 << 11) | 20) & 0xFu; }
#define XB_SPIN(cond, bar) do { unsigned _sp = 0; while (cond) { __builtin_amdgcn_s_sleep(1); \
    if ((++_sp & 255u) == 0u) { if (xb_ld(&(bar)[XB_TMO])) break; if (_sp > XB_SPIN_CAP) { atomicAdd(&(bar)[XB_TMO], 1u); break; } } } } while (0)

struct XcdBarrier {
    unsigned* bar; unsigned x;
    volatile LAS unsigned* st;
};

__device__ __forceinline__ int xb_lane() { return (int)__builtin_amdgcn_mbcnt_hi(~0u, __builtin_amdgcn_mbcnt_lo(~0u, 0u)); }
__device__ __forceinline__ XcdBarrier xcd_barrier_post(unsigned* bar, volatile LAS unsigned* st, int wave_id) {
    XcdBarrier b; b.bar = bar; b.x = xb_xcc_id(); b.st = st;
    if (wave_id == 0 && xb_lane() == 0) (void)xb_add(&bar[XB_XCNT(b.x)], 1u);
    return b;
}
__device__ __forceinline__ void xcd_barrier_complete(unsigned* bar, unsigned x, unsigned& nloc, unsigned& nx) {
    const unsigned G = gridDim.x * gridDim.y * gridDim.z;
    unsigned sum, cnt, mine, sp = 0u;
    for (;;) {
        sum = 0u; cnt = 0u; mine = 0u;
#pragma unroll
        for (unsigned j = 0; j < 16; ++j) { const unsigned c = xb_ld(&bar[XB_XCNT(j)]); sum += c; cnt += (c > 0u) ? 1u : 0u; mine = (j == x) ? c : mine; }
        if (sum == G) break;
        __builtin_amdgcn_s_sleep(1);
        if ((++sp & 255u) == 0u) { if (xb_ld(&bar[XB_TMO])) break; if (sp > XB_SPIN_CAP) { atomicAdd(&bar[XB_TMO], 1u); break; } }
    }
    nloc = mine > 0u ? mine : 1u; nx = cnt > 0u ? cnt : 1u;
}

__device__ __forceinline__ void xcd_barrier(const XcdBarrier& b, int wave_id) {
    asm volatile("s_waitcnt vmcnt(0)" ::: "memory");
    __syncthreads();
    if (wave_id == 0 && xb_lane() == 0) {
        unsigned* bar = b.bar;
        __builtin_amdgcn_s_waitcnt(0);
        unsigned nloc = b.st[0], nx = b.st[1];
        if (nloc == 0u) { xcd_barrier_complete(bar, b.x, nloc, nx); b.st[0] = nloc; b.st[1] = nx; }
        const unsigned old = xb_add(&bar[XB_XSUB(b.x)], 1u);
        const unsigned gen = old / nloc;
        if (old + 1u == (gen + 1u) * nloc) {
            __builtin_amdgcn_fence(__ATOMIC_RELEASE, "agent");
            asm volatile("s_waitcnt vmcnt(0)" ::: "memory");
            const unsigned og = xb_add(&bar[XB_TOP], 1u);
            const unsigned tg = og / nx;
            if (og + 1u == (tg + 1u) * nx) xb_add(&bar[XB_TOPGEN], 1u);
            else XB_SPIN(xb_ld(&bar[XB_TOPGEN]) == tg, bar);
            __builtin_amdgcn_fence(__ATOMIC_ACQUIRE, "agent");
            xb_add(&bar[XB_XGEN(b.x)], 1u);
            asm volatile("s_waitcnt vmcnt(0)" ::: "memory");
        } else {
            XB_SPIN(xb_ld(&bar[XB_XGEN(b.x)]) == gen, bar);
            __builtin_amdgcn_fence(__ATOMIC_ACQUIRE, "agent");
            asm volatile("s_waitcnt vmcnt(0)" ::: "memory");
        }
    }
    __syncthreads();
}
#ifndef DUP_MASK
#define DUP_MASK 0
#endif
#define REPS(k) (((DUP_MASK >> (k)) & 1) ? 2 : 1)
#ifndef DBG_NAIVE_GMLP
#define DBG_NAIVE_GMLP 0
#endif
#ifndef DBG_NAIVE_MEMATTN
#define DBG_NAIVE_MEMATTN 0
#endif
#ifndef DBG_NAIVE_MOBA
#define DBG_NAIVE_MOBA 0
#endif
#ifndef DBG_P1
#define DBG_P1 3
#endif
constexpr int NWAVES = 8;
constexpr int RING_BYTES = 131072;
constexpr int LDS_BYTES = 147456;

struct Args { const float* in[21]; float* out; unsigned char* ws; int ph_lo, ph_hi; };

__device__ __forceinline__ int opq(int v) { asm volatile("" : "+v"(v)); return v; }
__device__ __forceinline__ int lane_id() { return (int)__builtin_amdgcn_mbcnt_hi(~0u, __builtin_amdgcn_mbcnt_lo(~0u, 0u)); }
struct Frame {
    LAS unsigned char* lds;
    int wave, vcu, G;
};

__device__ __forceinline__ void p0_transpose_item(const float* W, int K, int N, bf16* WT, int ldt, int col_off, int mode, LAS float* scr, int item, int lane) {
    const int nblk = N / 32, kb = item / nblk, nb = item % nblk, k0 = 64 * kb, n0 = 32 * nb;
#pragma unroll 8
    for (int i = 0; i < 32; ++i) { const int kk = 2 * i + (lane >> 5); scr[kk * 33 + (lane & 31)] = W[(size_t)(k0 + kk) * N + n0 + (lane & 31)]; }
    asm volatile("s_waitcnt lgkmcnt(0)" ::: "memory");
    const int c = lane & 7;
    const int rbase = mode ? ((n0 / 128) * 256 + (n0 % 128) + (mode == 2 ? 128 : 0)) : n0;
#pragma unroll
    for (int j = 0; j < 4; ++j) { const int n = (lane >> 3) + 8 * j; const LAS float* s = scr + (8 * c) * 33 + n;
        v4u o; o.x = pk2(s[0 * 33], s[1 * 33]); o.y = pk2(s[2 * 33], s[3 * 33]); o.z = pk2(s[4 * 33], s[5 * 33]); o.w = pk2(s[6 * 33], s[7 * 33]);
        *(v4u*)(WT + (size_t)(rbase + n) * ldt + col_off + k0 + 8 * c) = o; }
    asm volatile("s_waitcnt lgkmcnt(0)" ::: "memory");
}
__device__ __forceinline__ void rms_row_bf16(const float* xrow, const float* g, bf16* orow, int lane_) {
    const int lane = opq(lane_);
    const f32x4* xr = (const f32x4*)xrow + lane;
    f32x4 v[4]; float s = 0.f;
#pragma unroll
    for (int j = 0; j < 4; ++j) { v[j] = xr[64 * j]; s += (v[j].x * v[j].x + v[j].y * v[j].y) + (v[j].z * v[j].z + v[j].w * v[j].w); }
    const float r = rsqrtf(wave_sum(s) * (1.f / DM) + EPS);
    unsigned long long* o8 = (unsigned long long*)orow + lane;
#pragma unroll
    for (int j = 0; j < 4; ++j) { const f32x4 gg = ((const f32x4*)g)[lane + 64 * j];
        o8[64 * j] = (unsigned long long)pk2(v[j].x * r * gg.x, v[j].y * r * gg.y) | ((unsigned long long)pk2(v[j].z * r * gg.z, v[j].w * r * gg.w) << 32); }
}
__device__ __forceinline__ void post_norm_row(const float* xin, const float* y, const float* g1, float* x1out, const float* g2, bf16* h2, int lane_) {
    const int lane = opq(lane_);
    const f32x4* yr = (const f32x4*)y + lane; const f32x4* xr = (const f32x4*)xin + lane;
    f32x4 v[4]; float s = 0.f;
#pragma unroll
    for (int j = 0; j < 4; ++j) { v[j] = yr[64 * j]; s += (v[j].x * v[j].x + v[j].y * v[j].y) + (v[j].z * v[j].z + v[j].w * v[j].w); }
    const float r = rsqrtf(wave_sum(s) * (1.f / DM) + EPS);
    float s2 = 0.f;
#pragma unroll
    for (int j = 0; j < 4; ++j) { const f32x4 gg = ((const f32x4*)g1)[lane + 64 * j]; const f32x4 xx = xr[64 * j];
        v[j] = xx + v[j] * r * gg; ((f32x4*)x1out)[lane + 64 * j] = v[j];
        s2 += (v[j].x * v[j].x + v[j].y * v[j].y) + (v[j].z * v[j].z + v[j].w * v[j].w); }
    if (h2) {
        const float r2 = rsqrtf(wave_sum(s2) * (1.f / DM) + EPS);
        unsigned long long* o8 = (unsigned long long*)h2 + lane;
#pragma unroll
        for (int j = 0; j < 4; ++j) { const f32x4 gg = ((const f32x4*)g2)[lane + 64 * j];
            o8[64 * j] = (unsigned long long)pk2(v[j].x * r2 * gg.x, v[j].y * r2 * gg.y) | ((unsigned long long)pk2(v[j].z * r2 * gg.z, v[j].w * r2 * gg.w) << 32); }
    }
}

__device__ __forceinline__ void gmlp_body(Frame& F, const bf16* gv, const float* gain, const float* bias, const float* wsp, const float* bsp, bf16* mix) {
    LAS float* stats = (LAS float*)F.lds;
    LAS float* vn = (LAS float*)(F.lds + 1024);
    LAS float* wl = (LAS float*)(F.lds + 1024 + 65536);
    const int lane = opq(lane_id()), tid = F.wave * 64 + lane;
    for (int chunk = F.vcu; chunk < T / CHUNK; chunk += F.G) {
        const int base = chunk * CHUNK;
        for (int r = F.wave; r < CHUNK; r += NWAVES) {
            float v[12]; float s = 0.f;
#pragma unroll
            for (int j = 0; j < 12; ++j) { v[j] = bf2f(gv[(size_t)(base + r) * 768 + lane + 64 * j]); s += v[j]; }
            const float mu = wave_sum(s) * (1.f / 768.f); float q = 0.f;
#pragma unroll
            for (int j = 0; j < 12; ++j) { const float d = v[j] - mu; q += d * d; }
            const float rstd = rsqrtf(wave_sum(q) * (1.f / 768.f) + EPS);
            if (lane == 0) { stats[2 * r] = mu; stats[2 * r + 1] = rstd; }
        }
        __syncthreads();
        for (int g = 0; g < 6; ++g) {
            for (int i = tid; i < CHUNK * 128; i += NWAVES * 64) { const int s = i >> 7, d = i & 127, ch = g * 128 + d;
                vn[i] = (bf2f(gv[(size_t)(base + s) * 768 + ch]) - stats[2 * s]) * stats[2 * s + 1] * gain[ch] + bias[ch];
                wl[i] = wsp[(size_t)g * CHUNK * CHUNK + i]; }
            __syncthreads();
            const int d = tid & 127, tq = tid >> 7;
            for (int i = 0; i < 32; ++i) { const int tl = tq + 4 * i; float a = 0.f;
                for (int s = 0; s <= tl; ++s) a += wl[tl * 128 + s] * vn[s * 128 + d];
                a += bsp[g * CHUNK + tl];
                const size_t o = (size_t)(base + tl) * 2048 + g * 128 + d;
                mix[o] = (bf16)f2bf(bf2f(mix[o]) * a); }
            __syncthreads();
        }
    }
}
__device__ __forceinline__ void moba_body(Frame& F, bf16* mix, const bf16* kb, const bf16* vb, const float* kmean, const float* relb) {
    LAS float* lg = (LAS float*)F.lds + F.wave * 1024;
    const int lane = opq(lane_id());
    for (int w = F.vcu * NWAVES + F.wave; w < BATCH * NH * SEQ; w += F.G * NWAVES) {
        const int s = w % SEQ, bh = w / SEQ, h = bh % NH, b = bh / NH;
        const int t = b * SEQ + s, cur = s / MBLK;
        float q[64];
#pragma unroll
        for (int d = 0; d < 64; ++d) q[d] = bf2f(mix[(size_t)t * 2048 + 768 + h * 64 + d]);
        float gt[8];
#pragma unroll
        for (int n = 0; n < 8; ++n) { float a = 0.f;
            if (n < cur) { const float* km = kmean + (size_t)(b * NBLK + n) * 768 + h * 64;
#pragma unroll
                for (int d = 0; d < 64; ++d) a += q[d] * km[d]; }
            gt[n] = a; }
        unsigned sel = 0;
#pragma unroll
        for (int n = 0; n < 8; ++n) if (n < cur) { int rank = 0;
#pragma unroll
            for (int m = 0; m < 8; ++m) if (m < cur && m != n) rank += (gt[m] > gt[n] || (gt[m] == gt[n] && m < n)) ? 1 : 0;
            if (rank < 3) sel |= 1u << n; }
        int nslot = 0; float mx = -INFINITY;
        for (int n = 0; n <= cur; ++n) {
            if (n < cur && !((sel >> n) & 1u)) continue;
#pragma unroll
            for (int i = 0; i < 4; ++i) { const int j = lane + 64 * i, kp = n * MBLK + j, dist = s - kp; float l = -INFINITY;
                if (dist >= 0) { const bf16* kr = kb + (size_t)(b * SEQ + kp) * 768 + h * 64; float a = 0.f;
#pragma unroll
                    for (int d = 0; d < 64; ++d) a += q[d] * bf2f(kr[d]);
                    l = a + relb[t5_bucket(dist) * NH + h] * LOG2E; }
                lg[nslot * 256 + j] = l; mx = fmaxf(mx, l); }
            ++nslot;
        }
        mx = wave_max(mx);
        float sum = 0.f; const int nk = nslot * 256;
        for (int j = lane; j < nk; j += 64) { const float p = exp2f(lg[j] - mx); lg[j] = p; sum += p; }
        sum = wave_sum(sum);
        asm volatile("s_waitcnt lgkmcnt(0)" ::: "memory");
        float o = 0.f; int slot = 0;
        for (int n = 0; n <= cur; ++n) {
            if (n < cur && !((sel >> n) & 1u)) continue;
            const int jmax = (n == cur) ? (s - cur * MBLK + 1) : MBLK;
            for (int j = 0; j < jmax; ++j) o += lg[slot * 256 + j] * bf2f(vb[(size_t)(b * SEQ + n * MBLK + j) * 768 + h * 64 + lane]);
            ++slot;
        }
        mix[(size_t)t * 2048 + 768 + h * 64 + lane] = (bf16)f2bf(o / sum);
        asm volatile("s_waitcnt lgkmcnt(0)" ::: "memory");
    }
}
__device__ __forceinline__ void memattn_body(Frame& F, bf16* mix, const bf16* memkv) {
    LAS float* lg = (LAS float*)(F.lds + 32768) + F.wave * 256;
    const int lane = opq(lane_id());
    for (int w = F.vcu * NWAVES + F.wave; w < BATCH * MH * SEQ; w += F.G * NWAVES) {
        const int s = w % SEQ, bh = w / SEQ, h = bh % MH, b = bh / MH;
        const int t = b * SEQ + s;
        float mx = -INFINITY;
#pragma unroll
        for (int i = 0; i < 4; ++i) { const int m = lane + 64 * i;
            const bf16* kr = memkv + (size_t)(b * MEMLEN + m) * 1024 + h * 128; float a = 0.f;
            for (int d = 0; d < 128; ++d) a += bf2f(mix[(size_t)t * 2048 + 1536 + h * 128 + d]) * bf2f(kr[d]);
            lg[m] = a; mx = fmaxf(mx, a); }
        mx = wave_max(mx);
        float sum = 0.f;
#pragma unroll
        for (int i = 0; i < 4; ++i) { const int m = lane + 64 * i; const float p = exp2f(lg[m] - mx); lg[m] = p; sum += p; }
        sum = wave_sum(sum);
        asm volatile("s_waitcnt lgkmcnt(0)" ::: "memory");
        float o0 = 0.f, o1 = 0.f;
        for (int m = 0; m < MEMLEN; ++m) { const bf16* vr = memkv + (size_t)(b * MEMLEN + m) * 1024 + 512 + h * 128;
            const float p = lg[m]; o0 += p * bf2f(vr[lane]); o1 += p * bf2f(vr[lane + 64]); }
        mix[(size_t)t * 2048 + 1536 + h * 128 + lane] = (bf16)f2bf(o0 / sum);
        mix[(size_t)t * 2048 + 1536 + h * 128 + lane + 64] = (bf16)f2bf(o1 / sum);
        asm volatile("s_waitcnt lgkmcnt(0)" ::: "memory");
    }
}

__global__ void __launch_bounds__(NWAVES * 64, 2) mega_fwd(Args args) {
    extern __shared__ __attribute__((aligned(16))) unsigned char lds_raw[];
    cg::grid_group grid = cg::this_grid();
    Frame F;
    F.lds = (LAS unsigned char*)lds_raw;
    F.wave = __builtin_amdgcn_readfirstlane((int)threadIdx.x >> 6);
    F.G = gridDim.x; { const int bx = blockIdx.x; F.vcu = (F.G % 8 == 0) ? (bx % 8) * (F.G / 8) + bx / 8 : bx; }
    unsigned char* ws = args.ws; unsigned char* dob = (unsigned char*)args.out;
    const float* x = args.in[0]; const float* mem = args.in[1];
    const float *ln_mix_pre = args.in[2], *ln_mix_post = args.in[3], *ln_ffn_pre = args.in[4], *ln_ffn_post = args.in[5], *ln_mem = args.in[6];
    bf16* H = (bf16*)(dob + DO_H); bf16* MERGED = H; bf16* MEMN = (bf16*)(dob + DO_MEMN);
    bf16 *WCAT = (bf16*)(dob + DO_WCAT), *WOUT = (bf16*)(dob + DO_WOUT), *WGU = (bf16*)(dob + DO_WGU), *WD = (bf16*)(dob + DO_WD);
    bf16 *WIN = (bf16*)(ws + WS_WIN), *WKV = (bf16*)(ws + WS_WKV), *MEMKV = (bf16*)(ws + WS_MEMKV), *MIX = (bf16*)(ws + WS_MIX);
    bf16 *GV = (bf16*)(ws + WS_GV), *KB = (bf16*)(ws + WS_KB), *VB = (bf16*)(ws + WS_VB), *GATES = (bf16*)(ws + WS_GATES);
    float* KMEAN = (float*)(ws + WS_KMEAN);
    float *Y = (float*)(ws + WS_Y), *FF = (float*)(ws + WS_F), *X1 = (float*)(ws + WS_X1); bf16 *HID = (bf16*)(ws + WS_HID), *H2 = (bf16*)(ws + WS_H2);
    const int gw = F.vcu * NWAVES + F.wave, NGW = F.G * NWAVES;
    volatile LAS unsigned* MISC = (volatile LAS unsigned*)(F.lds + (LDS_BYTES - 64));
    if (F.wave == 0 && lane_id() == 0) { MISC[0] = 0u; MISC[1] = 0u; }
    __syncthreads();
    unsigned* barw = (unsigned*)(ws + WS_CTL) + 4096;
    if (args.ph_lo < 0) grid.sync();
    XcdBarrier bar = xcd_barrier_post(barw, MISC, F.wave);

#define IN(k) (args.ph_lo <= (k) && (k) < args.ph_hi)
#define SEAM(k) do { if (IN(k) && IN((k) + 1)) xcd_barrier(bar, F.wave); } while (0)
    if (IN(0)) for (int rep_ = 0; rep_ < REPS(0); ++rep_) {
        LAS float* scr = (LAS float*)(F.lds + F.wave * 16384);
        const int lane0 = opq(lane_id());
        constexpr int I_IN = 16 * (INW / 32), I_KV = 16 * 32, I_A = 12 * 32, I_C = 8 * 32, I_O = 16 * 32, I_G = 16 * (DFF / 32), I_D = (DFF / 64) * 32;
        constexpr int NITEMS = I_IN + I_KV + 2 * I_A + I_C + I_O + 2 * I_G + I_D;
        for (int it = gw; it < NITEMS; it += NGW) {
            int r = it;
            if (r < I_IN) { p0_transpose_item(args.in[7], 1024, INW, WIN, 1024, 0, 0, scr, r, lane0); continue; } r -= I_IN;
            if (r < I_KV) { p0_transpose_item(args.in[13], 1024, 1024, WKV, 1024, 0, 0, scr, r, lane0); continue; } r -= I_KV;
            if (r < I_A) { p0_transpose_item(args.in[14], 768, 1024, WCAT, 2048, 0, 0, scr, r, lane0); continue; } r -= I_A;
            if (r < I_A) { p0_transpose_item(args.in[15], 768, 1024, WCAT, 2048, 768, 0, scr, r, lane0); continue; } r -= I_A;
            if (r < I_C) { p0_transpose_item(args.in[16], 512, 1024, WCAT, 2048, 1536, 0, scr, r, lane0); continue; } r -= I_C;
            if (r < I_O) { p0_transpose_item(args.in[17], 1024, 1024, WOUT, 1024, 0, 0, scr, r, lane0); continue; } r -= I_O;
            if (r < I_G) { p0_transpose_item(args.in[18], 1024, DFF, WGU, 1024, 0, 1, scr, r, lane0); continue; } r -= I_G;
            if (r < I_G) { p0_transpose_item(args.in[19], 1024, DFF, WGU, 1024, 0, 2, scr, r, lane0); continue; } r -= I_G;
            p0_transpose_item(args.in[20], DFF, 1024, WD, DFF, 0, 0, scr, r, lane0);
        }
        for (int m = gw; m < T; m += NGW) rms_row_bf16(x + (size_t)m * DM, ln_mix_pre, H + (size_t)m * DM, lane0);
        for (int m = gw; m < TM; m += NGW) rms_row_bf16(mem + (size_t)m * DM, ln_mem, MEMN + (size_t)m * DM, lane0);
        for (int i = blockIdx.x * (NWAVES * 64) + F.wave * 64 + lane0; i < BATCH * NBLK * 768; i += F.G * NWAVES * 64) KMEAN[i] = 0.f;
    }
    SEAM(0);
    if (IN(1)) for (int rep_ = 0; rep_ < REPS(1); ++rep_) {
        pg8::Gemm g{H, WIN, T, INW, 1024}; pg8::StaticOrder S; S.init(T, INW, F.G, (int)blockIdx.x);
        pg8::EpiProj E{MIX, GV, KB, VB, GATES, KMEAN};
        if (DBG_P1 & 1) pg8::gemm_phase<pg8::EpiProj, pg8::StaticOrder, true, true>(F.lds, g, S, E, F.wave);
        pg8::Gemm g2{MEMN, WKV, TM, 1024, 1024}; pg8::StaticOrder S2; S2.init(TM, 1024, F.G, (int)blockIdx.x);
        pg8::EpiBf16Plain E2{MEMKV, 1024};
        if (DBG_P1 & 2) pg8::gemm_phase<pg8::EpiBf16Plain, pg8::StaticOrder, true, true>(F.lds, g2, S2, E2, F.wave);
    }
    SEAM(1);
    if (IN(2)) {
#if DBG_NAIVE_GMLP
    gmlp_body(F, GV, args.in[8], args.in[9], args.in[10], args.in[11], MIX);
#else
    mix2::gmlp_phase(F.lds, F.wave, F.vcu, F.G, GV, args.in[8], args.in[9], args.in[10], args.in[11], MIX);
    if (DUP_MASK & 0x200) mix2::gmlp_phase(F.lds, F.wave, F.vcu, F.G, GV, args.in[8], args.in[9], args.in[10], args.in[11], MIX, (bf16*)(ws + 490 * MiB));
#endif
#if DBG_NAIVE_MOBA
    moba_body(F, MIX, KB, VB, KMEAN, args.in[12]);
#else
    { __syncthreads();
      const mattn::AttnTensors AT{(const mattn::bf16*)MIX, (const mattn::bf16*)KB, (const mattn::bf16*)VB, (mattn::bf16*)MIX, KMEAN, args.in[12]};
      mattn::attn_phase<8>((char*)lds_raw, AT, F.vcu, F.G);
      __syncthreads(); }
#endif
#if DBG_NAIVE_MEMATTN
    memattn_body(F, MIX, MEMKV);
#else
    mix2::memattn_phase(F.lds, F.wave, F.vcu, F.G, MIX, MEMKV);
    if (DUP_MASK & 0x400) mix2::memattn_phase(F.lds, F.wave, F.vcu, F.G, MIX, MEMKV, (bf16*)(ws + 490 * MiB));
#endif
    }
    SEAM(2);
    if (IN(3)) for (int rep_ = 0; rep_ < REPS(3); ++rep_) {
        pg8::Gemm g{MIX, WCAT, T, 1024, 2048}; pg8::StaticOrder S; S.init(T, 1024, F.G, (int)blockIdx.x);
        pg8::EpiMerge E{GATES, MERGED};
        pg8::gemm_phase<pg8::EpiMerge, pg8::StaticOrder, true, true, true>(F.lds, g, S, E, F.wave);
    }
    SEAM(3);
    if (IN(4)) for (int rep_ = 0; rep_ < REPS(4); ++rep_) {
        pg8::Gemm g{MERGED, WOUT, T, 1024, 1024}; pg8::StaticOrder S; S.init(T, 1024, F.G, (int)blockIdx.x);
        pg8::EpiF32 E{Y, 1024};
        pg8::gemm_phase<pg8::EpiF32, pg8::StaticOrder, true, true>(F.lds, g, S, E, F.wave);
    }
    SEAM(4);
    if (IN(5)) for (int rep_ = 0; rep_ < REPS(5); ++rep_) for (int m = gw; m < T; m += NGW) post_norm_row(x + (size_t)m * DM, Y + (size_t)m * DM, ln_mix_post, X1 + (size_t)m * DM, ln_ffn_pre, H2 + (size_t)m * DM, lane_id());
    SEAM(5);
    if (IN(6)) for (int rep_ = 0; rep_ < REPS(6); ++rep_) {
        pg8::Gemm g{H2, WGU, T, 2 * DFF, 1024}; pg8::StaticOrder S; S.init(T, 2 * DFF, F.G, (int)blockIdx.x);
        pg8::EpiSwiGLU E{HID, DFF};
        pg8::gemm_phase<pg8::EpiSwiGLU, pg8::StaticOrder, true, true>(F.lds, g, S, E, F.wave);
    }
    SEAM(6);
    if (IN(7)) for (int rep_ = 0; rep_ < REPS(7); ++rep_) {
        pg8::Gemm g{HID, WD, T, 1024, DFF}; pg8::StaticOrder S; S.init(T, 1024, F.G, (int)blockIdx.x);
        pg8::EpiF32 E{FF, 1024};
        pg8::gemm_phase<pg8::EpiF32, pg8::StaticOrder, true, true>(F.lds, g, S, E, F.wave);
    }
    SEAM(7);
    if (IN(8)) for (int rep_ = 0; rep_ < REPS(8); ++rep_) for (int m = gw; m < T; m += NGW) post_norm_row(X1 + (size_t)m * DM, FF + (size_t)m * DM, ln_ffn_post, args.out + (size_t)m * DM, nullptr, nullptr, lane_id());
}

extern "C" void kernel_launch(void* const* d_in, const int* in_sizes, int n_in, void* d_out, int out_size, void* d_ws, size_t ws_size, hipStream_t stream) {
    static int grid = 0;
    if (grid == 0) {
        if (n_in != 21 || out_size != T * DM || ws_size < WS_NEED) { fprintf(stderr, "kernel_launch: unexpected shapes (n_in %d out %d ws %zu)\n", n_in, out_size, ws_size); grid = -1; return; }
        int dev = 0, cus = 0, per_cu = 0;
        if (hipGetDevice(&dev) != hipSuccess || hipDeviceGetAttribute(&cus, hipDeviceAttributeMultiprocessorCount, dev) != hipSuccess) { grid = -1; return; }
        if (hipFuncSetAttribute((const void*)mega_fwd, hipFuncAttributeMaxDynamicSharedMemorySize, LDS_BYTES) != hipSuccess) { fprintf(stderr, "kernel_launch: hipFuncSetAttribute failed\n"); grid = -1; return; }
        if (hipOccupancyMaxActiveBlocksPerMultiprocessor(&per_cu, (const void*)mega_fwd, NWAVES * 64, LDS_BYTES) != hipSuccess || per_cu < 1) { fprintf(stderr, "kernel_launch: occupancy query says %d\n", per_cu); per_cu = 1; }
        (void)hipGetLastError();
        grid = cus;
    }
    if (grid < 0) return;
    Args a{};
    for (int i = 0; i < 21; ++i) a.in[i] = (const float*)d_in[i];
    a.out = (float*)d_out; a.ws = (unsigned char*)d_ws;
#ifndef MK_PER_PHASE
#define MK_PER_PHASE 0
#endif
    if (MK_PER_PHASE) {
        for (int p = 0; p < 9; ++p) { a.ph_lo = p; a.ph_hi = p + 1; hipLaunchKernelGGL(mega_fwd, dim3(grid), dim3(NWAVES * 64), LDS_BYTES, stream, a); }
    } else {
        a.ph_lo = 0; a.ph_hi = 9;
        (void)hipMemsetAsync((unsigned char*)d_ws + WS_CTL + 4096 * 4, 0, XCD_BAR_WORDS * 4, stream);
        void* kargs[] = {&a};
        hipError_t e = hipLaunchCooperativeKernel((const void*)mega_fwd, dim3(grid), dim3(NWAVES * 64), kargs, LDS_BYTES, stream);
        if (e != hipSuccess) fprintf(stderr, "kernel_launch: cooperative launch failed: %s (grid %d)\n", hipGetErrorString(e), grid);
    }
}
```
